# Optimizing an MI355X kernel written in HIP

```python
import math
import jax
import jax.numpy as jnp
from jax import lax
import numpy as np

D_MODEL = 1024
BATCH = 16
SEQ = 2048
DEPTH = 4

GRID_W = 64
CTX_LEN = 256
HEAD_DIM = 64
EPS = 1e-6
NEG_INF = -1e30

S5_CH = 256
S5_GROUP_CH = 16
S5_GROUPS = S5_CH // S5_GROUP_CH
S5_STATE = 64
NA_HEADS = 4
NA_DIM = NA_HEADS * HEAD_DIM
NA_KH = 8
NA_KW = 16
NA_QB = NA_KW
GLA_HEADS = 4
GLA_DK = 64
GLA_DV = 64
GLA_QK = GLA_HEADS * GLA_DK
GLA_V = GLA_HEADS * GLA_DV
GLA_RANK = 16
GLA_TAU = 16.0
GLA_CHUNK = 64
SWA_HEADS = 4
SWA_KV_HEADS = 2
SWA_Q = SWA_HEADS * HEAD_DIM
SWA_KV = SWA_KV_HEADS * HEAD_DIM
SWA_WINDOW = 128
SWA_BLOCK = 128
ROPE_BASE = 10000.0
D_FF = 2816
FFN_CONV = 3

IN_SIZES = (S5_CH, NA_DIM, NA_DIM, NA_DIM, GLA_QK, GLA_QK, GLA_V, GLA_RANK, GLA_RANK, GLA_V, SWA_Q, SWA_KV, SWA_KV)
D_IN = sum(IN_SIZES)
D_MIX = S5_CH + NA_DIM + GLA_V + SWA_Q

kernel_name = "hybrid_parallel_heads_diffusion_trunk"


def rmsnorm(x, g):
    xf = x.astype(jnp.float32)
    y = xf * lax.rsqrt(jnp.mean(xf * xf, axis=-1, keepdims=True) + EPS)
    return (y * g.astype(jnp.float32)).astype(x.dtype)


def split_in(p):
    out, off = [], 0
    for s in IN_SIZES:
        out.append(p[..., off:off + s])
        off += s
    return out


def joint_softmax(*logits):
    sizes = [t.shape[-1] for t in logits]
    p = jax.nn.softmax(jnp.concatenate([t.astype(jnp.float32) for t in logits], axis=-1), axis=-1)
    out, off = [], 0
    for s in sizes:
        out.append(p[..., off:off + s])
        off += s
    return out


def _linear_combine(e1, e2):
    a1, b1 = e1
    a2, b2 = e2
    return a2 * a1, a2 * b1 + b2


def s5_discretize(lam_re, lam_im, b_re, b_im, log_step):
    lam = lax.complex(lam_re.astype(jnp.float32), lam_im.astype(jnp.float32))
    step = jnp.exp(log_step.astype(jnp.float32))[:, None]
    lam_bar = jnp.exp(lam * step)
    b = lax.complex(b_re.astype(jnp.float32), b_im.astype(jnp.float32))
    b_bar = ((lam_bar - 1.0) / lam)[..., None] * b
    return lam_bar, b_bar


def s5_scan(u, lam_bar, b_bar, h0, reverse):
    bu = jnp.einsum("gpc,blgc->blgp", b_bar, u.astype(jnp.complex64))
    if h0 is not None:
        bu = bu.at[:, -1 if reverse else 0].add(lam_bar * h0)
    a = jnp.broadcast_to(lam_bar, bu.shape)
    _, h = lax.associative_scan(_linear_combine, (a, bu), reverse=reverse, axis=1)
    return h


def s5_mixer(u_c, u_l, lam_re, lam_im, b_re, b_im, c_re, c_im, log_step, d_skip, w_glu, ctx_out):
    bsz = u_l.shape[0]
    uc = u_c.astype(jnp.float32).reshape(bsz, -1, S5_GROUPS, S5_GROUP_CH)
    ul = u_l.astype(jnp.float32).reshape(bsz, -1, S5_GROUPS, S5_GROUP_CH)
    dsk = d_skip.astype(jnp.float32).reshape(S5_GROUPS, S5_GROUP_CH)
    y_l = dsk * ul
    y_c = dsk * uc if ctx_out else None
    for direction, reverse in ((0, False), (1, True)):
        lam_bar, b_bar = s5_discretize(lam_re[direction], lam_im[direction], b_re[direction], b_im[direction], log_step[direction])
        c_mat = lax.complex(c_re[direction].astype(jnp.float32), c_im[direction].astype(jnp.float32))
        h_c = s5_scan(uc, lam_bar, b_bar, None, reverse)
        h0 = h_c[:, 0] if reverse else h_c[:, -1]
        h_l = s5_scan(ul, lam_bar, b_bar, h0, reverse)
        y_l = y_l + jnp.einsum("gcp,blgp->blgc", c_mat, h_l).real
        if ctx_out:
            y_c = y_c + jnp.einsum("gcp,blgp->blgc", c_mat, h_c).real

    def glu(y):
        z = jax.nn.gelu(y.reshape(bsz, -1, S5_CH))
        return z * jax.nn.sigmoid(z @ w_glu.astype(jnp.float32))

    return (glu(y_c) if ctx_out else None), glu(y_l)


def dense_ctx_attention(q, k, v):
    s = jnp.einsum("bqhd,bkhd->bhqk", q, k).astype(jnp.float32) * HEAD_DIM ** -0.5
    p = jax.nn.softmax(s, axis=-1)
    return jnp.einsum("bhqk,bkhd->bqhd", p, v)


def na_mixer(q_c, k_c, v_c, q_l, k_l, v_l, rpb, rows, ctx_out):
    bsz, seq, _ = q_l.shape
    kh = min(NA_KH, rows)
    kw = NA_KW
    ncb = GRID_W // NA_QB
    kbw = 2 * kw
    scale = HEAD_DIM ** -0.5
    kc = k_c.reshape(bsz, -1, NA_HEADS, HEAD_DIM)
    vc = v_c.reshape(bsz, -1, NA_HEADS, HEAD_DIM)
    ql = q_l.reshape(bsz, rows, ncb, NA_QB, NA_HEADS, HEAD_DIM)
    kg = k_l.reshape(bsz, rows, GRID_W, NA_HEADS, HEAD_DIM)
    vg = v_l.reshape(bsz, rows, GRID_W, NA_HEADS, HEAD_DIM)
    r = jnp.arange(rows)
    row_idx = jnp.clip(r - kh // 2, 0, rows - kh)[:, None] + jnp.arange(kh)[None, :]
    q_col = jnp.arange(GRID_W).reshape(ncb, NA_QB)
    col_idx = jnp.clip(q_col[:, 0] - kw // 2, 0, GRID_W - kbw)[:, None] + jnp.arange(kbw)[None, :]
    k_blk = kg[:, row_idx[:, None, :, None], col_idx[None, :, None, :]]
    v_blk = vg[:, row_idx[:, None, :, None], col_idx[None, :, None, :]]
    win_start = jnp.clip(q_col - kw // 2, 0, GRID_W - kw)
    kcol = col_idx[:, None, :]
    in_win = (kcol >= win_start[..., None]) & (kcol < win_start[..., None] + kw)
    dr = row_idx - r[:, None] + (NA_KH - 1)
    dc = jnp.clip(kcol - q_col[..., None], -(kw - 1), kw - 1) + (NA_KW - 1)
    bias = rpb[:, dr[:, None, None, :, None], dc[None, :, :, None, :]]
    s_nb = jnp.einsum("brnqhd,brnkwhd->bhrnqkw", ql, k_blk).astype(jnp.float32) * scale + bias.astype(jnp.float32)
    s_nb = jnp.where(in_win[:, :, None, :], s_nb, NEG_INF)
    s_cx = jnp.einsum("brnqhd,bchd->bhrnqc", ql, kc).astype(jnp.float32) * scale
    p_nb, p_cx = joint_softmax(s_nb.reshape(s_nb.shape[:5] + (kh * kbw,)), s_cx)
    p_nb = p_nb.reshape(s_nb.shape)
    o = jnp.einsum("bhrnqkw,brnkwhd->brnqhd", p_nb, v_blk) + jnp.einsum("bhrnqc,bchd->brnqhd", p_cx, vc)
    o_l = o.reshape(bsz, seq, NA_DIM)
    o_c = None
    if ctx_out:
        qc = q_c.reshape(bsz, -1, NA_HEADS, HEAD_DIM)
        o_c = dense_ctx_attention(qc, kc, vc).reshape(bsz, -1, NA_DIM)
    return o_c, o_l


def gla_chunked(q, k, v, log_a, s0):
    bsz, L, H, dk = q.shape
    dv = v.shape[-1]
    n = L // GLA_CHUNK

    def chunks(t):
        return t.reshape(bsz, n, GLA_CHUNK, H, t.shape[-1]).transpose(0, 3, 1, 2, 4)

    qh, kh, vh, g = chunks(q), chunks(k), chunks(v), chunks(log_a)
    b = jnp.cumsum(g, axis=3)
    b_last = b[:, :, :, -1:]
    q_dec = qh * jnp.exp(b)
    k_dec = kh * jnp.exp(-b)
    k_end = kh * jnp.exp(b_last - b)
    causal = jnp.tril(jnp.ones((GLA_CHUNK, GLA_CHUNK), dtype=bool))
    a_intra = jnp.where(causal, jnp.einsum("bhnid,bhnjd->bhnij", q_dec, k_dec), 0.0)
    o_intra = jnp.einsum("bhnij,bhnjv->bhniv", a_intra, vh)
    ds = jnp.einsum("bhnjd,bhnjv->bhndv", k_end, vh)
    decay = jnp.exp(b_last[:, :, :, 0])
    if s0 is None:
        s0 = jnp.zeros((bsz, H, dk, dv), jnp.float32)

    def step(s, inp):
        dec, d = inp
        return dec[..., None] * s + d, s

    s_final, s_prev = lax.scan(step, s0, (jnp.moveaxis(decay, 2, 0), jnp.moveaxis(ds, 2, 0)))
    s_prev = jnp.moveaxis(s_prev, 0, 2)
    o_inter = jnp.einsum("bhnid,bhndv->bhniv", q_dec, s_prev)
    o = (o_intra + o_inter).transpose(0, 2, 3, 1, 4).reshape(bsz, L, H, dv)
    return o, s_final


def gla_prep(q, k, v, gf, gb, w_gate2, b_gate):
    bsz, L, _ = q.shape
    shp = (bsz, L, GLA_HEADS, GLA_DK)
    qh = q.astype(jnp.float32).reshape(shp) * GLA_DK ** -0.5
    kh = k.astype(jnp.float32).reshape(shp)
    vh = v.astype(jnp.float32).reshape(bsz, L, GLA_HEADS, GLA_DV)
    la_f = (jax.nn.log_sigmoid((gf @ w_gate2[0] + b_gate[0]).astype(jnp.float32)) / GLA_TAU).reshape(shp)
    la_b = (jax.nn.log_sigmoid((gb @ w_gate2[1] + b_gate[1]).astype(jnp.float32)) / GLA_TAU).reshape(shp)
    return qh, kh, vh, la_f, la_b


def _flip(t):
    return jnp.flip(t, axis=1)


def gla_mixer(q_c, k_c, v_c, gf_c, gb_c, r_c, q_l, k_l, v_l, gf_l, gb_l, r_l, w_gate2, b_gate, g_norm, ctx_out):
    qc, kc, vc, lfc, lbc = gla_prep(q_c, k_c, v_c, gf_c, gb_c, w_gate2, b_gate)
    ql, kl, vl, lfl, lbl = gla_prep(q_l, k_l, v_l, gf_l, gb_l, w_gate2, b_gate)
    o_cf, s_cf = gla_chunked(qc, kc, vc, lfc, None)
    o_cb, s_cb = gla_chunked(_flip(qc), _flip(kc), _flip(vc), _flip(lbc), None)
    o_lf, _ = gla_chunked(ql, kl, vl, lfl, s_cf)
    o_lb, _ = gla_chunked(_flip(ql), _flip(kl), _flip(vl), _flip(lbl), s_cb)

    def finish(o, r):
        bsz, L = o.shape[:2]
        return rmsnorm(o, g_norm).reshape(bsz, L, GLA_V) * jax.nn.silu(r.astype(jnp.float32))

    o_l = finish(o_lf + _flip(o_lb), r_l)
    o_c = finish(o_cf + _flip(o_cb), r_c) if ctx_out else None
    return o_c, o_l


def rotate_axis(t, pos):
    d = t.shape[-1]
    inv_freq = ROPE_BASE ** (-jnp.arange(0, d, 2, dtype=jnp.float32) / d)
    ang = pos.astype(jnp.float32)[:, None] * inv_freq[None, :]
    cos = jnp.cos(ang)[None, :, None, :]
    sin = jnp.sin(ang)[None, :, None, :]
    t1 = t[..., : d // 2].astype(jnp.float32)
    t2 = t[..., d // 2:].astype(jnp.float32)
    return jnp.concatenate([t1 * cos - t2 * sin, t1 * sin + t2 * cos], axis=-1).astype(t.dtype)


def rope_2d(t, pos_row, pos_col):
    half = t.shape[-1] // 2
    return jnp.concatenate([rotate_axis(t[..., :half], pos_row), rotate_axis(t[..., half:], pos_col)], axis=-1)


def swa_mixer(q_c, k_c, v_c, q_l, k_l, v_l, sink, pos_row, pos_col, ctx_out):
    bsz, seq, _ = q_l.shape
    grp = SWA_HEADS // SWA_KV_HEADS
    nb = seq // SWA_BLOCK
    scale = HEAD_DIM ** -0.5
    ql = rope_2d(q_l.reshape(bsz, seq, SWA_HEADS, HEAD_DIM), pos_row, pos_col)
    ql = ql.reshape(bsz, nb, SWA_BLOCK, SWA_KV_HEADS, grp, HEAD_DIM)
    kl = rope_2d(k_l.reshape(bsz, seq, SWA_KV_HEADS, HEAD_DIM), pos_row, pos_col)
    vl = v_l.reshape(bsz, seq, SWA_KV_HEADS, HEAD_DIM)

    def band(t):
        tp = jnp.pad(t, ((0, 0), (SWA_BLOCK, SWA_BLOCK), (0, 0), (0, 0)))
        tp = tp.reshape(bsz, nb + 2, SWA_BLOCK, SWA_KV_HEADS, HEAD_DIM)
        return jnp.concatenate([tp[:, :-2], tp[:, 1:-1], tp[:, 2:]], axis=2)

    k_band, v_band = band(kl), band(vl)
    qpos = jnp.arange(nb)[:, None] * SWA_BLOCK + jnp.arange(SWA_BLOCK)[None, :]
    kpos = (jnp.arange(nb)[:, None] - 1) * SWA_BLOCK + jnp.arange(3 * SWA_BLOCK)[None, :]
    valid = ((kpos[:, None, :] >= 0) & (kpos[:, None, :] < seq)
             & (jnp.abs(qpos[:, :, None] - kpos[:, None, :]) <= SWA_WINDOW))
    kc = k_c.reshape(bsz, -1, SWA_KV_HEADS, HEAD_DIM)
    vc = v_c.reshape(bsz, -1, SWA_KV_HEADS, HEAD_DIM)
    sink_f = sink.astype(jnp.float32)
    s_band = jnp.einsum("bnqhgd,bnkhd->bhgnqk", ql, k_band).astype(jnp.float32) * scale
    s_band = jnp.where(valid, s_band, NEG_INF)
    s_cx = jnp.einsum("bnqhgd,bchd->bhgnqc", ql, kc).astype(jnp.float32) * scale
    s_sink = jnp.broadcast_to(sink_f.reshape(SWA_KV_HEADS, grp, 1, 1, 1), s_cx.shape[:-1] + (1,))
    p_band, p_cx, _ = joint_softmax(s_band, s_cx, s_sink)
    o = jnp.einsum("bhgnqk,bnkhd->bnqhgd", p_band, v_band) + jnp.einsum("bhgnqc,bchd->bnqhgd", p_cx, vc)
    o_l = o.reshape(bsz, seq, SWA_Q)
    o_c = None
    if ctx_out:
        qc = q_c.reshape(bsz, -1, SWA_KV_HEADS, grp, HEAD_DIM)
        sc = jnp.einsum("bqhgd,bkhd->bhgqk", qc, kc).astype(jnp.float32) * scale
        sc_sink = jnp.broadcast_to(sink_f.reshape(SWA_KV_HEADS, grp, 1, 1), sc.shape[:-1] + (1,))
        pc, _ = joint_softmax(sc, sc_sink)
        o_c = jnp.einsum("bhgqk,bkhd->bqhgd", pc, vc).reshape(bsz, -1, SWA_Q)
    return o_c, o_l


def conv_ffn(h, w_up, conv_w, w_down):
    gate, val = jnp.split(h @ w_up, 2, axis=-1)
    gp = jnp.pad(gate, ((0, 0), (1, 1), (0, 0)))
    gate = gp[:, :-2] * conv_w[0] + gp[:, 1:-1] * conv_w[1] + gp[:, 2:] * conv_w[2]
    return (jax.nn.gelu(gate) * val) @ w_down


def token_mixing(pc, pl, rows, pos_row, pos_col, s5_lam_re, s5_lam_im, s5_b_re, s5_b_im, s5_c_re, s5_c_im,
                 s5_log_step, s5_d, s5_w_glu, na_rpb, gla_w_gate2, gla_b_gate, gla_g_norm, swa_sink, ctx_out):
    (a_c, naq_c, nak_c, nav_c, gq_c, gk_c, gv_c, gf_c, gb_c, gr_c, sq_c, sk_c, sv_c) = split_in(pc)
    (a_l, naq_l, nak_l, nav_l, gq_l, gk_l, gv_l, gf_l, gb_l, gr_l, sq_l, sk_l, sv_l) = split_in(pl)
    oa_c, oa_l = s5_mixer(a_c, a_l, s5_lam_re, s5_lam_im, s5_b_re, s5_b_im, s5_c_re, s5_c_im,
                          s5_log_step, s5_d, s5_w_glu, ctx_out)
    ob_c, ob_l = na_mixer(naq_c, nak_c, nav_c, naq_l, nak_l, nav_l, na_rpb, rows, ctx_out)
    oc_c, oc_l = gla_mixer(gq_c, gk_c, gv_c, gf_c, gb_c, gr_c, gq_l, gk_l, gv_l, gf_l, gb_l, gr_l,
                           gla_w_gate2, gla_b_gate, gla_g_norm, ctx_out)
    od_c, od_l = swa_mixer(sq_c, sk_c, sv_c, sq_l, sk_l, sv_l, swa_sink, pos_row, pos_col, ctx_out)
    dt = pl.dtype
    y_l = jnp.concatenate([oa_l.astype(dt), ob_l.astype(dt), oc_l.astype(dt), od_l.astype(dt)], axis=-1)
    y_c = None
    if ctx_out:
        y_c = jnp.concatenate([oa_c.astype(dt), ob_c.astype(dt), oc_c.astype(dt), od_c.astype(dt)], axis=-1)
    return y_c, y_l


def setup_inputs(seed: int = 0) -> dict:
    key = jax.random.key(seed)
    ks = jax.random.split(key, 29)
    f32 = jnp.float32
    L = DEPTH

    def nrm(k, shape, s=1.0):
        return s * jax.random.normal(k, shape, f32)

    n_idx = jnp.arange(S5_STATE, dtype=f32)
    return {
        "x": nrm(ks[0], (BATCH, SEQ, D_MODEL)),
        "c": nrm(ks[1], (BATCH, D_MODEL)),
        "ctx": nrm(ks[2], (BATCH, CTX_LEN, D_MODEL)),
        "c_ctx": nrm(ks[3], (D_MODEL,)),
        "w_mod": nrm(ks[4], (L, D_MODEL, 6 * D_MODEL), D_MODEL ** -0.5),
        "b_mod": nrm(ks[5], (L, 6 * D_MODEL), 0.02),
        "g_pre_mix": 1.0 + nrm(ks[6], (L, D_MODEL), 0.05),
        "g_post_mix": 1.0 + nrm(ks[7], (L, D_MODEL), 0.05),
        "g_pre_ffn": 1.0 + nrm(ks[8], (L, D_MODEL), 0.05),
        "g_post_ffn": 1.0 + nrm(ks[9], (L, D_MODEL), 0.05),
        "w_in": nrm(ks[10], (L, D_MODEL, D_IN), D_MODEL ** -0.5),
        "w_out": nrm(ks[11], (L, D_MIX, D_MODEL), D_MIX ** -0.5),
        "s5_lam_re": -0.5 + nrm(ks[12], (L, 2, S5_GROUPS, S5_STATE), 0.01),
        "s5_lam_im": math.pi * n_idx + nrm(ks[13], (L, 2, S5_GROUPS, S5_STATE), 0.01),
        "s5_b_re": nrm(ks[14], (L, 2, S5_GROUPS, S5_STATE, S5_GROUP_CH), (2 * S5_GROUP_CH) ** -0.5),
        "s5_b_im": nrm(ks[15], (L, 2, S5_GROUPS, S5_STATE, S5_GROUP_CH), (2 * S5_GROUP_CH) ** -0.5),
        "s5_c_re": nrm(ks[16], (L, 2, S5_GROUPS, S5_GROUP_CH, S5_STATE), S5_STATE ** -0.5),
        "s5_c_im": nrm(ks[17], (L, 2, S5_GROUPS, S5_GROUP_CH, S5_STATE), S5_STATE ** -0.5),
        "s5_log_step": jax.random.uniform(ks[18], (L, 2, S5_GROUPS), f32, math.log(1e-3), math.log(1e-1)),
        "s5_d": nrm(ks[19], (L, S5_CH)),
        "s5_w_glu": nrm(ks[20], (L, S5_CH, S5_CH), S5_CH ** -0.5),
        "na_rpb": nrm(ks[21], (L, NA_HEADS, 2 * NA_KH - 1, 2 * NA_KW - 1), 0.1),
        "gla_w_gate2": nrm(ks[22], (L, 2, GLA_RANK, GLA_QK), GLA_RANK ** -0.5),
        "gla_b_gate": nrm(ks[23], (L, 2, GLA_QK), 0.1),
        "gla_g_norm": 1.0 + nrm(ks[24], (L, GLA_DV), 0.05),
        "swa_sink": nrm(ks[25], (L, SWA_HEADS), 0.5),
        "ffn_w_up": nrm(ks[26], (L, D_MODEL, 2 * D_FF), D_MODEL ** -0.5),
        "ffn_conv": nrm(ks[27], (L, FFN_CONV, D_FF), FFN_CONV ** -0.5),
        "ffn_w_down": nrm(ks[28], (L, D_FF, D_MODEL), D_FF ** -0.5),
    }


def reference(x, c, ctx, c_ctx, w_mod, b_mod, g_pre_mix, g_post_mix, g_pre_ffn, g_post_ffn, w_in, w_out,
              s5_lam_re, s5_lam_im, s5_b_re, s5_b_im, s5_c_re, s5_c_im, s5_log_step, s5_d, s5_w_glu,
              na_rpb, gla_w_gate2, gla_b_gate, gla_g_norm, swa_sink, ffn_w_up, ffn_conv, ffn_w_down):
    seq = x.shape[1]
    rows = seq // GRID_W
    t = jnp.arange(seq)
    pos_row, pos_col = t // GRID_W, t % GRID_W
    silu_c = jax.nn.silu(c)
    silu_cc = jax.nn.silu(c_ctx)
    xl, xc = x, ctx
    for l in range(DEPTH):
        ctx_out = l < DEPTH - 1
        mod_l = (silu_c @ w_mod[l] + b_mod[l])[:, None, :]
        mod_c = (silu_cc @ w_mod[l] + b_mod[l])[None, None, :]
        sh_ml, sc_ml, gt_ml, sh_fl, sc_fl, gt_fl = jnp.split(mod_l, 6, axis=-1)
        sh_mc, sc_mc, gt_mc, sh_fc, sc_fc, gt_fc = jnp.split(mod_c, 6, axis=-1)
        hl = rmsnorm(xl, g_pre_mix[l]) * (1.0 + sc_ml) + sh_ml
        hc = rmsnorm(xc, g_pre_mix[l]) * (1.0 + sc_mc) + sh_mc
        y_c, y_l = token_mixing(hc @ w_in[l], hl @ w_in[l], rows, pos_row, pos_col,
                                s5_lam_re[l], s5_lam_im[l], s5_b_re[l], s5_b_im[l], s5_c_re[l], s5_c_im[l],
                                s5_log_step[l], s5_d[l], s5_w_glu[l], na_rpb[l], gla_w_gate2[l], gla_b_gate[l],
                                gla_g_norm[l], swa_sink[l], ctx_out)
        xl = xl + gt_ml * rmsnorm(y_l @ w_out[l], g_post_mix[l])
        hl = rmsnorm(xl, g_pre_ffn[l]) * (1.0 + sc_fl) + sh_fl
        xl = xl + gt_fl * rmsnorm(conv_ffn(hl, ffn_w_up[l], ffn_conv[l], ffn_w_down[l]), g_post_ffn[l])
        if ctx_out:
            xc = xc + gt_mc * rmsnorm(y_c @ w_out[l], g_post_mix[l])
            hc = rmsnorm(xc, g_pre_ffn[l]) * (1.0 + sc_fc) + sh_fc
            xc = xc + gt_fc * rmsnorm(conv_ffn(hc, ffn_w_up[l], ffn_conv[l], ffn_w_down[l]), g_post_ffn[l])
    return xl
```

```cpp
#include <hip/hip_runtime.h>
#include <hip/hip_cooperative_groups.h>
#include <cstdio>
namespace cg = cooperative_groups;

#ifndef MULTI_LAUNCH
#define MULTI_LAUNCH 0
#endif

typedef unsigned short bf16_t;
typedef short bf16x8 __attribute__((ext_vector_type(8)));
typedef short bf16x4 __attribute__((ext_vector_type(4)));
typedef float f32x4 __attribute__((ext_vector_type(4)));
#define MFMA16(a, b, c) __builtin_amdgcn_mfma_f32_16x16x32_bf16(a, b, c, 0, 0, 0)
#define WAVE_LDS_SYNC() asm volatile("s_waitcnt lgkmcnt(0)" ::: "memory")

constexpr int DM = 1024, NBATCH = 16, SEQ = 2048, CL = 256, SL = 2304, NT = NBATCH * SL, DEPTH = 4;
constexpr int DIN = 2592, PSTR = 2688, DFF = 2816, DUP = 5632, HALF_T = NT / 2;
constexpr int OFF_A = 0, OFF_NAQ = 256, OFF_NAK = 512, OFF_NAV = 768, OFF_GQ = 1024, OFF_GK = 1280, OFF_GV = 1536,
              OFF_GF = 1792, OFF_GB = 1808, OFF_GR = 1824, OFF_SQ = 2080, OFF_SK = 2336, OFF_SV = 2464;
constexpr float EPS = 1e-6f;
constexpr float NEG = -1e30f;

constexpr size_t WS_XC = 0;
constexpr size_t WS_WIN = WS_XC + (size_t)NBATCH * CL * DM * 4;
constexpr size_t WS_WOUT = WS_WIN + (size_t)DEPTH * PSTR * DM * 2;
constexpr size_t WS_WUP = WS_WOUT + (size_t)DEPTH * DM * DM * 2;
constexpr size_t WS_WDOWN = WS_WUP + (size_t)DEPTH * DUP * DM * 2;
constexpr size_t WS_WGLU = WS_WDOWN + (size_t)DEPTH * DM * DFF * 2;
constexpr size_t WS_SC = WS_WGLU + (size_t)DEPTH * 256 * 256 * 2;
constexpr size_t WS_MOD = WS_SC + (size_t)17 * 1024 * 4;
constexpr size_t WS_CNT = WS_MOD + (size_t)DEPTH * 17 * 6144 * 4;
constexpr size_t WS_BIG = WS_CNT + 1024;
constexpr size_t B_P = 0;
constexpr size_t B_YM = B_P + (size_t)NT * PSTR * 2;
constexpr size_t B_VTN = B_YM + (size_t)NT * DM * 2;
constexpr size_t B_VTS = B_VTN + (size_t)NBATCH * 4 * 64 * SL * 2;
constexpr size_t B_YS = B_VTS + (size_t)NBATCH * 2 * 64 * SL * 2;
constexpr size_t B_OG = B_YS + (size_t)2 * NT * 256 * 2;
constexpr size_t B_END = B_OG + (size_t)2 * NT * 256 * 2;
constexpr size_t B_T = 0;
constexpr size_t B_G = B_T + (size_t)NT * DM * 2;
constexpr size_t B_V = B_G + (size_t)HALF_T * DFF * 2;
constexpr size_t B_HFFN = B_V + (size_t)HALF_T * DFF * 2;
constexpr size_t B_HMIX = B_YM;
static_assert(B_HFFN + (size_t)NT * DM * 2 <= B_END, "ws overlay");
static_assert(B_V + (size_t)HALF_T * DFF * 2 <= B_HFFN, "ws overlay2");
constexpr size_t WS_TOTAL = WS_BIG + B_END;

constexpr int SMEM_BYTES = 57344;
constexpr int NPRE = 3, NPL = 13, NPHASE = NPRE + DEPTH * NPL;

struct Params {
    const float *x, *c, *ctx, *c_ctx, *w_mod, *b_mod, *g_pre_mix, *g_post_mix, *g_pre_ffn, *g_post_ffn, *w_in, *w_out;
    const float *s5_lam_re, *s5_lam_im, *s5_b_re, *s5_b_im, *s5_c_re, *s5_c_im, *s5_log_step, *s5_d, *s5_w_glu;
    const float *na_rpb, *gla_w_gate2, *gla_b_gate, *gla_g_norm, *swa_sink, *ffn_w_up, *ffn_conv, *ffn_w_down;
    float* out;
    unsigned char* ws;
    int phase_lo, phase_hi;
};

__device__ __forceinline__ float bf2f(bf16_t h) { return __uint_as_float(((unsigned)h) << 16); }
__device__ __forceinline__ bf16_t f2bf(float f) {
    unsigned u = __float_as_uint(f);
    u += 0x7fffu + ((u >> 16) & 1u);
    return (bf16_t)(u >> 16);
}
__device__ __forceinline__ float sigmoidf_(float x) { return 1.f / (1.f + __expf(-x)); }
__device__ __forceinline__ float siluf_(float x) { return x / (1.f + __expf(-x)); }
__device__ __forceinline__ float gelu_tanh(float x) {
    float u = 1.5957691216f * (x + 0.044715f * x * x * x);
    return x / (1.f + __expf(-u));
}
__device__ __forceinline__ float wave_sum(float v) {
#pragma unroll
    for (int o = 32; o >= 1; o >>= 1) v += __shfl_xor(v, o);
    return v;
}
__device__ __forceinline__ bf16x4 pack4(float a, float b, float c, float d) {
    bf16x4 r;
    r[0] = (short)f2bf(a); r[1] = (short)f2bf(b); r[2] = (short)f2bf(c); r[3] = (short)f2bf(d);
    return r;
}
__device__ __forceinline__ int s_of(int dir, int i) { return dir == 0 ? i : (i < CL ? (CL - 1 - i) : (SL + CL - 1 - i)); }
__device__ __forceinline__ int clampi(int v, int lo, int hi) { return v < lo ? lo : (v > hi ? hi : v); }

__device__ __forceinline__ int opaque_tid() { int t = threadIdx.x; asm volatile("" : "+v"(t)); return t; }
__device__ __forceinline__ int opaque_bid() { int b = blockIdx.x; asm volatile("" : "+s"(b)); return b; }

__device__ __forceinline__ void phase_pre0(const Params& p, unsigned char* smem) {
    float(*tile)[65] = (float(*)[65])smem;
    const int tid = opaque_tid();
    constexpr int T_IN = 16 * 42, T_OUT = 16 * 16, T_UP = 16 * 88, T_DOWN = 44 * 16, T_GLU = 4 * 4;
    constexpr int T_L = T_IN + T_OUT + T_UP + T_DOWN + T_GLU;
    float* SC = (float*)(p.ws + WS_SC);
    unsigned* cnt = (unsigned*)(p.ws + WS_CNT);
    for (int task = opaque_bid(); task < DEPTH * T_L + 1; task += gridDim.x) {
        if (task == DEPTH * T_L) {
            for (int i = tid; i < 17 * 1024; i += 256) {
                float v = (i < 16 * 1024) ? p.c[i] : p.c_ctx[i - 16 * 1024];
                SC[i] = siluf_(v);
            }
            if (tid < 64) cnt[tid] = 0u;
            continue;
        }
        const int l = task / T_L;
        int r = task % T_L;
        const float* src; bf16_t* dst; int K, N, nkt;
        if (r < T_IN) { src = p.w_in + (size_t)l * DM * DIN; dst = (bf16_t*)(p.ws + WS_WIN) + (size_t)l * PSTR * DM; K = DM; N = DIN; nkt = 16; }
        else if ((r -= T_IN) < T_OUT) { src = p.w_out + (size_t)l * DM * DM; dst = (bf16_t*)(p.ws + WS_WOUT) + (size_t)l * DM * DM; K = DM; N = DM; nkt = 16; }
        else if ((r -= T_OUT) < T_UP) { src = p.ffn_w_up + (size_t)l * DM * DUP; dst = (bf16_t*)(p.ws + WS_WUP) + (size_t)l * DUP * DM; K = DM; N = DUP; nkt = 16; }
        else if ((r -= T_UP) < T_DOWN) { src = p.ffn_w_down + (size_t)l * DFF * DM; dst = (bf16_t*)(p.ws + WS_WDOWN) + (size_t)l * DM * DFF; K = DFF; N = DM; nkt = 44; }
        else { r -= T_DOWN; src = p.s5_w_glu + (size_t)l * 256 * 256; dst = (bf16_t*)(p.ws + WS_WGLU) + (size_t)l * 256 * 256; K = 256; N = 256; nkt = 4; }
        const int kt = r % nkt, nt = r / nkt, k0 = kt * 64, n0 = nt * 64;
        const int tx = tid & 63, ty = tid >> 6;
#pragma unroll
        for (int i = 0; i < 16; ++i) {
            const int k = ty + 4 * i, n = n0 + tx;
            tile[k][tx] = (n < N) ? src[(size_t)(k0 + k) * N + n] : 0.f;
        }
        __syncthreads();
#pragma unroll
        for (int i = 0; i < 16; ++i) {
            const int n = ty + 4 * i;
            dst[(size_t)(n0 + n) * K + k0 + tx] = f2bf(tile[tx][n]);
        }
        __syncthreads();
    }
}

__device__ __forceinline__ void phase_mod(const Params& p, unsigned char* smem) {
    float* red = (float*)smem;
    const int tid = opaque_tid(), lane = tid & 63;
    const int w = __builtin_amdgcn_readfirstlane(tid >> 6);
    const float* SC = (const float*)(p.ws + WS_SC);
    float* MOD = (float*)(p.ws + WS_MOD);
    for (int task = opaque_bid(); task < DEPTH * 96; task += gridDim.x) {
        const int l = task / 96, j0 = (task % 96) * 64;
        const float* W = p.w_mod + (size_t)l * DM * 6144 + j0 + lane;
        float acc[17];
#pragma unroll
        for (int r = 0; r < 17; ++r) acc[r] = 0.f;
        for (int k = w * 256; k < w * 256 + 256; ++k) {
            const float wv = W[(size_t)k * 6144];
#pragma unroll
            for (int r = 0; r < 17; ++r) acc[r] += SC[r * 1024 + k] * wv;
        }
#pragma unroll
        for (int r = 0; r < 17; ++r) red[(w * 17 + r) * 64 + lane] = acc[r];
        __syncthreads();
        for (int i = tid; i < 17 * 64; i += 256) {
            const int r = i >> 6, jj = i & 63;
            float s = red[(0 * 17 + r) * 64 + jj] + red[(1 * 17 + r) * 64 + jj] + red[(2 * 17 + r) * 64 + jj] + red[(3 * 17 + r) * 64 + jj];
            MOD[((size_t)(l * 17 + r)) * 6144 + j0 + jj] = s + p.b_mod[l * 6144 + j0 + jj];
        }
        __syncthreads();
    }
}

__device__ __forceinline__ void phase_rowwise(const Params& p, int mode, int l) {
    const int lane = opaque_tid() & 63;
    const int gw = opaque_bid() * 4 + (opaque_tid() >> 6), nw = gridDim.x * 4;
    const float* MOD = (const float*)(p.ws + WS_MOD);
    float* Xc = (float*)(p.ws + WS_XC);
    unsigned char* big = p.ws + WS_BIG;
    const bf16_t* T = (const bf16_t*)(big + B_T);
    bf16_t* Hdst = (bf16_t*)(big + (mode == 1 ? B_HFFN : B_HMIX));
    const bool in_from_input = (l == 0 && mode != 2);
    for (int t = gw; t < NT; t += nw) {
        const int b = t / SL, s = t - b * SL;
        const bool isctx = s < CL;
        if (l == DEPTH - 1 && isctx && mode != 0) continue;
        const int modrow = isctx ? 16 : b;
        const float* xin; float* xout;
        if (isctx) { xin = (in_from_input ? p.ctx : Xc) + (size_t)(b * CL + s) * DM; xout = Xc + (size_t)(b * CL + s) * DM; }
        else { xin = (in_from_input ? p.x : p.out) + (size_t)(b * SEQ + s - CL) * DM; xout = p.out + (size_t)(b * SEQ + s - CL) * DM; }
        const float* mr = MOD + (size_t)(l * 17 + modrow) * 6144;
        float xv[16];
#pragma unroll
        for (int i = 0; i < 4; ++i) {
            const float4 v = *(const float4*)(xin + i * 256 + lane * 4);
            xv[4 * i] = v.x; xv[4 * i + 1] = v.y; xv[4 * i + 2] = v.z; xv[4 * i + 3] = v.w;
        }
        if (mode != 0) {
            const bf16_t* tr = T + (size_t)t * DM;
            float rv[16]; float ss = 0.f;
#pragma unroll
            for (int i = 0; i < 4; ++i) {
                const bf16x4 v = *(const bf16x4*)(tr + i * 256 + lane * 4);
#pragma unroll
                for (int k = 0; k < 4; ++k) { rv[4 * i + k] = bf2f((bf16_t)v[k]); ss += rv[4 * i + k] * rv[4 * i + k]; }
            }
            ss = wave_sum(ss);
            const float rstd = rsqrtf(ss * (1.f / DM) + EPS);
            const float* gpost = (mode == 1 ? p.g_post_mix : p.g_post_ffn) + l * DM;
            const float* gate = mr + (mode == 1 ? 2 : 5) * 1024;
#pragma unroll
            for (int i = 0; i < 4; ++i) {
                const int c = i * 256 + lane * 4;
                const float4 g4 = *(const float4*)(gpost + c);
                const float4 t4 = *(const float4*)(gate + c);
                xv[4 * i] += t4.x * (rv[4 * i] * rstd * g4.x);
                xv[4 * i + 1] += t4.y * (rv[4 * i + 1] * rstd * g4.y);
                xv[4 * i + 2] += t4.z * (rv[4 * i + 2] * rstd * g4.z);
                xv[4 * i + 3] += t4.w * (rv[4 * i + 3] * rstd * g4.w);
                float4 o; o.x = xv[4 * i]; o.y = xv[4 * i + 1]; o.z = xv[4 * i + 2]; o.w = xv[4 * i + 3];
                *(float4*)(xout + c) = o;
            }
        }
        if (mode == 2 && l == DEPTH - 1) continue;
        float ss = 0.f;
#pragma unroll
        for (int k = 0; k < 16; ++k) ss += xv[k] * xv[k];
        ss = wave_sum(ss);
        const float rstd = rsqrtf(ss * (1.f / DM) + EPS);
        const int ln = (mode == 2) ? l + 1 : l;
        const float* g = (mode == 1 ? p.g_pre_ffn : p.g_pre_mix) + ln * DM;
        const float* mrn = MOD + (size_t)(ln * 17 + modrow) * 6144;
        const float* sh = mrn + (mode == 1 ? 3 : 0) * 1024;
        const float* sc = mrn + (mode == 1 ? 4 : 1) * 1024;
#pragma unroll
        for (int i = 0; i < 4; ++i) {
            const int c = i * 256 + lane * 4;
            const float4 g4 = *(const float4*)(g + c);
            const float4 s4 = *(const float4*)(sc + c);
            const float4 h4 = *(const float4*)(sh + c);
            bf16x4 o = pack4(xv[4 * i] * rstd * g4.x * (1.f + s4.x) + h4.x, xv[4 * i + 1] * rstd * g4.y * (1.f + s4.y) + h4.y,
                             xv[4 * i + 2] * rstd * g4.z * (1.f + s4.z) + h4.z, xv[4 * i + 3] * rstd * g4.w * (1.f + s4.w) + h4.w);
            *(bf16x4*)(Hdst + (size_t)t * DM + c) = o;
        }
    }
}

__device__ __forceinline__ void gemm_phase(const bf16_t* __restrict__ A, int lda, const bf16_t* __restrict__ Bt, int K, int nM, int nN, int nsplit,
                           bf16_t* C0, bf16_t* C1, int ldc, bool skipctx, unsigned char* smem) {
    constexpr int BK = 32, HT = 128 * BK;
    bf16_t* SA = (bf16_t*)smem;
    bf16_t* SB = SA + HT;
    const int tid = opaque_tid(), wid = tid >> 6, lane = tid & 63, wr = wid >> 1, wc = wid & 1, fr = lane & 15, fq = lane >> 4;
    const int ntiles = nM * nN, nig = 8 * nN;
    for (int tile = opaque_bid(); tile < ntiles; tile += gridDim.x) {
        const int gid = tile / nig, fm = gid * 8, rem = tile % nig;
        const int gsz = (nM - fm) < 8 ? (nM - fm) : 8;
        const int pm = fm + rem % gsz, pn = rem / gsz;
        if (skipctx && (pm % 18) < 2) continue;
        const int brow = pm * 128, bcol = pn * 128;
        f32x4 acc[4][4];
#pragma unroll
        for (int m = 0; m < 4; ++m)
#pragma unroll
            for (int n = 0; n < 4; ++n) acc[m][n] = (f32x4){0.f, 0.f, 0.f, 0.f};
        for (int t = 0; t < K / BK; ++t) {
#pragma unroll
            for (int i = 0; i < 2; ++i) {
                const int bb = tid * 16 + i * 4096, r = bb / 64, c = (bb % 64) / 2;
                __builtin_amdgcn_global_load_lds((const unsigned*)(A + (size_t)(brow + r) * lda + t * BK + c), (__attribute__((address_space(3))) unsigned*)((char*)SA + bb), 16, 0, 0);
                __builtin_amdgcn_global_load_lds((const unsigned*)(Bt + (size_t)(bcol + r) * K + t * BK + c), (__attribute__((address_space(3))) unsigned*)((char*)SB + bb), 16, 0, 0);
            }
            asm volatile("s_waitcnt vmcnt(0)" ::: "memory");
            __syncthreads();
            bf16x8 At[4], Bl[4];
#pragma unroll
            for (int m = 0; m < 4; ++m) At[m] = *(const bf16x8*)((const char*)SA + (wr * 64 + m * 16 + fr) * BK * 2 + fq * 16);
#pragma unroll
            for (int n = 0; n < 4; ++n) Bl[n] = *(const bf16x8*)((const char*)SB + (wc * 64 + n * 16 + fr) * BK * 2 + fq * 16);
#pragma unroll
            for (int m = 0; m < 4; ++m)
#pragma unroll
                for (int n = 0; n < 4; ++n) acc[m][n] = MFMA16(Bl[n], At[m], acc[m][n]);
            __syncthreads();
        }
        bf16_t* Cb = (pn < nsplit) ? C0 : C1;
        const int ccol0 = ((pn < nsplit) ? pn : pn - nsplit) * 128;
#pragma unroll
        for (int m = 0; m < 4; ++m) {
            bf16_t* rowp = Cb + (size_t)(brow + wr * 64 + m * 16 + fr) * ldc + ccol0 + wc * 64 + fq * 4;
#pragma unroll
            for (int n = 0; n < 4; ++n) *(bf16x4*)(rowp + n * 16) = pack4(acc[m][n][0], acc[m][n][1], acc[m][n][2], acc[m][n][3]);
        }
    }
}

__device__ __forceinline__ void phase_prep(const Params& p) {
    const int lane = opaque_tid() & 63;
    const int gw = opaque_bid() * 4 + (opaque_tid() >> 6), nw = gridDim.x * 4;
    unsigned char* big = p.ws + WS_BIG;
    bf16_t* P = (bf16_t*)(big + B_P);
    bf16_t* VTN = (bf16_t*)(big + B_VTN);
    bf16_t* VTS = (bf16_t*)(big + B_VTS);
    constexpr int N_ROPE = NBATCH * SEQ, N_VT = NBATCH * 6 * (SL / 8);
    for (int task = gw; task < N_ROPE + N_VT; task += nw) {
        if (task < N_ROPE) {
            const int b = task / SEQ, pos = task % SEQ;
            bf16_t* pr = P + (size_t)(b * SL + CL + pos) * PSTR;
            const int row = pos >> 6, col = pos & 63;
#pragma unroll
            for (int e0 = 0; e0 < 192; e0 += 64) {
                const int e = e0 + lane;
                const int head = e >> 5, pair = e & 31, half = pair >> 4, i = pair & 15;
                const int base = (head < 4) ? (OFF_SQ + head * 64) : (OFF_SK + (head - 4) * 64);
                const int i1 = base + half * 32 + i, i2 = i1 + 16;
                const float inv_freq = exp2f(-(float)i * (13.287712379549449f / 16.f));
                const float ang = (float)(half ? col : row) * inv_freq;
                float sn, cs; sincosf(ang, &sn, &cs);
                const float t1 = bf2f(pr[i1]), t2 = bf2f(pr[i2]);
                pr[i1] = f2bf(t1 * cs - t2 * sn);
                pr[i2] = f2bf(t1 * sn + t2 * cs);
            }
        } else {
            const int r = task - N_ROPE;
            const int grp = r % (SL / 8), slot = (r / (SL / 8)) % 6, b = r / (6 * (SL / 8));
            const int s0 = grp * 8;
            const int col = (slot < 4) ? (OFF_NAV + slot * 64) : (OFF_SV + (slot - 4) * 64);
            const bf16_t* src = P + (size_t)(b * SL + s0) * PSTR + col + lane;
            bf16x8 v;
#pragma unroll
            for (int k = 0; k < 8; ++k) v[k] = (short)src[(size_t)k * PSTR];
            bf16_t* dst = (slot < 4) ? (VTN + ((size_t)(b * 4 + slot) * 64 + lane) * SL + s0) : (VTS + ((size_t)(b * 2 + slot - 4) * 64 + lane) * SL + s0);
            *(bf16x8*)dst = v;
        }
    }
}

template <class F>
__device__ __forceinline__ void attn_block(const bf16_t* Kb, const bf16_t* Vtb, const bf16x8 (&qB)[2], f32x4 (&o)[4], float& m, float& l,
                                           int fr, int fq, F fix) {
    f32x4 s[2];
#pragma unroll
    for (int t = 0; t < 2; ++t) {
        const bf16_t* kr = Kb + (size_t)(t * 16 + fr) * PSTR + fq * 8;
        const bf16x8 k0 = *(const bf16x8*)kr;
        const bf16x8 k1 = *(const bf16x8*)(kr + 32);
        s[t] = MFMA16(k0, qB[0], ((f32x4){0.f, 0.f, 0.f, 0.f}));
        s[t] = MFMA16(k1, qB[1], s[t]);
    }
    float bm = NEG;
#pragma unroll
    for (int t = 0; t < 2; ++t)
#pragma unroll
        for (int j = 0; j < 4; ++j) {
            const float v = fix(t * 16 + fq * 4 + j, s[t][j] * 0.125f);
            s[t][j] = v;
            bm = fmaxf(bm, v);
        }
    bm = fmaxf(bm, __shfl_xor(bm, 16));
    bm = fmaxf(bm, __shfl_xor(bm, 32));
    const float mn = fmaxf(m, bm);
    const float alpha = __expf(m - mn);
    m = mn;
    float ps = 0.f;
    bf16x8 pB;
#pragma unroll
    for (int t = 0; t < 2; ++t)
#pragma unroll
        for (int j = 0; j < 4; ++j) {
            const float pv = __expf(s[t][j] - mn);
            ps += pv;
            pB[t * 4 + j] = (short)f2bf(pv);
        }
    l = l * alpha + ps;
#pragma unroll
    for (int dt = 0; dt < 4; ++dt) {
        o[dt] *= alpha;
        const bf16_t* vr = Vtb + (size_t)(dt * 16 + fr) * SL + fq * 4;
        const bf16x4 v0 = *(const bf16x4*)vr;
        const bf16x4 v1 = *(const bf16x4*)(vr + 16);
        bf16x8 vA;
        vA[0] = v0[0]; vA[1] = v0[1]; vA[2] = v0[2]; vA[3] = v0[3]; vA[4] = v1[0]; vA[5] = v1[1]; vA[6] = v1[2]; vA[7] = v1[3];
        o[dt] = MFMA16(vA, pB, o[dt]);
    }
}

__device__ __forceinline__ void attn_finish(f32x4 (&o)[4], float l, float extra, bf16_t* dst  , int fq) {
    float lt = l + __shfl_xor(l, 16);
    lt += __shfl_xor(lt, 32);
    lt += extra;
    const float inv = 1.f / lt;
#pragma unroll
    for (int dt = 0; dt < 4; ++dt)
        *(bf16x4*)(dst + dt * 16 + fq * 4) = pack4(o[dt][0] * inv, o[dt][1] * inv, o[dt][2] * inv, o[dt][3] * inv);
}

struct FixNone { __device__ __forceinline__ float operator()(int, float v) const { return v; } };

__device__ __forceinline__ void attn_task(const Params& p, int l, int kind, int b, int a, int c, int h, int lane) {
    const int fr = lane & 15, fq = lane >> 4;
    unsigned char* big = p.ws + WS_BIG;
    const bf16_t* Pb = (const bf16_t*)(big + B_P) + (size_t)b * SL * PSTR;
    bf16_t* YM = (bf16_t*)(big + B_YM) + (size_t)b * SL * DM;
    const bool isna = (kind == 0 || kind == 2);
    const int kvh = isna ? h : (h >> 1);
    const bf16_t* Kbase = Pb + (isna ? OFF_NAK : OFF_SK) + kvh * 64;
    const bf16_t* Vbase = isna ? ((const bf16_t*)(big + B_VTN) + (size_t)(b * 4 + kvh) * 64 * SL)
                               : ((const bf16_t*)(big + B_VTS) + (size_t)(b * 2 + kvh) * 64 * SL);
    int qtok;
    if (kind == 0) qtok = CL + a * 64 + c * 16 + fr;
    else if (kind == 1) qtok = CL + a * 16 + fr;
    else qtok = a * 16 + fr;
    const bf16_t* qp = Pb + (size_t)qtok * PSTR + (isna ? OFF_NAQ : OFF_SQ) + h * 64 + fq * 8;
    bf16x8 qB[2];
    qB[0] = *(const bf16x8*)qp;
    qB[1] = *(const bf16x8*)(qp + 32);
    f32x4 o[4];
#pragma unroll
    for (int dt = 0; dt < 4; ++dt) o[dt] = (f32x4){0.f, 0.f, 0.f, 0.f};
    float m = NEG, lsum = 0.f;
    for (int cb = 0; cb < 8; ++cb) attn_block(Kbase + (size_t)cb * 32 * PSTR, Vbase + cb * 32, qB, o, m, lsum, fr, fq, FixNone());
    if (kind == 0) {
        const int r = a, n = c;
        const int row0 = clampi(r - 4, 0, 24), col0 = clampi(16 * n - 8, 0, 32);
        const int qcol = 16 * n + fr, ws = clampi(qcol - 8, 0, 48);
        for (int rr = 0; rr < 8; ++rr) {
            const int krow = row0 + rr, s0 = CL + krow * 64 + col0, dr = krow - r + 7;
            const float* bias = p.na_rpb + ((size_t)(l * 4 + h) * 15 + dr) * 31;
            attn_block(Kbase + (size_t)s0 * PSTR, Vbase + s0, qB, o, m, lsum, fr, fq, [&](int kk, float v) {
                const int kcol = col0 + kk;
                const bool valid = (kcol >= ws) && (kcol < ws + 16);
                const int dc = clampi(kcol - qcol, -15, 15) + 15;
                return valid ? v + bias[dc] : NEG;
            });
        }
    } else if (kind == 1) {
        const int q0 = a * 16, qpos = q0 + fr;
        const int lo = ((q0 - 128 + 1024) & ~31) - 1024;
        for (int kb = 0; kb < 9; ++kb) {
            const int ks = lo + kb * 32;
            if (ks < 0 || ks >= SEQ) continue;
            const int s0 = CL + ks;
            attn_block(Kbase + (size_t)s0 * PSTR, Vbase + s0, qB, o, m, lsum, fr, fq, [&](int kk, float v) {
                const int d = qpos - (ks + kk);
                return (d <= 128 && d >= -128) ? v : NEG;
            });
        }
    }
    float extra = 0.f;
    if (!isna) extra = __expf(p.swa_sink[l * 4 + h] - m);
    attn_finish(o, lsum, extra, YM + (size_t)qtok * DM + (isna ? 256 : 768) + h * 64, fq);
}

__device__ __forceinline__ void s5_task(const Params& p, int l, int b, int g, int dir, int lane, float* bu  , bf16_t* hb  ) {
    const int fr = lane & 15, fq = lane >> 4;
    unsigned char* big = p.ws + WS_BIG;
    const bf16_t* Pb = (const bf16_t*)(big + B_P) + (size_t)b * SL * PSTR + OFF_A + g * 16;
    bf16_t* YS = (bf16_t*)(big + B_YS) + ((size_t)dir * NT + (size_t)b * SL) * 256 + g * 16;
    const int base = (l * 2 + dir) * 16 + g;
    const float step = expf(p.s5_log_step[base]);
    float lbr, lbi;
    {
        const float lre = p.s5_lam_re[base * 64 + lane], lim = p.s5_lam_im[base * 64 + lane];
        const float er = expf(lre * step);
        float sn, cs; sincosf(lim * step, &sn, &cs);
        lbr = er * cs; lbi = er * sn;
    }
    bf16x8 Bop[8];
#pragma unroll
    for (int q = 0; q < 4; ++q) {
        const int pp = q * 16 + fr;
        const float lre = p.s5_lam_re[base * 64 + pp], lim = p.s5_lam_im[base * 64 + pp];
        const float er = expf(lre * step);
        float sn, cs; sincosf(lim * step, &sn, &cs);
        const float nr = er * cs - 1.f, ni = er * sn;
        const float den = 1.f / (lre * lre + lim * lim);
        const float cr = (nr * lre + ni * lim) * den, ci = (ni * lre - nr * lim) * den;
        bf16x8 vr, vi;
#pragma unroll
        for (int jj = 0; jj < 8; ++jj) {
            float br = 0.f, bi = 0.f;
            if (fq < 2) {
                const size_t idx = ((size_t)base * 64 + pp) * 16 + fq * 8 + jj;
                br = p.s5_b_re[idx]; bi = p.s5_b_im[idx];
            }
            vr[jj] = (short)f2bf(cr * br - ci * bi);
            vi[jj] = (short)f2bf(cr * bi + ci * br);
        }
        Bop[q] = vr; Bop[q + 4] = vi;
    }
    bf16x8 Cop[4];
#pragma unroll
    for (int ks = 0; ks < 4; ++ks) {
        bf16x8 v;
#pragma unroll
        for (int jj = 0; jj < 8; ++jj) {
            const int k = ks * 32 + fq * 8 + jj;
            const size_t idx = ((size_t)base * 16 + fr) * 64 + (k & 63);
            v[jj] = (short)f2bf(k < 64 ? p.s5_c_re[idx] : -p.s5_c_im[idx]);
        }
        Cop[ks] = v;
    }
    const bf16x8 zero8 = (bf16x8){0, 0, 0, 0, 0, 0, 0, 0};
    float hr = 0.f, hi = 0.f;
    bf16x8 uN = zero8;
    if (fq < 2) uN = *(const bf16x8*)(Pb + (size_t)s_of(dir, fr) * PSTR + fq * 8);
    for (int blk = 0; blk < SL / 16; ++blk) {
        const int i0 = blk * 16;
        const bf16x8 uA = uN;
        if (blk + 1 < SL / 16 && fq < 2) uN = *(const bf16x8*)(Pb + (size_t)s_of(dir, i0 + 16 + fr) * PSTR + fq * 8);
#pragma unroll
        for (int nt = 0; nt < 8; ++nt) {
            const f32x4 acc = MFMA16(uA, Bop[nt], ((f32x4){0.f, 0.f, 0.f, 0.f}));
#pragma unroll
            for (int j = 0; j < 4; ++j) bu[(fq * 4 + j) * 132 + nt * 16 + fr] = acc[j];
        }
        WAVE_LDS_SYNC();
#pragma unroll
        for (int t = 0; t < 16; ++t) {
            const float br = bu[t * 132 + lane], bi = bu[t * 132 + 64 + lane];
            const float nr = lbr * hr - lbi * hi + br;
            const float ni = lbr * hi + lbi * hr + bi;
            hr = nr; hi = ni;
            hb[t * 136 + lane] = f2bf(hr);
            hb[t * 136 + 64 + lane] = f2bf(hi);
        }
        WAVE_LDS_SYNC();
        f32x4 y = (f32x4){0.f, 0.f, 0.f, 0.f};
#pragma unroll
        for (int ks = 0; ks < 4; ++ks) {
            const bf16x8 hA = *(const bf16x8*)(hb + fr * 136 + ks * 32 + fq * 8);
            y = MFMA16(hA, Cop[ks], y);
        }
#pragma unroll
        for (int j = 0; j < 4; ++j) YS[(size_t)s_of(dir, i0 + fq * 4 + j) * 256 + fr] = f2bf(y[j]);
        WAVE_LDS_SYNC();
    }
}

__device__ __forceinline__ void gla_task(const Params& p, int l, int b, int h, int dir, unsigned char* smem) {
    constexpr int LS = 72;
    bf16_t* Qd = (bf16_t*)smem;
    bf16_t* Kd = Qd + 64 * LS;
    bf16_t* KeT = Kd + 64 * LS;
    bf16_t* Vt = KeT + 64 * LS;
    bf16_t* Am = Vt + 64 * LS;
    bf16_t* St = Am + 64 * LS;
    float* segsum = (float*)(St + 64 * LS);
    float* decay = segsum + 256;
    const int tid = opaque_tid(), lane = tid & 63, w = tid >> 6, fr = lane & 15, fq = lane >> 4;
    const int d = lane, iq = w;
    unsigned char* big = p.ws + WS_BIG;
    const bf16_t* Pb = (const bf16_t*)(big + B_P) + (size_t)b * SL * PSTR;
    bf16_t* OG = (bf16_t*)(big + B_OG) + ((size_t)dir * NT + (size_t)b * SL) * 256 + h * 64;
    for (int i = tid; i < 64 * LS; i += 256) St[i] = 0;
    f32x4 Sacc[4];
#pragma unroll
    for (int k = 0; k < 4; ++k) Sacc[k] = (f32x4){0.f, 0.f, 0.f, 0.f};
    float wg[16];
    {
        const float* Wg = p.gla_w_gate2 + (size_t)((l * 2 + dir) * 16) * 256 + h * 64 + d;
#pragma unroll
        for (int r = 0; r < 16; ++r) wg[r] = Wg[r * 256];
    }
    const float bgv = p.gla_b_gate[(l * 2 + dir) * 256 + h * 64 + d];
    const int gcol = dir == 0 ? OFF_GF : OFF_GB;
    __syncthreads();
    for (int n = 0; n < SL / 64; ++n) {
        float bcum[16];
        float run = 0.f;
#pragma unroll
        for (int ii = 0; ii < 16; ++ii) {
            const int s = s_of(dir, n * 64 + iq * 16 + ii);
            const bf16_t* pr = Pb + (size_t)s * PSTR + gcol;
            const bf16x8 g0 = *(const bf16x8*)pr;
            const bf16x8 g1 = *(const bf16x8*)(pr + 8);
            float z = bgv;
#pragma unroll
            for (int r = 0; r < 8; ++r) z += bf2f((bf16_t)g0[r]) * wg[r];
#pragma unroll
            for (int r = 0; r < 8; ++r) z += bf2f((bf16_t)g1[r]) * wg[8 + r];
            const float ls = fminf(z, 0.f) - __logf(1.f + __expf(-fabsf(z)));
            run += ls * (1.f / 16.f);
            bcum[ii] = run;
        }
        segsum[iq * 64 + d] = run;
        __syncthreads();
        float pre = 0.f, tot = 0.f;
#pragma unroll
        for (int q = 0; q < 4; ++q) {
            const float v = segsum[q * 64 + d];
            tot += v;
            if (q < iq) pre += v;
        }
        bf16x8 ke0, ke1, vv0, vv1;
#pragma unroll
        for (int ii = 0; ii < 16; ++ii) {
            const int il = iq * 16 + ii;
            const int s = s_of(dir, n * 64 + il);
            const bf16_t* pr = Pb + (size_t)s * PSTR + h * 64 + d;
            const float bb = pre + bcum[ii];
            const float q = bf2f(pr[OFF_GQ]), k = bf2f(pr[OFF_GK]);
            const bf16_t v = pr[OFF_GV];
            Qd[il * LS + d] = f2bf(q * 0.125f * __expf(bb));
            Kd[il * LS + d] = f2bf(k * __expf(-bb));
            const bf16_t ke = f2bf(k * __expf(tot - bb));
            if (ii < 8) { ke0[ii] = (short)ke; vv0[ii] = (short)v; } else { ke1[ii - 8] = (short)ke; vv1[ii - 8] = (short)v; }
        }
        *(bf16x8*)(KeT + d * LS + iq * 16) = ke0;
        *(bf16x8*)(KeT + d * LS + iq * 16 + 8) = ke1;
        *(bf16x8*)(Vt + d * LS + iq * 16) = vv0;
        *(bf16x8*)(Vt + d * LS + iq * 16 + 8) = vv1;
        if (iq == 0) decay[d] = __expf(tot);
        __syncthreads();
        bf16x8 qf[2];
        qf[0] = *(const bf16x8*)(Qd + (16 * w + fr) * LS + fq * 8);
        qf[1] = *(const bf16x8*)(Qd + (16 * w + fr) * LS + 32 + fq * 8);
#pragma unroll
        for (int jt = 0; jt < 4; ++jt) {
            f32x4 acc = (f32x4){0.f, 0.f, 0.f, 0.f};
#pragma unroll
            for (int ks = 0; ks < 2; ++ks) {
                const bf16x8 kf = *(const bf16x8*)(Kd + (jt * 16 + fr) * LS + ks * 32 + fq * 8);
                acc = MFMA16(kf, qf[ks], acc);
            }
            const int il = 16 * w + fr, j0 = jt * 16 + fq * 4;
            *(bf16x4*)(Am + il * LS + j0) = pack4(il >= j0 ? acc[0] : 0.f, il >= j0 + 1 ? acc[1] : 0.f, il >= j0 + 2 ? acc[2] : 0.f, il >= j0 + 3 ? acc[3] : 0.f);
        }
        WAVE_LDS_SYNC();
        bf16x8 af[2];
        af[0] = *(const bf16x8*)(Am + (16 * w + fr) * LS + fq * 8);
        af[1] = *(const bf16x8*)(Am + (16 * w + fr) * LS + 32 + fq * 8);
        {
            const int s = s_of(dir, n * 64 + 16 * w + fr);
            bf16_t* orow = OG + (size_t)s * 256;
#pragma unroll
            for (int dvt = 0; dvt < 4; ++dvt) {
                f32x4 acc = (f32x4){0.f, 0.f, 0.f, 0.f};
#pragma unroll
                for (int ks = 0; ks < 2; ++ks) {
                    const bf16x8 vf = *(const bf16x8*)(Vt + (dvt * 16 + fr) * LS + ks * 32 + fq * 8);
                    acc = MFMA16(vf, af[ks], acc);
                    const bf16x8 sf = *(const bf16x8*)(St + (dvt * 16 + fr) * LS + ks * 32 + fq * 8);
                    acc = MFMA16(sf, qf[ks], acc);
                }
                *(bf16x4*)(orow + dvt * 16 + fq * 4) = pack4(acc[0], acc[1], acc[2], acc[3]);
            }
        }
        __syncthreads();
        bf16x8 vb[2];
        vb[0] = *(const bf16x8*)(Vt + (16 * w + fr) * LS + fq * 8);
        vb[1] = *(const bf16x8*)(Vt + (16 * w + fr) * LS + 32 + fq * 8);
#pragma unroll
        for (int dkt = 0; dkt < 4; ++dkt) {
            const f32x4 dec = *(const f32x4*)(decay + dkt * 16 + fq * 4);
            Sacc[dkt] *= dec;
#pragma unroll
            for (int ks = 0; ks < 2; ++ks) {
                const bf16x8 kf = *(const bf16x8*)(KeT + (dkt * 16 + fr) * LS + ks * 32 + fq * 8);
                Sacc[dkt] = MFMA16(kf, vb[ks], Sacc[dkt]);
            }
            *(bf16x4*)(St + (16 * w + fr) * LS + dkt * 16 + fq * 4) = pack4(Sacc[dkt][0], Sacc[dkt][1], Sacc[dkt][2], Sacc[dkt][3]);
        }
    }
    __syncthreads();
}

__device__ __forceinline__ int next_task(unsigned* cnt, int* s_task) {
    __syncthreads();
    if (opaque_tid() == 0) *s_task = (int)atomicAdd(cnt, 1u);
    __syncthreads();
    return *s_task;
}
__device__ __forceinline__ void phase_mix(const Params& p, int l, unsigned char* smem) {
    __shared__ int s_task;
    const int tid = opaque_tid(), lane = tid & 63, w = tid >> 6;
    const bool ctx_out = l < DEPTH - 1;
    unsigned* cnt = (unsigned*)(p.ws + WS_CNT) + l * 4;
    while (true) {
        const int task = next_task(cnt + 0, &s_task);
        if (task >= 128) break;
        gla_task(p, l, task >> 3, (task >> 1) & 3, task & 1, smem);
    }
    while (true) {
        const int task = next_task(cnt + 1, &s_task);
        if (task >= 128) break;
        const int wt = task * 4 + w;
        float* bu = (float*)(smem + w * 12800);
        bf16_t* hb = (bf16_t*)(smem + w * 12800 + 8448);
        s5_task(p, l, wt >> 5, (wt >> 1) & 15, wt & 1, lane, bu, hb);
    }
    const int ntask = ctx_out ? 4608 : 4096;
    while (true) {
        const int task = next_task(cnt + 2, &s_task);
        if (task >= ntask) break;
        int kind, b, a, c = 0;
        if (task < 2048) { kind = 0; b = task >> 7; a = (task >> 2) & 31; c = task & 3; }
        else if (task < 4096) { const int bt = task - 2048; kind = 1; b = bt >> 7; a = bt & 127; }
        else { const int bt = task - 4096; kind = 2 + (bt >> 8); b = (bt & 255) >> 4; a = bt & 15; }
        attn_task(p, l, kind, b, a, c, w, lane);
    }
}

__device__ __forceinline__ void phase_fin(const Params& p, int l, unsigned char* smem) {
    const int tid = opaque_tid(), lane = tid & 63, w = tid >> 6, fr = lane & 15, fq = lane >> 4;
    const int gw = opaque_bid() * 4 + w, nw = gridDim.x * 4;
    const bool ctx_out = l < DEPTH - 1;
    unsigned char* big = p.ws + WS_BIG;
    const bf16_t* P = (const bf16_t*)(big + B_P);
    bf16_t* YM = (bf16_t*)(big + B_YM);
    const bf16_t* YS = (const bf16_t*)(big + B_YS);
    const bf16_t* OG = (const bf16_t*)(big + B_OG);
    const bf16_t* WG = (const bf16_t*)(p.ws + WS_WGLU) + (size_t)l * 256 * 256;
    bf16_t* zb = (bf16_t*)(smem + w * 8448);
    constexpr int N_GLU = NT / 16;
    for (int task = gw; task < N_GLU + NT; task += nw) {
        if (task < N_GLU) {
            const int tok0 = task * 16;
            if (!ctx_out && (tok0 % SL) < CL) continue;
            {
                const int tt = lane >> 2, cq = (lane & 3) * 64;
                const size_t tok = (size_t)tok0 + tt;
#pragma unroll
                for (int c8 = 0; c8 < 8; ++c8) {
                    const int c = cq + c8 * 8;
                    const bf16x8 u = *(const bf16x8*)(P + tok * PSTR + OFF_A + c);
                    const bf16x8 yf = *(const bf16x8*)(YS + tok * 256 + c);
                    const bf16x8 yr = *(const bf16x8*)(YS + ((size_t)NT + tok) * 256 + c);
                    const float4 d0 = *(const float4*)(p.s5_d + l * 256 + c);
                    const float4 d1 = *(const float4*)(p.s5_d + l * 256 + c + 4);
                    const float dd[8] = {d0.x, d0.y, d0.z, d0.w, d1.x, d1.y, d1.z, d1.w};
                    bf16x8 z;
#pragma unroll
                    for (int k = 0; k < 8; ++k) {
                        const float y = dd[k] * bf2f((bf16_t)u[k]) + bf2f((bf16_t)yf[k]) + bf2f((bf16_t)yr[k]);
                        z[k] = (short)f2bf(gelu_tanh(y));
                    }
                    *(bf16x8*)(zb + tt * 264 + c) = z;
                }
            }
            WAVE_LDS_SYNC();
            bf16x8 zB[8];
#pragma unroll
            for (int ks = 0; ks < 8; ++ks) zB[ks] = *(const bf16x8*)(zb + fr * 264 + ks * 32 + fq * 8);
            bf16_t* orow = YM + ((size_t)tok0 + fr) * DM;
            for (int nt = 0; nt < 16; ++nt) {
                f32x4 acc = (f32x4){0.f, 0.f, 0.f, 0.f};
#pragma unroll
                for (int ks = 0; ks < 8; ++ks) {
                    const bf16x8 wA = *(const bf16x8*)(WG + (size_t)(nt * 16 + fr) * 256 + ks * 32 + fq * 8);
                    acc = MFMA16(wA, zB[ks], acc);
                }
                const bf16x4 z4 = *(const bf16x4*)(zb + fr * 264 + nt * 16 + fq * 4);
                *(bf16x4*)(orow + nt * 16 + fq * 4) = pack4(bf2f((bf16_t)z4[0]) * sigmoidf_(acc[0]), bf2f((bf16_t)z4[1]) * sigmoidf_(acc[1]),
                                                            bf2f((bf16_t)z4[2]) * sigmoidf_(acc[2]), bf2f((bf16_t)z4[3]) * sigmoidf_(acc[3]));
            }
            WAVE_LDS_SYNC();
        } else {
            const size_t tok = (size_t)(task - N_GLU);
            if (!ctx_out && (int)(tok % SL) < CL) continue;
            const int c = lane * 4;
            const bf16x4 a = *(const bf16x4*)(OG + tok * 256 + c);
            const bf16x4 bq = *(const bf16x4*)(OG + ((size_t)NT + tok) * 256 + c);
            float o[4]; float ss = 0.f;
#pragma unroll
            for (int k = 0; k < 4; ++k) { o[k] = bf2f((bf16_t)a[k]) + bf2f((bf16_t)bq[k]); ss += o[k] * o[k]; }
            ss += __shfl_xor(ss, 1); ss += __shfl_xor(ss, 2); ss += __shfl_xor(ss, 4); ss += __shfl_xor(ss, 8);
            const float rstd = rsqrtf(ss * (1.f / 64.f) + EPS);
            const float4 gn = *(const float4*)(p.gla_g_norm + l * 64 + (c & 63));
            const bf16x4 rr = *(const bf16x4*)(P + tok * PSTR + OFF_GR + c);
            *(bf16x4*)(YM + tok * DM + 512 + c) = pack4(o[0] * rstd * gn.x * siluf_(bf2f((bf16_t)rr[0])), o[1] * rstd * gn.y * siluf_(bf2f((bf16_t)rr[1])),
                                                       o[2] * rstd * gn.z * siluf_(bf2f((bf16_t)rr[2])), o[3] * rstd * gn.w * siluf_(bf2f((bf16_t)rr[3])));
        }
    }
}

__device__ __forceinline__ void phase_conv(const Params& p, int l, int hf) {
    unsigned char* big = p.ws + WS_BIG;
    const bf16_t* G = (const bf16_t*)(big + B_G);
    bf16_t* V = (bf16_t*)(big + B_V);
    const float* cw = p.ffn_conv + (size_t)l * 3 * DFF;
    constexpr int NG = DFF / 8;
    const size_t total = (size_t)HALF_T * NG;
    for (size_t idx = (size_t)opaque_bid() * 256 + opaque_tid(); idx < total; idx += (size_t)gridDim.x * 256) {
        const int tl = (int)(idx / NG), j = (int)(idx % NG) * 8;
        const int t = hf * HALF_T + tl, s = t % SL;
        const bool isctx = s < CL;
        if (l == DEPTH - 1 && isctx) continue;
        const bool hasp = isctx ? (s > 0) : (s > CL);
        const bool hasn = isctx ? (s < CL - 1) : (s < SL - 1);
        const bf16x8 zero8 = (bf16x8){0, 0, 0, 0, 0, 0, 0, 0};
        const bf16x8 gc = *(const bf16x8*)(G + (size_t)tl * DFF + j);
        const bf16x8 gp = hasp ? *(const bf16x8*)(G + (size_t)(tl - 1) * DFF + j) : zero8;
        const bf16x8 gn = hasn ? *(const bf16x8*)(G + (size_t)(tl + 1) * DFF + j) : zero8;
        const bf16x8 vv = *(const bf16x8*)(V + (size_t)tl * DFF + j);
        bf16x8 o;
#pragma unroll
        for (int k = 0; k < 8; ++k) {
            const float gg = cw[j + k] * bf2f((bf16_t)gp[k]) + cw[DFF + j + k] * bf2f((bf16_t)gc[k]) + cw[2 * DFF + j + k] * bf2f((bf16_t)gn[k]);
            o[k] = (short)f2bf(gelu_tanh(gg) * bf2f((bf16_t)vv[k]));
        }
        *(bf16x8*)(V + (size_t)tl * DFF + j) = o;
    }
}

#define LAUNDER(ptr) asm volatile("" : "+s"(ptr))
__device__ __forceinline__ void run_phase(const Params& p0, int ph, unsigned char* smem) {
    Params p = p0;
    LAUNDER(p.ws);
    unsigned char* big = p.ws + WS_BIG;
    if (ph == 0) { phase_pre0(p, smem); return; }
    if (ph == 1) { phase_mod(p, smem); return; }
    const int l = ph < NPRE ? 0 : (ph - NPRE) / NPL, q = ph < NPRE ? -1 : (ph - NPRE) % NPL;
    const bool last = (l == DEPTH - 1);
    if (q == -1 || q == 5 || q == 12) {
        phase_rowwise(p, q == -1 ? 0 : (q == 5 ? 1 : 2), l);
    } else if (q == 1) {
        phase_prep(p);
    } else if (q == 2) {
        phase_mix(p, l, smem);
    } else if (q == 3) {
        phase_fin(p, l, smem);
    } else if (q == 7 || q == 10) {
        phase_conv(p, l, (q == 7) ? 0 : 1);
    } else {
        const bf16_t* A; const bf16_t* Bt; bf16_t* C0; bf16_t* C1 = nullptr; int lda, K, nM, nN, nsplit, ldc; bool skip = last;
        if (q == 0) {
            A = (const bf16_t*)(big + B_HMIX); lda = DM; Bt = (const bf16_t*)(p.ws + WS_WIN) + (size_t)l * PSTR * DM; K = DM; nM = NT / 128; nN = PSTR / 128;
            nsplit = nN; C0 = (bf16_t*)(big + B_P); ldc = PSTR; skip = false;
        } else if (q == 4) {
            A = (const bf16_t*)(big + B_YM); lda = DM; Bt = (const bf16_t*)(p.ws + WS_WOUT) + (size_t)l * DM * DM; K = DM; nM = NT / 128; nN = DM / 128;
            nsplit = nN; C0 = (bf16_t*)(big + B_T); ldc = DM;
        } else if (q == 6 || q == 9) {
            const int hf = (q == 6) ? 0 : 1;
            A = (const bf16_t*)(big + B_HFFN) + (size_t)hf * HALF_T * DM; lda = DM; Bt = (const bf16_t*)(p.ws + WS_WUP) + (size_t)l * DUP * DM; K = DM;
            nM = HALF_T / 128; nN = DUP / 128; nsplit = DFF / 128; C0 = (bf16_t*)(big + B_G); C1 = (bf16_t*)(big + B_V); ldc = DFF;
        } else {
            const int hf = (q == 8) ? 0 : 1;
            A = (const bf16_t*)(big + B_V); lda = DFF; Bt = (const bf16_t*)(p.ws + WS_WDOWN) + (size_t)l * DM * DFF; K = DFF; nM = HALF_T / 128; nN = DM / 128;
            nsplit = nN; C0 = (bf16_t*)(big + B_T) + (size_t)hf * HALF_T * DM; ldc = DM;
        }
        gemm_phase(A, lda, Bt, K, nM, nN, nsplit, C0, C1, ldc, skip, smem);
    }
}

__global__ void __launch_bounds__(256, 2) mega(Params p) {
    __shared__ __attribute__((aligned(16))) unsigned char smem[SMEM_BYTES];
    cg::grid_group grid = cg::this_grid();
    for (int ph = p.phase_lo; ph < p.phase_hi; ++ph) {
        run_phase(p, ph, smem);
        if (ph + 1 < p.phase_hi) grid.sync();
    }
}

extern "C" void kernel_launch(void* const* d_in, const int* in_sizes, int n_in, void* d_out, int out_size, void* d_ws, size_t ws_size,
                              hipStream_t stream) {
    Params p{};
    const float** f = (const float**)&p;
    for (int i = 0; i < 29; ++i) f[i] = (const float*)d_in[i];
    p.out = (float*)d_out;
    p.ws = (unsigned char*)d_ws;
    static int grid_blocks = 0;
    if (!grid_blocks) {
        int dev = 0, cus = 0, per_cu = 0;
        hipGetDevice(&dev);
        hipDeviceGetAttribute(&cus, hipDeviceAttributeMultiprocessorCount, dev);
        hipOccupancyMaxActiveBlocksPerMultiprocessor(&per_cu, mega, 256, 0);
        if (per_cu > 2) per_cu = 2;
        if (per_cu < 1) per_cu = 1;
        grid_blocks = cus * per_cu;
    }
    if (ws_size < WS_TOTAL) fprintf(stderr, "workspace too small: %zu < %zu\n", ws_size, (size_t)WS_TOTAL);
#if MULTI_LAUNCH
    for (int ph = 0; ph < NPHASE; ++ph) {
        p.phase_lo = ph; p.phase_hi = ph + 1;
        hipLaunchKernelGGL(mega, dim3(grid_blocks), dim3(256), 0, stream, p);
    }
#else
    p.phase_lo = 0; p.phase_hi = NPHASE;
    void* args[] = {&p};
    hipError_t e = hipLaunchCooperativeKernel((void*)mega, dim3(grid_blocks), dim3(256), args, 0, stream);
    if (e != hipSuccess) fprintf(stderr, "cooperative launch failed: %s (grid %d)\n", hipGetErrorString(e), grid_blocks);
#endif
}
```

```cpp
#include <hip/hip_runtime.h>
#include <hip/hip_cooperative_groups.h>
#include <cstdio>
namespace cg = cooperative_groups;

__device__ __forceinline__ int pg8_opaque_tid() { int t = threadIdx.x; asm volatile("" : "+v"(t)); return t; }
namespace pg8 {
#define PG8_LAS __attribute__((address_space(3)))
typedef unsigned short bf16_t;
typedef short bf16x8 __attribute__((ext_vector_type(8)));
typedef float f32x4 __attribute__((ext_vector_type(4)));
typedef unsigned u32x4 __attribute__((ext_vector_type(4)));
constexpr int BM = 256, BK = 64, HALF = 128, HTB = HALF * BK * 2  , STAGE_BYTES = 8 * HTB, NXCD = 8, WGM = 8;

__host__ __device__ __forceinline__ int lds_byte(int r, int c) { const int st = (r >> 4) * 2 + (c >> 5), rr = r & 15, cc = c & 31, ob = rr * 64 + cc * 2; return st * 1024 + (ob ^ (((ob >> 9) & 1) << 5)); }
__host__ __device__ __forceinline__ void stage_rc(int b, int& R, int& C) { const int st = b / 1024, sb = b % 1024, swz = sb ^ (((sb >> 9) & 1) << 5); R = (st >> 1) * 16 + swz / 64; C = (st & 1) * 32 + (swz % 64) / 2; }
__host__ __device__ __forceinline__ int perm32(int rho) { const int n = rho >> 4, i = rho & 15; return 8 * (i >> 2) + 4 * n + (i & 3); }

struct Unit { int pm, pn; };
struct Gemm { const bf16_t* A; const bf16_t* Bt; int M, N, K, ld; };

struct StaticOrder {
    int nM, nN, nwg, G, c;
    __host__ __device__ void init(int M, int N, int G_, int c_) { nM = M / BM; nN = N / BM; nwg = nM * nN; G = G_; c = c_; }
    __host__ __device__ bool next(int i, Unit& u) const {
        const long L = (long)i * G + c; if (L >= nwg) return false;
        int wgid = (int)L; { const int q = nwg / NXCD, r = nwg % NXCD, xcd = wgid % NXCD, off = wgid / NXCD; wgid = (xcd < r ? xcd * (q + 1) : r * (q + 1) + (xcd - r) * q) + off; }
        const int nig = WGM * nN, gid = wgid / nig, fm = gid * WGM, gsz = (nM - fm) < WGM ? (nM - fm) : WGM;
        u.pm = fm + ((wgid % nig) % gsz); u.pn = (wgid % nig) / gsz; return true;
    }
    __device__ __forceinline__ void a_ready(const Unit&) const {}
    __device__ __forceinline__ void done(const Unit&) const {}
};
__device__ __forceinline__ unsigned cvt_pk_bf16(float lo, float hi) { unsigned r; asm volatile("v_cvt_pk_bf16_f32 %0, %1, %2" : "=v"(r) : "v"(lo), "v"(hi)); return r; }
template <class Epi, class Sched, bool STAMP = false>
__device__ __forceinline__ void gemm_phase(PG8_LAS unsigned char* lds, const Gemm g, const Sched& S, const Epi& E, unsigned long long* stamps) {
    const int tid = pg8_opaque_tid(), wid = __builtin_amdgcn_readfirstlane(tid >> 6), lane = tid & 63, wr = wid >> 2, wc = wid & 3, fr = lane & 15, fq = lane >> 4;
    const int K = g.K, nt = K / BK, LD = g.ld;
    int ts_lo = 0, ts_hi = 0, nts = 0; const unsigned long long rt_entry = STAMP ? (unsigned long long)wall_clock64() : 0ull;
#define PG8_STAMP() do { if (STAMP && wid == 0 && nts < 64) { const unsigned long long _c = (unsigned long long)clock64(); \
        ts_lo = (lane == nts) ? (int)(unsigned)_c : ts_lo; ts_hi = (lane == nts) ? (int)(unsigned)(_c >> 32) : ts_hi; ++nts; } } while (0)
    PG8_STAMP();
    unsigned voffA[2], voffB[2];
#pragma unroll
    for (int i = 0; i < 2; ++i) { int R, C; stage_rc(tid * 16 + i * 8192, R, C); const int Rb = Epi::PERM ? ((R & ~31) + perm32(R & 31)) : R;
        voffA[i] = (unsigned)(R * LD + C) * 2u; voffB[i] = (unsigned)(Rb * LD + C) * 2u; }
    const size_t kstep = (size_t)(BK * 2);
    const size_t hstep = (size_t)HALF * LD * 2;
    const size_t tstep = 2 * hstep;
    const unsigned ldsw = (unsigned)wid * 1024u;
    const int aoff = lds_byte(wr * 64 + fr, fq * 8), boff = lds_byte(wc * 32 + fr, fq * 8);
#define PG8_SA(b, h) (((b) * 2 + (h)) * HTB)
#define PG8_SB(b, h) ((4 + (b) * 2 + (h)) * HTB)
#define PG8_STAGE(bufoff, gbase, voff) do { _Pragma("unroll") for (int _i = 0; _i < 2; ++_i) \
        __builtin_amdgcn_global_load_lds((const unsigned*)((const char*)(gbase) + (voff)[_i]), (PG8_LAS unsigned*)(lds + (bufoff) + ldsw + _i * 8192), 16, 0, 0); } while (0)
#define PG8_LDA(dst, b, h) do { _Pragma("unroll") for (int m = 0; m < 4; ++m) _Pragma("unroll") for (int k = 0; k < 2; ++k) dst[m][k] = *(const PG8_LAS bf16x8*)(lds + PG8_SA(b, h) + aoff + m * 2048 + k * 1024); } while (0)
#define PG8_LDB(dst, b, h) do { _Pragma("unroll") for (int n = 0; n < 2; ++n) _Pragma("unroll") for (int k = 0; k < 2; ++k) dst[n][k] = *(const PG8_LAS bf16x8*)(lds + PG8_SB(b, h) + boff + n * 2048 + k * 1024); } while (0)
#define PG8_MMA(ai, bj, At, Bt) do { __builtin_amdgcn_s_setprio(1); _Pragma("unroll") for (int m = 0; m < 4; ++m) _Pragma("unroll") for (int n = 0; n < 2; ++n) _Pragma("unroll") for (int k = 0; k < 2; ++k) \
        acc[ai][bj][m][n] = __builtin_amdgcn_mfma_f32_16x16x32_bf16(Bt[n][k], At[m][k], acc[ai][bj][m][n], 0, 0, 0); __builtin_amdgcn_s_setprio(0); } while (0)
#define PG8_WAIT_V(n) asm volatile("s_waitcnt vmcnt(" #n ")" ::: "memory")
#define PG8_WAIT_L(n) asm volatile("s_waitcnt lgkmcnt(" #n ")" ::: "memory")
#define PG8_BAR __builtin_amdgcn_s_barrier()
#define PG8_SCHED __builtin_amdgcn_sched_barrier(0)
    Unit cur, nxt; int ui = 0;
    if (!S.next(0, cur)) return;
    f32x4 acc[2][2][4][2];
#pragma unroll
    for (int a = 0; a < 2; ++a)
#pragma unroll
        for (int b = 0; b < 2; ++b)
#pragma unroll
            for (int m = 0; m < 4; ++m)
#pragma unroll
                for (int n = 0; n < 2; ++n) acc[a][b][m][n] = (f32x4){0.f, 0.f, 0.f, 0.f};
    bf16x8 At[4][2], B0[2][2], B1[2][2];
    const char* cA = (const char*)g.A + (size_t)cur.pm * tstep; const char* cB = (const char*)g.Bt + (size_t)cur.pn * tstep;
    S.a_ready(cur);
    PG8_STAGE(PG8_SB(0, 0), cB, voffB); PG8_STAGE(PG8_SA(0, 0), cA, voffA); PG8_STAGE(PG8_SB(0, 1), cB + hstep, voffB); PG8_STAGE(PG8_SA(0, 1), cA + hstep, voffA);
    if (wr == 1) PG8_BAR;
    PG8_WAIT_V(4); PG8_BAR;
    PG8_STAGE(PG8_SB(1, 0), cB + kstep, voffB); PG8_STAGE(PG8_SA(1, 0), cA + kstep, voffA); PG8_STAGE(PG8_SB(1, 1), cB + hstep + kstep, voffB);
    PG8_WAIT_V(6); PG8_BAR;
    PG8_STAMP();
    for (;;) {
        const bool has_next = S.next(ui + 1, nxt);
        const char* nA = has_next ? (const char*)g.A + (size_t)nxt.pm * tstep : cA; const char* nB = has_next ? (const char*)g.Bt + (size_t)nxt.pn * tstep : cB;
        for (int t = 0; t < nt; t += 2) {
            const bool last = (t == nt - 2);
            const char* a1 = cA + (size_t)(t + 1) * kstep;
            const char* a2 = last ? nA : cA + (size_t)(t + 2) * kstep; const char* b2 = last ? nB : cB + (size_t)(t + 2) * kstep;
            const char* a3 = a2 + kstep; const char* b3 = b2 + kstep;
            if (last && has_next) S.a_ready(nxt);
            PG8_LDB(B0, 0, 0); PG8_SCHED; PG8_LDA(At, 0, 0); PG8_STAGE(PG8_SA(1, 1), a1 + hstep, voffA);
            PG8_WAIT_L(8); PG8_BAR; PG8_WAIT_L(0); PG8_MMA(0, 0, At, B0); PG8_BAR; PG8_SCHED;
            PG8_LDB(B1, 0, 1); PG8_STAGE(PG8_SB(0, 0), b2, voffB);
            PG8_BAR; PG8_WAIT_L(0); PG8_MMA(0, 1, At, B1); PG8_BAR;
            PG8_LDA(At, 0, 1); PG8_STAGE(PG8_SA(0, 0), a2, voffA);
            PG8_BAR; PG8_WAIT_L(0); PG8_MMA(1, 0, At, B0); PG8_BAR; PG8_SCHED;
            PG8_STAGE(PG8_SB(0, 1), b2 + hstep, voffB);
            PG8_WAIT_V(6); PG8_BAR; PG8_MMA(1, 1, At, B1); PG8_BAR;
            PG8_LDB(B0, 1, 0); PG8_SCHED; PG8_LDA(At, 1, 0); PG8_STAGE(PG8_SA(0, 1), a2 + hstep, voffA);
            PG8_WAIT_L(8); PG8_BAR; PG8_WAIT_L(0); PG8_MMA(0, 0, At, B0); PG8_BAR; PG8_SCHED;
            PG8_LDB(B1, 1, 1); PG8_STAGE(PG8_SB(1, 0), b3, voffB);
            PG8_BAR; PG8_WAIT_L(0); PG8_MMA(0, 1, At, B1); PG8_BAR;
            PG8_LDA(At, 1, 1); PG8_STAGE(PG8_SA(1, 0), a3, voffA);
            PG8_BAR; PG8_WAIT_L(0); PG8_MMA(1, 0, At, B0); PG8_BAR; PG8_SCHED;
            PG8_STAGE(PG8_SB(1, 1), b3 + hstep, voffB);
            PG8_WAIT_V(6); PG8_BAR; PG8_MMA(1, 1, At, B1); PG8_BAR;
        }
        PG8_STAMP();
        if constexpr (!Epi::AFTER_DRAIN) { E(acc, cur, wr, wc, fr, fq); S.done(cur); }
        PG8_STAMP();
        if (!has_next) break;
#pragma unroll
        for (int a = 0; a < 2; ++a)
#pragma unroll
            for (int b = 0; b < 2; ++b)
#pragma unroll
                for (int m = 0; m < 4; ++m)
#pragma unroll
                    for (int n = 0; n < 2; ++n) acc[a][b][m][n] = (f32x4){0.f, 0.f, 0.f, 0.f};
        cur = nxt; cA = nA; cB = nB; ++ui;
    }
    PG8_WAIT_V(0);
    if (wr == 0) PG8_BAR;
    PG8_BAR;
    if constexpr (Epi::AFTER_DRAIN) { E.fused(acc, cur, wr, wc, fr, fq, lds, wid, lane); S.done(cur); }
    PG8_STAMP();
    if (STAMP && wid == 0) { stamps[lane] = lane < nts ? (((unsigned long long)(unsigned)ts_hi << 32) | (unsigned)ts_lo) : 0ull;
        if (lane == 62) stamps[62] = rt_entry; if (lane == 63) stamps[63] = (unsigned long long)wall_clock64(); }
#undef PG8_STAMP
#undef PG8_SA
#undef PG8_SB
#undef PG8_STAGE
#undef PG8_LDA
#undef PG8_LDB
#undef PG8_MMA
#undef PG8_WAIT_V
#undef PG8_WAIT_L
#undef PG8_BAR
#undef PG8_SCHED
}
}


#define XB_SPIN_CAP_OVERRIDE 1
#define XB_TMO      128
#define XB_XCNT(j)  (256  + 64 * (j))
#define XB_XSUB(j)  (1280 + 64 * (j))
#define XB_XGEN(j)  (2304 + 64 * (j))
#define XB_TOP      3328
#define XB_TOPGEN   3392
#define XCD_BAR_WORDS 3456
#define XB_SPIN_CAP (1u << 22)
#define LAS __attribute__((address_space(3)))

__device__ __forceinline__ unsigned xb_ld(unsigned* p)              { return __hip_atomic_load(p, __ATOMIC_RELAXED, __HIP_MEMORY_SCOPE_AGENT); }
__device__ __forceinline__ unsigned xb_add(unsigned* p, unsigned v) { return __hip_atomic_fetch_add(p, v, __ATOMIC_RELAXED, __HIP_MEMORY_SCOPE_AGENT); }
__device__ __forceinline__ unsigned xb_xcc_id() { return (unsigned)__builtin_amdgcn_s_getreg((3 << 11) | 20) & 0xFu; }
#define XB_SPIN(cond, bar) do { unsigned _sp = 0; while (cond) { __builtin_amdgcn_s_sleep(1); \
    if ((++_sp & 255u) == 0u) { if (xb_ld(&(bar)[XB_TMO])) break; if (_sp > XB_SPIN_CAP) { atomicAdd(&(bar)[XB_TMO], 1u); break; } } } } while (0)

struct XcdBarrier {
    unsigned* bar; unsigned x;
    volatile LAS unsigned* st;
};

__device__ __forceinline__ XcdBarrier xcd_barrier_post(unsigned* bar, volatile LAS unsigned* st) {
    XcdBarrier b; b.bar = bar; b.x = xb_xcc_id(); b.st = st;
    if (threadIdx.x == 0) (void)xb_add(&bar[XB_XCNT(b.x)], 1u);
    return b;
}
__device__ __forceinline__ void xcd_barrier_complete(unsigned* bar, unsigned x, unsigned& nloc, unsigned& nx) {
    const unsigned G = gridDim.x * gridDim.y * gridDim.z;
    unsigned sum, cnt, mine, sp = 0u;
    for (;;) {
        sum = 0u; cnt = 0u; mine = 0u;
#pragma unroll
        for (unsigned j = 0; j < 16; ++j) { const unsigned c = xb_ld(&bar[XB_XCNT(j)]); sum += c; cnt += (c > 0u) ? 1u : 0u; mine = (j == x) ? c : mine; }
        if (sum == G) break;
        __builtin_amdgcn_s_sleep(1);
        if ((++sp & 255u) == 0u) { if (xb_ld(&bar[XB_TMO])) break; if (sp > XB_SPIN_CAP) { atomicAdd(&bar[XB_TMO], 1u); break; } }
    }
    nloc = mine > 0u ? mine : 1u; nx = cnt > 0u ? cnt : 1u;
}

__device__ __forceinline__ void xcd_barrier(const XcdBarrier& b) {
    asm volatile("s_waitcnt vmcnt(0)" ::: "memory");
    __syncthreads();
    if (threadIdx.x == 0) {
        unsigned* bar = b.bar;
        __builtin_amdgcn_s_waitcnt(0);
        unsigned nloc = b.st[0], nx = b.st[1];
        if (nloc == 0u) { xcd_barrier_complete(bar, b.x, nloc, nx); b.st[0] = nloc; b.st[1] = nx; }
        const unsigned old = xb_add(&bar[XB_XSUB(b.x)], 1u);
        const unsigned gen = old / nloc;
        if (old + 1u == (gen + 1u) * nloc) {
            __builtin_amdgcn_fence(__ATOMIC_RELEASE, "agent");
            asm volatile("s_waitcnt vmcnt(0)" ::: "memory");
            const unsigned og = xb_add(&bar[XB_TOP], 1u);
            const unsigned tg = og / nx;
            if (og + 1u == (tg + 1u) * nx) xb_add(&bar[XB_TOPGEN], 1u);
            else XB_SPIN(xb_ld(&bar[XB_TOPGEN]) == tg, bar);
            __builtin_amdgcn_fence(__ATOMIC_ACQUIRE, "agent");
            xb_add(&bar[XB_XGEN(b.x)], 1u);
            asm volatile("s_waitcnt vmcnt(0)" ::: "memory");
        } else {
            XB_SPIN(xb_ld(&bar[XB_XGEN(b.x)]) == gen, bar);
            __builtin_amdgcn_fence(__ATOMIC_ACQUIRE, "agent");
            asm volatile("s_waitcnt vmcnt(0)" ::: "memory");
        }
    }
    __syncthreads();
}


typedef unsigned short bf16_t;
typedef short bf16x8 __attribute__((ext_vector_type(8)));
typedef short bf16x4 __attribute__((ext_vector_type(4)));
typedef float f32x4 __attribute__((ext_vector_type(4)));
typedef unsigned u32x4 __attribute__((ext_vector_type(4)));
#define MFMA16(a, b, c) __builtin_amdgcn_mfma_f32_16x16x32_bf16(a, b, c, 0, 0, 0)
#define WAVE_LDS_SYNC() asm volatile("s_waitcnt lgkmcnt(0)" ::: "memory")

constexpr int NTH = 512, NW = 8;
constexpr int DM = 1024, NBATCH = 16, SEQ = 2048, CL = 256, SL = 2304, NT = NBATCH * SL, DEPTH = 4;
constexpr int DIN = 2592, PSTR = 2816, DFF = 2816, DUP = 5632, HALF_T = NT / 2;
constexpr int OFF_A = 0, OFF_NAQ = 256, OFF_NAK = 512, OFF_NAV = 768, OFF_GQ = 1024, OFF_GK = 1280, OFF_GV = 1536,
              OFF_GF = 1792, OFF_GB = 1808, OFF_GR = 1824, OFF_SQ = 2080, OFF_SK = 2336, OFF_SV = 2464;
constexpr float EPS = 1e-6f;
constexpr float NEG = -1e30f;

constexpr size_t WS_XC = 0;
constexpr size_t WS_WIN = WS_XC + (size_t)NBATCH * CL * DM * 4;
constexpr size_t WS_WOUT = WS_WIN + (size_t)DEPTH * PSTR * DM * 2;
constexpr size_t WS_WUP = WS_WOUT + (size_t)DEPTH * DM * DM * 2;
constexpr size_t WS_WDOWN = WS_WUP + (size_t)DEPTH * DUP * DM * 2;
constexpr size_t WS_WGLU = WS_WDOWN + (size_t)DEPTH * DM * DFF * 2;
constexpr size_t WS_SC = WS_WGLU + (size_t)DEPTH * 256 * 256 * 2;
constexpr size_t WS_MOD = WS_SC + (size_t)17 * 1024 * 4;
constexpr size_t WS_CNT = WS_MOD + (size_t)DEPTH * 17 * 6144 * 4;
constexpr size_t WS_BAR = WS_CNT + 4096;
constexpr size_t WS_CTL_BYTES = 4096 + (size_t)XCD_BAR_WORDS * 4;
constexpr size_t WS_BIG = (WS_BAR + (size_t)XCD_BAR_WORDS * 4 + 255) / 256 * 256;
constexpr size_t B_P = 0;
constexpr size_t B_YM = B_P + (size_t)NT * PSTR * 2;
constexpr size_t B_VTN = B_YM + (size_t)NT * DM * 2;
constexpr size_t B_VTS = B_VTN + (size_t)NBATCH * 4 * 64 * SL * 2;
constexpr size_t B_YS = B_VTS + (size_t)NBATCH * 2 * 64 * SL * 2;
constexpr size_t B_OG = B_YS + (size_t)2 * NT * 256 * 2;
constexpr size_t B_END = B_OG + (size_t)2 * NT * 256 * 2;
constexpr size_t B_T = 0;
constexpr size_t B_ACT = B_T + (size_t)NT * DM * 2;
constexpr size_t B_HFFN = B_ACT + (size_t)NT * DFF * 2;
constexpr size_t B_GB = B_HFFN + (size_t)NT * DM * 2;
constexpr size_t B_VB = B_GB + (size_t)(NT / 64) * 4 * DFF * 2;
constexpr size_t B_HMIX = B_YM;
constexpr size_t B_PART = B_HFFN;
static_assert(B_VB + (size_t)(NT / 64) * 2 * DFF * 2 <= B_END, "ws overlay");
constexpr size_t WS_TOTAL = WS_BIG + B_END;

constexpr int LDS_MAIN = 139264, LDS_BYTES = LDS_MAIN + 256;
constexpr int LDS_KC = 51200, LDS_VC = LDS_KC + 256 * 144, LDS_RPB = LDS_VC + 64 * 528;
static_assert(LDS_RPB + 8 * 2048 <= LDS_MAIN, "lds map");
constexpr int NPRE = 2, NPL = 10, NPHASE = NPRE + DEPTH * NPL;

struct Params {
    const float *x, *c, *ctx, *c_ctx, *w_mod, *b_mod, *g_pre_mix, *g_post_mix, *g_pre_ffn, *g_post_ffn, *w_in, *w_out;
    const float *s5_lam_re, *s5_lam_im, *s5_b_re, *s5_b_im, *s5_c_re, *s5_c_im, *s5_log_step, *s5_d, *s5_w_glu;
    const float *na_rpb, *gla_w_gate2, *gla_b_gate, *gla_g_norm, *swa_sink, *ffn_w_up, *ffn_conv, *ffn_w_down;
    float* out;
    unsigned char* ws;
    int phase_lo, phase_hi;
};

__device__ __forceinline__ float bf2f(bf16_t h) { return __uint_as_float(((unsigned)h) << 16); }
__device__ __forceinline__ bf16_t f2bf(float f) { return __builtin_bit_cast(bf16_t, (__bf16)f); }
__device__ __forceinline__ float sigmoidf_(float x) { return 1.f / (1.f + __expf(-x)); }
__device__ __forceinline__ float siluf_(float x) { return x / (1.f + __expf(-x)); }
__device__ __forceinline__ float gelu_tanh(float x) {
    float u = 1.5957691216f * (x + 0.044715f * x * x * x);
    return x / (1.f + __expf(-u));
}
#define DPP_ADD(v, CTRL) ((v) + __uint_as_float(__builtin_amdgcn_update_dpp(0u, __float_as_uint(v), (CTRL), 0xF, 0xF, false)))
__device__ __forceinline__ float wave_sum(float v) {
    v = DPP_ADD(v, 0xB1);
    v = DPP_ADD(v, 0x4E);
    v = DPP_ADD(v, 0x141);
    v = DPP_ADD(v, 0x140);
    unsigned x = __float_as_uint(v);
    auto r = __builtin_amdgcn_permlane16_swap(x, x, false, false);
    v = __uint_as_float(r[0]) + __uint_as_float(r[1]);
    x = __float_as_uint(v);
    auto r2 = __builtin_amdgcn_permlane32_swap(x, x, false, false);
    return __uint_as_float(r2[0]) + __uint_as_float(r2[1]);
}
typedef unsigned u32x2 __attribute__((ext_vector_type(2)));
typedef float f32x2_t __attribute__((ext_vector_type(2)));
typedef __bf16 bf16v2_t __attribute__((ext_vector_type(2)));
__device__ __forceinline__ unsigned cvt2(float lo, float hi) { f32x2_t v = {lo, hi}; return __builtin_bit_cast(unsigned, __builtin_convertvector(v, bf16v2_t)); }
__device__ __forceinline__ bf16x4 pack4(float a, float b, float c, float d) {
    u32x2 r; r.x = cvt2(a, b); r.y = cvt2(c, d);
    return __builtin_bit_cast(bf16x4, r);
}
__device__ __forceinline__ bf16x8 pack8(float a, float b, float c, float d, float e, float f, float g, float h) {
    u32x4 r; r.x = cvt2(a, b); r.y = cvt2(c, d); r.z = cvt2(e, f); r.w = cvt2(g, h);
    return __builtin_bit_cast(bf16x8, r);
}
__device__ __forceinline__ int s_of(int dir, int i) { return dir == 0 ? i : (i < CL ? (CL - 1 - i) : (SL + CL - 1 - i)); }
__device__ __forceinline__ int clampi(int v, int lo, int hi) { return v < lo ? lo : (v > hi ? hi : v); }
__device__ __forceinline__ int opaque_tid() { int t = threadIdx.x; asm volatile("" : "+v"(t)); return t; }
__device__ __forceinline__ int opaque_bid() { int b = blockIdx.x; asm volatile("" : "+s"(b)); return b; }

__device__ __forceinline__ void phase_pre0(const Params& p, unsigned char* smem) {
    float(*tile)[65] = (float(*)[65])smem;
    const int tid = opaque_tid();
    constexpr int T_IN = 16 * 44, T_OUT = 16 * 16, T_UP = 16 * 88, T_DOWN = 44 * 16, T_GLU = 4 * 4;
    constexpr int T_L = T_IN + T_OUT + T_UP + T_DOWN + T_GLU;
    for (int task = opaque_bid(); task < DEPTH * T_L; task += gridDim.x) {
        const int l = task / T_L;
        int r = task % T_L;
        const float* src; bf16_t* dst; int K, N, nkt;
        if (r < T_IN) { src = p.w_in + (size_t)l * DM * DIN; dst = (bf16_t*)(p.ws + WS_WIN) + (size_t)l * PSTR * DM; K = DM; N = DIN; nkt = 16; }
        else if ((r -= T_IN) < T_OUT) { src = p.w_out + (size_t)l * DM * DM; dst = (bf16_t*)(p.ws + WS_WOUT) + (size_t)l * DM * DM; K = DM; N = DM; nkt = 16; }
        else if ((r -= T_OUT) < T_UP) { src = p.ffn_w_up + (size_t)l * DM * DUP; dst = (bf16_t*)(p.ws + WS_WUP) + (size_t)l * DUP * DM; K = DM; N = DUP; nkt = 16; }
        else if ((r -= T_UP) < T_DOWN) { src = p.ffn_w_down + (size_t)l * DFF * DM; dst = (bf16_t*)(p.ws + WS_WDOWN) + (size_t)l * DM * DFF; K = DFF; N = DM; nkt = 44; }
        else { r -= T_DOWN; src = p.s5_w_glu + (size_t)l * 256 * 256; dst = (bf16_t*)(p.ws + WS_WGLU) + (size_t)l * 256 * 256; K = 256; N = 256; nkt = 4; }
        const int kt = r % nkt, nt = r / nkt, k0 = kt * 64, n0 = nt * 64;
        const int tx = tid & 63, ty = tid >> 6;
#pragma unroll
        for (int i = 0; i < 8; ++i) {
            const int k = ty + 8 * i, n = n0 + tx;
            tile[k][tx] = (n < N) ? src[(size_t)(k0 + k) * N + n] : 0.f;
        }
        __syncthreads();
#pragma unroll
        for (int i = 0; i < 8; ++i) {
            const int n = ty + 8 * i;
            int nrow = n0 + n;
            if (N == DUP) { const int nn = nrow < DFF ? nrow : nrow - DFF; nrow = (nn >> 7) * 256 + (nrow < DFF ? 0 : 128) + (nn & 127); }
            dst[(size_t)nrow * K + k0 + tx] = f2bf(tile[tx][n]);
        }
        __syncthreads();
    }
}

__device__ __forceinline__ void phase_mod(const Params& p, unsigned char* smem) {
    float* red = (float*)smem;
    float* scl = (float*)(smem + 36864);
    const int tid = opaque_tid(), lane = tid & 63;
    const int w = __builtin_amdgcn_readfirstlane(tid >> 6);
    float* MOD = (float*)(p.ws + WS_MOD);
    for (int i = tid; i < 17 * 1024; i += NTH) {
        const float v = (i < 16 * 1024) ? p.c[i] : p.c_ctx[i - 16 * 1024];
        scl[i] = siluf_(v);
    }
    __syncthreads();
    for (int task = opaque_bid(); task < DEPTH * 96; task += gridDim.x) {
        const int l = task / 96, j0 = (task % 96) * 64;
        const float* W = p.w_mod + (size_t)l * DM * 6144 + j0 + lane;
        float acc[17];
#pragma unroll
        for (int r = 0; r < 17; ++r) acc[r] = 0.f;
        for (int k = w * 128; k < w * 128 + 128; ++k) {
            const float wv = W[(size_t)k * 6144];
#pragma unroll
            for (int r = 0; r < 17; ++r) acc[r] += scl[r * 1024 + k] * wv;
        }
#pragma unroll
        for (int r = 0; r < 17; ++r) red[(w * 17 + r) * 64 + lane] = acc[r];
        __syncthreads();
        for (int i = tid; i < 17 * 64; i += NTH) {
            const int r = i >> 6, jj = i & 63;
            float s = 0.f;
#pragma unroll
            for (int ww = 0; ww < NW; ++ww) s += red[(ww * 17 + r) * 64 + jj];
            MOD[((size_t)(l * 17 + r)) * 6144 + j0 + jj] = s + p.b_mod[l * 6144 + j0 + jj];
        }
        __syncthreads();
    }
}

__device__ __forceinline__ void phase_rowwise(const Params& p, int mode, int l) {
    const int tid = opaque_tid();
    const int lane = tid & 63;
    const int gw = opaque_bid() * NW + (tid >> 6), nw = gridDim.x * NW;
    const float* MOD = (const float*)(p.ws + WS_MOD);
    float* Xc = (float*)(p.ws + WS_XC);
    unsigned char* big = p.ws + WS_BIG;
    const bf16_t* T = (const bf16_t*)(big + B_T);
    bf16_t* Hdst = (bf16_t*)(big + (mode == 1 ? B_HFFN : B_HMIX));
    const bool in_from_input = (l == 0 && mode != 2);
    const bool skipctx = (l == DEPTH - 1 && mode != 0);
    const int nrows = skipctx ? NBATCH * SEQ : NT;
    for (int i0 = gw; i0 < nrows; i0 += 2 * nw) {
        int tt[2]; bool ok[2];
        const float* xin[2]; float* xout[2]; int modrow[2];
#pragma unroll
        for (int r = 0; r < 2; ++r) {
            const int i = i0 + r * nw;
            ok[r] = i < nrows;
            const int ii = ok[r] ? i : i0;
            int b, s;
            if (skipctx) { b = ii / SEQ; s = CL + (ii - b * SEQ); } else { b = ii / SL; s = ii - b * SL; }
            tt[r] = b * SL + s;
            const bool isctx = s < CL;
            modrow[r] = isctx ? 16 : b;
            if (isctx) { xin[r] = (in_from_input ? p.ctx : Xc) + (size_t)(b * CL + s) * DM; xout[r] = Xc + (size_t)(b * CL + s) * DM; }
            else { xin[r] = (in_from_input ? p.x : p.out) + (size_t)(b * SEQ + s - CL) * DM; xout[r] = p.out + (size_t)(b * SEQ + s - CL) * DM; }
        }
        float xv[2][16];
#pragma unroll
        for (int r = 0; r < 2; ++r)
#pragma unroll
            for (int i = 0; i < 4; ++i) {
                const float4 v = *(const float4*)(xin[r] + i * 256 + lane * 4);
                xv[r][4 * i] = v.x; xv[r][4 * i + 1] = v.y; xv[r][4 * i + 2] = v.z; xv[r][4 * i + 3] = v.w;
            }
        if (mode != 0) {
            float rv[2][16]; float ss[2] = {0.f, 0.f};
#pragma unroll
            for (int r = 0; r < 2; ++r) {
                const bf16_t* tr = T + (size_t)tt[r] * DM;
                const bool part = (modrow[r] == 16);
                if (part) {
                    const int bb = tt[r] / SL, s = tt[r] - bb * SL;
                    const float* p0 = (const float*)(big + (mode == 2 ? B_PART : B_ACT)) + (size_t)(bb * CL + s) * DM;
                    const float* p1 = p0 + (size_t)NBATCH * CL * DM;
#pragma unroll
                    for (int i = 0; i < 4; ++i) {
                        const float4 a = *(const float4*)(p0 + i * 256 + lane * 4), c4 = *(const float4*)(p1 + i * 256 + lane * 4);
                        rv[r][4 * i] = a.x + c4.x; rv[r][4 * i + 1] = a.y + c4.y; rv[r][4 * i + 2] = a.z + c4.z; rv[r][4 * i + 3] = a.w + c4.w;
#pragma unroll
                        for (int k = 0; k < 4; ++k) ss[r] += rv[r][4 * i + k] * rv[r][4 * i + k];
                    }
                } else {
#pragma unroll
                    for (int i = 0; i < 4; ++i) {
                        const bf16x4 v = *(const bf16x4*)(tr + i * 256 + lane * 4);
#pragma unroll
                        for (int k = 0; k < 4; ++k) { rv[r][4 * i + k] = bf2f((bf16_t)v[k]); ss[r] += rv[r][4 * i + k] * rv[r][4 * i + k]; }
                    }
                }
            }
            ss[0] = wave_sum(ss[0]); ss[1] = wave_sum(ss[1]);
            const float* gpost = (mode == 1 ? p.g_post_mix : p.g_post_ffn) + l * DM;
#pragma unroll
            for (int r = 0; r < 2; ++r) {
                const float rstd = rsqrtf(ss[r] * (1.f / DM) + EPS);
                const float* gate = MOD + (size_t)(l * 17 + modrow[r]) * 6144 + (mode == 1 ? 2 : 5) * 1024;
#pragma unroll
                for (int i = 0; i < 4; ++i) {
                    const int c = i * 256 + lane * 4;
                    const float4 g4 = *(const float4*)(gpost + c);
                    const float4 t4 = *(const float4*)(gate + c);
                    xv[r][4 * i] += t4.x * (rv[r][4 * i] * rstd * g4.x);
                    xv[r][4 * i + 1] += t4.y * (rv[r][4 * i + 1] * rstd * g4.y);
                    xv[r][4 * i + 2] += t4.z * (rv[r][4 * i + 2] * rstd * g4.z);
                    xv[r][4 * i + 3] += t4.w * (rv[r][4 * i + 3] * rstd * g4.w);
                    float4 o; o.x = xv[r][4 * i]; o.y = xv[r][4 * i + 1]; o.z = xv[r][4 * i + 2]; o.w = xv[r][4 * i + 3];
                    if (ok[r]) *(float4*)(xout[r] + c) = o;
                }
            }
        }
        if (mode == 2 && l == DEPTH - 1) continue;
        float ss[2] = {0.f, 0.f};
#pragma unroll
        for (int r = 0; r < 2; ++r)
#pragma unroll
            for (int k = 0; k < 16; ++k) ss[r] += xv[r][k] * xv[r][k];
        ss[0] = wave_sum(ss[0]); ss[1] = wave_sum(ss[1]);
        const int ln = (mode == 2) ? l + 1 : l;
        const float* g = (mode == 1 ? p.g_pre_ffn : p.g_pre_mix) + ln * DM;
#pragma unroll
        for (int r = 0; r < 2; ++r) {
            const float rstd = rsqrtf(ss[r] * (1.f / DM) + EPS);
            const float* mrn = MOD + (size_t)(ln * 17 + modrow[r]) * 6144;
            const float* sh = mrn + (mode == 1 ? 3 : 0) * 1024;
            const float* sc = mrn + (mode == 1 ? 4 : 1) * 1024;
#pragma unroll
            for (int i = 0; i < 4; ++i) {
                const int c = i * 256 + lane * 4;
                const float4 g4 = *(const float4*)(g + c);
                const float4 s4 = *(const float4*)(sc + c);
                const float4 h4 = *(const float4*)(sh + c);
                const bf16x4 o = pack4(xv[r][4 * i] * rstd * g4.x * (1.f + s4.x) + h4.x, xv[r][4 * i + 1] * rstd * g4.y * (1.f + s4.y) + h4.y,
                                       xv[r][4 * i + 2] * rstd * g4.z * (1.f + s4.z) + h4.z, xv[r][4 * i + 3] * rstd * g4.w * (1.f + s4.w) + h4.w);
                if (ok[r]) *(bf16x4*)(Hdst + (size_t)tt[r] * DM + c) = o;
            }
        }
    }
}

struct EpiStore {
    static constexpr bool PERM = true, AFTER_DRAIN = false;
    bf16_t* O; int ldc; int split_cols; size_t split_stride;
    __device__ __forceinline__ void operator()(const f32x4 (&acc)[2][2][4][2], const pg8::Unit& u, int wr, int wc, int fr, int fq) const {
        const int row0 = u.pm * 256 + wr * 64 + fr; int colt = u.pn * 256; bf16_t* base = O;
        if (split_cols) { const int t = colt / split_cols; base += (size_t)t * split_stride; colt -= t * split_cols; }
        const int col0 = colt + wc * 32 + 8 * fq;
#pragma unroll
        for (int ai = 0; ai < 2; ++ai)
#pragma unroll
            for (int m = 0; m < 4; ++m) {
                bf16_t* rowp = base + (size_t)(row0 + ai * 128 + m * 16) * ldc + col0;
#pragma unroll
                for (int bj = 0; bj < 2; ++bj) {
                    const f32x4 v0 = acc[ai][bj][m][0], v1 = acc[ai][bj][m][1];
                    u32x4 w; w.x = cvt2(v0[0], v0[1]); w.y = cvt2(v0[2], v0[3]); w.z = cvt2(v1[0], v1[1]); w.w = cvt2(v1[2], v1[3]);
                    *(u32x4*)(rowp + bj * 128) = w;
                }
            }
    }
};
__device__ __forceinline__ float dpp_ror1(float v) { return __uint_as_float(__builtin_amdgcn_update_dpp(0u, __float_as_uint(v), 0x121, 0xF, 0xF, false)); }
__device__ __forceinline__ float dpp_ror15(float v) { return __uint_as_float(__builtin_amdgcn_update_dpp(0u, __float_as_uint(v), 0x12F, 0xF, 0xF, false)); }
struct EpiConv {
    static constexpr bool PERM = true, AFTER_DRAIN = false;
    bf16_t* ACT; bf16_t* GB; bf16_t* VB; const float* cw;
    __device__ __forceinline__ void operator()(const f32x4 (&acc)[2][2][4][2], const pg8::Unit& u, int wr, int wc, int fr, int fq) const {
        const int col0 = u.pn * 128 + wc * 32 + 8 * fq;
        float c0[8], c1[8], c2[8];
        *(float4*)&c0[0] = *(const float4*)(cw + col0); *(float4*)&c0[4] = *(const float4*)(cw + col0 + 4);
        *(float4*)&c1[0] = *(const float4*)(cw + DFF + col0); *(float4*)&c1[4] = *(const float4*)(cw + DFF + col0 + 4);
        *(float4*)&c2[0] = *(const float4*)(cw + 2 * DFF + col0); *(float4*)&c2[4] = *(const float4*)(cw + 2 * DFF + col0 + 4);
#pragma unroll
        for (int ai = 0; ai < 2; ++ai) {
            const int row0 = u.pm * 256 + ai * 128 + wr * 64;
            const int strip = row0 >> 6;
#pragma unroll
            for (int m = 0; m < 4; ++m) {
                float outv[8];
#pragma unroll
                for (int e = 0; e < 8; ++e) {
                    const int n = e >> 2, j = e & 3;
                    const float g = acc[ai][0][m][n][j];
                    const float pa = dpp_ror1(g), na = dpp_ror15(g);
                    const float pb = (m > 0) ? dpp_ror1(acc[ai][0][m > 0 ? m - 1 : 0][n][j]) : 0.f;
                    const float nb = (m < 3) ? dpp_ror15(acc[ai][0][m < 3 ? m + 1 : 3][n][j]) : 0.f;
                    const float prev = (fr == 0) ? pb : pa, next = (fr == 15) ? nb : na;
                    const float gg = c0[e] * prev + c1[e] * g + c2[e] * next;
                    outv[e] = gelu_tanh(gg) * acc[ai][1][m][n][j];
                }
                const int lr = m * 16 + fr;
                if (lr != 0 && lr != 63)
                    *(bf16x8*)(ACT + (size_t)(row0 + lr) * DFF + col0) = pack8(outv[0], outv[1], outv[2], outv[3], outv[4], outv[5], outv[6], outv[7]);
                if (lr < 2 || lr >= 62) {
                    const int slot = lr < 2 ? lr : lr - 60;
                    *(bf16x8*)(GB + ((size_t)strip * 4 + slot) * DFF + col0) = pack8(acc[ai][0][m][0][0], acc[ai][0][m][0][1], acc[ai][0][m][0][2], acc[ai][0][m][0][3],
                                                                                     acc[ai][0][m][1][0], acc[ai][0][m][1][1], acc[ai][0][m][1][2], acc[ai][0][m][1][3]);
                    if (lr == 0 || lr == 63)
                        *(bf16x8*)(VB + ((size_t)strip * 2 + (lr ? 1 : 0)) * DFF + col0) = pack8(acc[ai][1][m][0][0], acc[ai][1][m][0][1], acc[ai][1][m][0][2], acc[ai][1][m][0][3],
                                                                                                 acc[ai][1][m][1][0], acc[ai][1][m][1][1], acc[ai][1][m][1][2], acc[ai][1][m][1][3]);
                }
            }
        }
    }
};
struct EpiPart {
    static constexpr bool PERM = true, AFTER_DRAIN = false;
    float* O;
    __device__ __forceinline__ void operator()(const f32x4 (&acc)[2][2][4][2], const pg8::Unit& u, int wr, int wc, int fr, int fq) const {
        const int row0 = (u.pm / 9) * 256 + wr * 64 + fr, col0 = u.pn * 256 + wc * 32 + 8 * fq;
#pragma unroll
        for (int ai = 0; ai < 2; ++ai)
#pragma unroll
            for (int m = 0; m < 4; ++m) {
                float* rowp = O + (size_t)(row0 + ai * 128 + m * 16) * DM + col0;
#pragma unroll
                for (int bj = 0; bj < 2; ++bj) { *(f32x4*)(rowp + bj * 128) = acc[ai][bj][m][0]; *(f32x4*)(rowp + bj * 128 + 4) = acc[ai][bj][m][1]; }
            }
    }
};
struct CtxOrder : pg8::StaticOrder {
    __device__ __forceinline__ bool next(int i, pg8::Unit& u) const {
        if (!pg8::StaticOrder::next(i, u)) return false;
        u.pm = u.pm * 9;
        return true;
    }
};
struct SkipOrder : pg8::StaticOrder {
    int skip;
    __device__ __forceinline__ bool next(int i, pg8::Unit& u) const {
        if (!pg8::StaticOrder::next(i, u)) return false;
        if (skip) u.pm = (u.pm >> 3) * 9 + 1 + (u.pm & 7);
        return true;
    }
};

__device__ __forceinline__ void phase_prep(const Params& p, unsigned char* smem) {
    const int tid = opaque_tid();
    const int lane = tid & 63, w = tid >> 6;
    unsigned char* big = p.ws + WS_BIG;
    bf16_t* P = (bf16_t*)(big + B_P);
    bf16_t* VTN = (bf16_t*)(big + B_VTN);
    bf16_t* VTS = (bf16_t*)(big + B_VTS);
    bf16_t* tl = (bf16_t*)smem;
    constexpr int N_ROPE = NBATCH * SEQ / NW, N_VT = NBATCH * 6 * (SL / 64);
    for (int task = opaque_bid(); task < N_ROPE + N_VT; task += gridDim.x) {
        if (task < N_ROPE) {
            const int tk = task * NW + w;
            const int b = tk / SEQ, pos = tk % SEQ;
            bf16_t* pr = P + (size_t)(b * SL + CL + pos) * PSTR;
            const int row = pos >> 6, col = pos & 63;
#pragma unroll
            for (int e0 = 0; e0 < 192; e0 += 64) {
                const int e = e0 + lane;
                const int head = e >> 5, pair = e & 31, half = pair >> 4, i = pair & 15;
                const int base = (head < 4) ? (OFF_SQ + head * 64) : (OFF_SK + (head - 4) * 64);
                const int i1 = base + half * 32 + i, i2 = i1 + 16;
                const float inv_freq = exp2f(-(float)i * (13.287712379549449f / 16.f));
                const float ang = (float)(half ? col : row) * inv_freq;
                float sn, cs; __sincosf(ang, &sn, &cs);
                const float t1 = bf2f(pr[i1]), t2 = bf2f(pr[i2]);
                pr[i1] = f2bf(t1 * cs - t2 * sn);
                pr[i2] = f2bf(t1 * sn + t2 * cs);
            }
        } else {
            const int r = task - N_ROPE;
            const int st = r % (SL / 64), slot = (r / (SL / 64)) % 6, b = r / (6 * (SL / 64));
            const int s0 = st * 64;
            const int col = (slot < 4) ? (OFF_NAV + slot * 64) : (OFF_SV + (slot - 4) * 64);
            {
                const int tt = tid >> 3, dc = (tid & 7) * 8;
                const bf16x8 v = *(const bf16x8*)(P + (size_t)(b * SL + s0 + tt) * PSTR + col + dc);
#pragma unroll
                for (int k = 0; k < 8; ++k) tl[(dc + k) * 72 + tt] = (bf16_t)v[k];
            }
            __syncthreads();
            {
                const int d = tid >> 3, tc = (tid & 7) * 8;
                const bf16x8 v = *(const bf16x8*)(tl + d * 72 + tc);
                bf16_t* dst = (slot < 4) ? (VTN + ((size_t)(b * 4 + slot) * 64 + d) * SL + s0 + tc) : (VTS + ((size_t)(b * 2 + slot - 4) * 64 + d) * SL + s0 + tc);
                *(bf16x8*)dst = v;
            }
            __syncthreads();
        }
    }
}

__device__ __forceinline__ float quad_max(float v) {
    unsigned x = __float_as_uint(v);
    auto r = __builtin_amdgcn_permlane16_swap(x, x, false, false);
    float a = fmaxf(__uint_as_float(r[0]), __uint_as_float(r[1]));
    x = __float_as_uint(a);
    auto r2 = __builtin_amdgcn_permlane32_swap(x, x, false, false);
    return fmaxf(__uint_as_float(r2[0]), __uint_as_float(r2[1]));
}
__device__ __forceinline__ float quad_sum(float v) {
    unsigned x = __float_as_uint(v);
    auto r = __builtin_amdgcn_permlane16_swap(x, x, false, false);
    float a = __uint_as_float(r[0]) + __uint_as_float(r[1]);
    x = __float_as_uint(a);
    auto r2 = __builtin_amdgcn_permlane32_swap(x, x, false, false);
    return __uint_as_float(r2[0]) + __uint_as_float(r2[1]);
}
struct KFrag { bf16x8 k[4]; };
struct VFrag { bf16x8 v[4]; };
__device__ __forceinline__ KFrag load_k(const char* kb_u, unsigned ko0, unsigned ko1) {
    KFrag f;
    f.k[0] = *(const bf16x8*)(kb_u + ko0); f.k[1] = *(const bf16x8*)(kb_u + ko0 + 64);
    f.k[2] = *(const bf16x8*)(kb_u + ko1); f.k[3] = *(const bf16x8*)(kb_u + ko1 + 64);
    return f;
}
__device__ __forceinline__ VFrag load_v(const char* vb_u, const unsigned (&vo)[4]) {
    VFrag f;
#pragma unroll
    for (int dt = 0; dt < 4; ++dt) f.v[dt] = *(const bf16x8*)(vb_u + vo[dt]);
    return f;
}
constexpr float LOG2E = 1.4426950408889634f;

template <bool CTXLDS>
__device__ __forceinline__ void attn_task(const Params& p, int l, int kind, int b, int a, int c, int h, int lane, const float* rpbl  ,
                                          const char* Kc, const char* Vc) {
    const int fr = lane & 15, fq = lane >> 4;
    unsigned char* big = p.ws + WS_BIG;
    const bf16_t* Pb = (const bf16_t*)(big + B_P) + (size_t)b * SL * PSTR;
    bf16_t* YM = (bf16_t*)(big + B_YM) + (size_t)b * SL * DM;
    const bool isna = (kind == 0 || kind == 2);
    const int kvh = isna ? h : (h >> 1);
    const char* Kbase = (const char*)(Pb + (isna ? OFF_NAK : OFF_SK) + kvh * 64);
    const char* Vbase = (const char*)(isna ? ((const bf16_t*)(big + B_VTN) + (size_t)(b * 4 + kvh) * 64 * SL)
                                           : ((const bf16_t*)(big + B_VTS) + (size_t)(b * 2 + kvh) * 64 * SL));
    const int krow = (fr >> 2) * 8 + (fr & 3);
    const unsigned ko0 = (unsigned)(krow * PSTR + fq * 8) * 2u, ko1 = ko0 + 4u * PSTR * 2u;
    unsigned vo[4];
#pragma unroll
    for (int dt = 0; dt < 4; ++dt) vo[dt] = (unsigned)((dt * 16 + fr) * SL + fq * 8) * 2u;
    int qtok[2];
    if (kind == 0) { qtok[0] = CL + (2 * a) * 64 + c * 16 + fr; qtok[1] = qtok[0] + 64; }
    else if (kind == 1) { qtok[0] = CL + a * 32 + fr; qtok[1] = qtok[0] + 16; }
    else { qtok[0] = a * 32 + fr; qtok[1] = qtok[0] + 16; }
    bf16x8 qB[2][2];
#pragma unroll
    for (int g = 0; g < 2; ++g) {
        const bf16_t* qp = Pb + (size_t)qtok[g] * PSTR + (isna ? OFF_NAQ : OFF_SQ) + h * 64 + fq * 8;
        qB[g][0] = *(const bf16x8*)qp;
        qB[g][1] = *(const bf16x8*)(qp + 32);
    }
    int nloc = 0, loc0 = 0, locstep = 32;
    int row0A = 0, rowoff = 0, q0 = 0;
    int dcv[8]; unsigned vmask = 0u;
#pragma unroll
    for (int e = 0; e < 8; ++e) dcv[e] = 0;
    if (kind == 0) {
        const int r0 = 2 * a;
        row0A = clampi(r0 - 4, 0, 24);
        const int row0B = clampi(r0 - 3, 0, 24);
        rowoff = row0B - row0A;
        const int col0 = clampi(16 * c - 8, 0, 32), qcol = 16 * c + fr, wst = clampi(qcol - 8, 0, 48);
        nloc = 8 + rowoff; loc0 = CL + row0A * 64 + col0; locstep = 64;
#pragma unroll
        for (int e = 0; e < 8; ++e) {
            const int kcol = col0 + fq * 8 + e;
            if ((kcol >= wst) && (kcol < wst + 16)) vmask |= (1u << e);
            dcv[e] = clampi(kcol - qcol, -15, 15) + 15;
        }
    } else if (kind == 1) {
        q0 = a * 32;
        const int lo = q0 - 128;
        const int first = lo < 0 ? 0 : lo, last = (lo + 288) > SEQ ? SEQ : (lo + 288);
        nloc = (last - first) >> 5; loc0 = CL + first; locstep = 32;
    }
    const int nblk = 8 + nloc;
    auto s0_of = [&](int i) { const int ii = i < nblk ? i : nblk - 1; return ii < 8 ? ii * 32 : loc0 + (ii - 8) * locstep; };
    f32x4 o[2][4];
    float m[2], lsum[2];
#pragma unroll
    for (int g = 0; g < 2; ++g) {
        m[g] = NEG; lsum[g] = 0.f;
#pragma unroll
        for (int dt = 0; dt < 4; ++dt) o[g][dt] = (f32x4){0.f, 0.f, 0.f, 0.f};
    }
    constexpr float C1 = 0.125f * LOG2E;
    auto compute = [&](const KFrag& kc, const VFrag& vc, int i, int s0) {
#pragma unroll
        for (int g = 0; g < 2; ++g) {
            bool act = true;
            float badd[8];
#pragma unroll
            for (int e = 0; e < 8; ++e) badd[e] = 0.f;
            if (i >= 8) {
                if (kind == 0) {
                    const int j = i - 8;
                    act = (g == 0) ? (j < 8) : (j >= rowoff);
                    if (act) {
                        const float* bias = rpbl + (row0A + j - (2 * a + g) + 7) * 31;
#pragma unroll
                        for (int e = 0; e < 8; ++e) badd[e] = ((vmask >> e) & 1u) ? bias[dcv[e]] : NEG;
                    }
                } else {
                    const int kp0 = s0 - CL, qlo = q0 + 16 * g;
                    const bool full = (kp0 >= qlo + 15 - 128) && (kp0 + 31 <= qlo + 128);
                    if (!full) {
#pragma unroll
                        for (int e = 0; e < 8; ++e) {
                            const int d = qlo + fr - (kp0 + fq * 8 + e);
                            badd[e] = (d <= 128 && d >= -128) ? 0.f : NEG;
                        }
                    }
                }
            }
            if (act) {
                f32x4 s[2];
                s[0] = MFMA16(kc.k[0], qB[g][0], ((f32x4){0.f, 0.f, 0.f, 0.f}));
                s[0] = MFMA16(kc.k[1], qB[g][1], s[0]);
                s[1] = MFMA16(kc.k[2], qB[g][0], ((f32x4){0.f, 0.f, 0.f, 0.f}));
                s[1] = MFMA16(kc.k[3], qB[g][1], s[1]);
                float t[8];
                float bm = NEG;
#pragma unroll
                for (int e = 0; e < 8; ++e) { t[e] = fmaf(s[e >> 2][e & 3], C1, badd[e]); bm = fmaxf(bm, t[e]); }
                bm = quad_max(bm);
                if (__any(bm > m[g] + 8.f)) {
                    const float mn = fmaxf(m[g], bm);
                    const float alpha = __builtin_amdgcn_exp2f(m[g] - mn);
                    m[g] = mn;
                    lsum[g] *= alpha;
#pragma unroll
                    for (int dt = 0; dt < 4; ++dt) o[g][dt] *= alpha;
                }
                float pv[8]; float ps = 0.f;
#pragma unroll
                for (int e = 0; e < 8; ++e) { pv[e] = __builtin_amdgcn_exp2f(t[e] - m[g]); ps += pv[e]; }
                lsum[g] += ps;
                const bf16x8 pB = pack8(pv[0], pv[1], pv[2], pv[3], pv[4], pv[5], pv[6], pv[7]);
#pragma unroll
                for (int dt = 0; dt < 4; ++dt) o[g][dt] = MFMA16(vc.v[dt], pB, o[g][dt]);
            }
        }
    };
    if (CTXLDS) {
        KFrag gk0 = load_k(Kbase + (size_t)s0_of(8) * (PSTR * 2), ko0, ko1);
        VFrag gv0 = load_v(Vbase + (size_t)s0_of(8) * 2, vo);
        KFrag gk1 = load_k(Kbase + (size_t)s0_of(9) * (PSTR * 2), ko0, ko1);
        const char* kl = Kc + (krow * 144 + fq * 16);
        auto lds_k = [&](int s0) { KFrag f; const char* q = kl + s0 * 144;
            f.k[0] = *(const bf16x8*)q; f.k[1] = *(const bf16x8*)(q + 64); f.k[2] = *(const bf16x8*)(q + 4 * 144); f.k[3] = *(const bf16x8*)(q + 4 * 144 + 64); return f; };
        auto lds_v = [&](int s0) { VFrag f;
#pragma unroll
            for (int dt = 0; dt < 4; ++dt) f.v[dt] = *(const bf16x8*)(Vc + (dt * 16 + fr) * 528 + (s0 + fq * 8) * 2);
            return f; };
        KFrag kc = lds_k(0); VFrag vc = lds_v(0);
        for (int i = 0; i < 8; ++i) {
            const int sn = (i < 7 ? i + 1 : 7) * 32;
            const KFrag kn = lds_k(sn); const VFrag vn = lds_v(sn);
            compute(kc, vc, i, i * 32);
            kc = kn; vc = vn;
        }
        kc = gk0; vc = gv0;
        KFrag kn = gk1;
        for (int i = 8; i < nblk; ++i) {
            const KFrag kn2 = load_k(Kbase + (size_t)s0_of(i + 2) * (PSTR * 2), ko0, ko1);
            const VFrag vn = load_v(Vbase + (size_t)s0_of(i + 1) * 2, vo);
            compute(kc, vc, i, s0_of(i));
            kc = kn; kn = kn2; vc = vn;
        }
    } else {
        KFrag kc = load_k(Kbase + (size_t)s0_of(0) * (PSTR * 2), ko0, ko1);
        KFrag kn = load_k(Kbase + (size_t)s0_of(1) * (PSTR * 2), ko0, ko1);
        VFrag vc = load_v(Vbase + (size_t)s0_of(0) * 2, vo);
        for (int i = 0; i < nblk; ++i) {
            const KFrag kn2 = load_k(Kbase + (size_t)s0_of(i + 2) * (PSTR * 2), ko0, ko1);
            const VFrag vn = load_v(Vbase + (size_t)s0_of(i + 1) * 2, vo);
            compute(kc, vc, i, s0_of(i));
            kc = kn; kn = kn2; vc = vn;
        }
    }
#pragma unroll
    for (int g = 0; g < 2; ++g) {
        float lt = quad_sum(lsum[g]);
        if (!isna) lt += __builtin_amdgcn_exp2f(p.swa_sink[l * 4 + h] * LOG2E - m[g]);
        const float inv = 1.f / lt;
        bf16_t* dst = YM + (size_t)qtok[g] * DM + (isna ? 256 : 768) + h * 64;
#pragma unroll
        for (int dt = 0; dt < 4; ++dt)
            *(bf16x4*)(dst + dt * 16 + fq * 4) = pack4(o[g][dt][0] * inv, o[g][dt][1] * inv, o[g][dt][2] * inv, o[g][dt][3] * inv);
    }
}

__device__ __forceinline__ void s5_task(const Params& p, int l, int b, int g, int dir, int lane, float* bu  , bf16_t* hb  ) {
    const int fr = lane & 15, fq = lane >> 4;
    unsigned char* big = p.ws + WS_BIG;
    const bf16_t* Pb = (const bf16_t*)(big + B_P) + (size_t)b * SL * PSTR + OFF_A + g * 16;
    bf16_t* YS = (bf16_t*)(big + B_YS) + ((size_t)dir * NT + (size_t)b * SL) * 256 + g * 16;
    const int base = (l * 2 + dir) * 16 + g;
    const float step = expf(p.s5_log_step[base]);
    float lbr, lbi;
    {
        const float lre = p.s5_lam_re[base * 64 + lane], lim = p.s5_lam_im[base * 64 + lane];
        const float er = expf(lre * step);
        float sn, cs; sincosf(lim * step, &sn, &cs);
        lbr = er * cs; lbi = er * sn;
        const float nr = lbr - 1.f, ni = lbi;
        const float den = 1.f / (lre * lre + lim * lim);
        bu[2 * lane] = (nr * lre + ni * lim) * den;
        bu[2 * lane + 1] = (ni * lre - nr * lim) * den;
    }
    WAVE_LDS_SYNC();
    bf16x8 Bop[8];
#pragma unroll
    for (int nt = 0; nt < 8; ++nt) {
        const int pp = nt * 8 + (fr >> 1), part = fr & 1;
        const float cr = bu[2 * pp], ci = bu[2 * pp + 1];
        float v[8];
#pragma unroll
        for (int jj = 0; jj < 8; ++jj) {
            float br = 0.f, bi = 0.f;
            if (fq < 2) {
                const size_t idx = ((size_t)base * 64 + pp) * 16 + fq * 8 + jj;
                br = p.s5_b_re[idx]; bi = p.s5_b_im[idx];
            }
            v[jj] = part ? (cr * bi + ci * br) : (cr * br - ci * bi);
        }
        Bop[nt] = pack8(v[0], v[1], v[2], v[3], v[4], v[5], v[6], v[7]);
        if (nt & 1) asm volatile("" ::: "memory");
    }
    WAVE_LDS_SYNC();
    bf16x8 Cop[4];
#pragma unroll
    for (int ks = 0; ks < 4; ++ks) {
        float v[8];
#pragma unroll
        for (int jj = 0; jj < 8; ++jj) {
            const int k = ks * 32 + fq * 8 + jj;
            const size_t idx = ((size_t)base * 16 + fr) * 64 + (k >> 1);
            v[jj] = (k & 1) ? -p.s5_c_im[idx] : p.s5_c_re[idx];
        }
        Cop[ks] = pack8(v[0], v[1], v[2], v[3], v[4], v[5], v[6], v[7]);
        asm volatile("" ::: "memory");
    }
    const bf16x8 zero8 = (bf16x8){0, 0, 0, 0, 0, 0, 0, 0};
    float hr = 0.f, hi = 0.f;
    bf16x8 uN = zero8, uN2 = zero8;
    if (fq < 2) {
        uN = *(const bf16x8*)(Pb + (size_t)s_of(dir, fr) * PSTR + fq * 8);
        uN2 = *(const bf16x8*)(Pb + (size_t)s_of(dir, 16 + fr) * PSTR + fq * 8);
    }
    for (int blk = 0; blk < SL / 16; ++blk) {
        const int i0 = blk * 16;
        const bf16x8 uA = uN;
        uN = uN2;
        if (blk + 2 < SL / 16 && fq < 2) uN2 = *(const bf16x8*)(Pb + (size_t)s_of(dir, i0 + 32 + fr) * PSTR + fq * 8);
#pragma unroll
        for (int nt = 0; nt < 8; ++nt) {
            const f32x4 acc = MFMA16(uA, Bop[nt], ((f32x4){0.f, 0.f, 0.f, 0.f}));
#pragma unroll
            for (int j = 0; j < 4; ++j) bu[(fq * 4 + j) * 132 + nt * 16 + fr] = acc[j];
        }
        WAVE_LDS_SYNC();
#pragma unroll
        for (int t = 0; t < 16; ++t) {
            const float2 v = *(const float2*)(bu + t * 132 + 2 * lane);
            const float nr = lbr * hr - lbi * hi + v.x;
            const float ni = lbr * hi + lbi * hr + v.y;
            hr = nr; hi = ni;
            *(unsigned*)(hb + t * 136 + 2 * lane) = cvt2(hr, hi);
        }
        WAVE_LDS_SYNC();
        f32x4 y = (f32x4){0.f, 0.f, 0.f, 0.f};
#pragma unroll
        for (int ks = 0; ks < 4; ++ks) {
            const bf16x8 hA = *(const bf16x8*)(hb + fr * 136 + ks * 32 + fq * 8);
            y = MFMA16(hA, Cop[ks], y);
        }
#pragma unroll
        for (int j = 0; j < 4; ++j) YS[(size_t)s_of(dir, i0 + fq * 4 + j) * 256 + fr] = f2bf(y[j]);
        WAVE_LDS_SYNC();
    }
}

__device__ __forceinline__ void gla_task(const Params& p, int l, int b, int h, int dir, unsigned char* smem) {
    constexpr int LS = 72;
    bf16_t* Qd = (bf16_t*)smem;
    bf16_t* Kd = Qd + 64 * LS;
    bf16_t* KeT = Kd + 64 * LS;
    bf16_t* Vt = KeT + 64 * LS;
    bf16_t* Am = Vt + 64 * LS;
    bf16_t* St = Am + 64 * LS;
    float* segsum = (float*)(St + 64 * LS);
    float* decay = segsum + 512;
    unsigned* gfl = (unsigned*)(decay + 64);
    const int tid = opaque_tid(), lane = tid & 63, w = tid >> 6, fr = lane & 15, fq = lane >> 4;
    const int d = lane, iq = w, it = w >> 1, hb2 = (w & 1) * 2;
    unsigned char* big = p.ws + WS_BIG;
    const bf16_t* Pb = (const bf16_t*)(big + B_P) + (size_t)b * SL * PSTR;
    bf16_t* OG = (bf16_t*)(big + B_OG) + ((size_t)dir * NT + (size_t)b * SL) * 256 + h * 64;
    for (int i = tid; i < 64 * LS; i += NTH) St[i] = 0;
    f32x4 Sacc[2];
    Sacc[0] = (f32x4){0.f, 0.f, 0.f, 0.f}; Sacc[1] = (f32x4){0.f, 0.f, 0.f, 0.f};
    float wg[16];
    {
        const float* Wg = p.gla_w_gate2 + (size_t)((l * 2 + dir) * 16) * 256 + h * 64 + d;
#pragma unroll
        for (int r = 0; r < 16; ++r) wg[r] = Wg[r * 256];
    }
    const float bgv = p.gla_b_gate[(l * 2 + dir) * 256 + h * 64 + d];
    const int gcol = dir == 0 ? OFF_GF : OFF_GB;
    unsigned gfn = *(const unsigned*)(Pb + (size_t)s_of(dir, tid >> 3) * PSTR + gcol + 2 * (tid & 7));
    bf16_t qn[8], kn[8], vn[8];
#pragma unroll
    for (int ii = 0; ii < 8; ++ii) {
        const bf16_t* pr = Pb + (size_t)s_of(dir, iq * 8 + ii) * PSTR + h * 64 + d;
        qn[ii] = pr[OFF_GQ]; kn[ii] = pr[OFF_GK]; vn[ii] = pr[OFF_GV];
    }
    gfl[tid] = gfn;
    __syncthreads();
    for (int n = 0; n < SL / 64; ++n) {
        bf16_t qc[8], kc[8], vc[8];
#pragma unroll
        for (int ii = 0; ii < 8; ++ii) { qc[ii] = qn[ii]; kc[ii] = kn[ii]; vc[ii] = vn[ii]; }
        if (n + 1 < SL / 64) {
            gfn = *(const unsigned*)(Pb + (size_t)s_of(dir, (n + 1) * 64 + (tid >> 3)) * PSTR + gcol + 2 * (tid & 7));
#pragma unroll
            for (int ii = 0; ii < 8; ++ii) {
                const bf16_t* pr = Pb + (size_t)s_of(dir, (n + 1) * 64 + iq * 8 + ii) * PSTR + h * 64 + d;
                qn[ii] = pr[OFF_GQ]; kn[ii] = pr[OFF_GK]; vn[ii] = pr[OFF_GV];
            }
        }
        const unsigned* gcur = gfl + (n & 1) * 512;
        float bcum[8];
        float run = 0.f;
#pragma unroll
        for (int ii = 0; ii < 8; ++ii) {
            const bf16x8 g0 = *(const bf16x8*)(gcur + (iq * 8 + ii) * 8);
            const bf16x8 g1 = *(const bf16x8*)(gcur + (iq * 8 + ii) * 8 + 4);
            float z = bgv;
#pragma unroll
            for (int r = 0; r < 8; ++r) z += bf2f((bf16_t)g0[r]) * wg[r];
#pragma unroll
            for (int r = 0; r < 8; ++r) z += bf2f((bf16_t)g1[r]) * wg[8 + r];
            const float ls = fminf(z, 0.f) - __logf(1.f + __expf(-fabsf(z)));
            run += ls * (1.f / 16.f);
            bcum[ii] = run;
        }
        segsum[iq * 64 + d] = run;
        __syncthreads();
        float pre = 0.f, tot = 0.f;
#pragma unroll
        for (int q = 0; q < 8; ++q) {
            const float v = segsum[q * 64 + d];
            tot += v;
            if (q < iq) pre += v;
        }
        float kev[8];
#pragma unroll
        for (int ii = 0; ii < 8; ++ii) {
            const int il = iq * 8 + ii;
            const float bb = pre + bcum[ii];
            const float q = bf2f(qc[ii]), k = bf2f(kc[ii]);
            Qd[il * LS + d] = f2bf(q * 0.125f * __expf(bb));
            Kd[il * LS + d] = f2bf(k * __expf(-bb));
            kev[ii] = k * __expf(tot - bb);
        }
        *(bf16x8*)(KeT + d * LS + iq * 8) = pack8(kev[0], kev[1], kev[2], kev[3], kev[4], kev[5], kev[6], kev[7]);
        {
            bf16x8 vv;
#pragma unroll
            for (int ii = 0; ii < 8; ++ii) vv[ii] = (short)vc[ii];
            *(bf16x8*)(Vt + d * LS + iq * 8) = vv;
        }
        if (iq == 0) decay[d] = __expf(tot);
        __syncthreads();
        bf16x8 qf[2];
        qf[0] = *(const bf16x8*)(Qd + (16 * it + fr) * LS + fq * 8);
        qf[1] = *(const bf16x8*)(Qd + (16 * it + fr) * LS + 32 + fq * 8);
#pragma unroll
        for (int j2 = 0; j2 < 2; ++j2) {
            const int jt = hb2 + j2;
            f32x4 acc = (f32x4){0.f, 0.f, 0.f, 0.f};
#pragma unroll
            for (int ks = 0; ks < 2; ++ks) {
                const bf16x8 kf = *(const bf16x8*)(Kd + (jt * 16 + fr) * LS + ks * 32 + fq * 8);
                acc = MFMA16(kf, qf[ks], acc);
            }
            const int il = 16 * it + fr, j0 = jt * 16 + fq * 4;
            *(bf16x4*)(Am + il * LS + j0) = pack4(il >= j0 ? acc[0] : 0.f, il >= j0 + 1 ? acc[1] : 0.f, il >= j0 + 2 ? acc[2] : 0.f, il >= j0 + 3 ? acc[3] : 0.f);
        }
        __syncthreads();
        bf16x8 af[2];
        af[0] = *(const bf16x8*)(Am + (16 * it + fr) * LS + fq * 8);
        af[1] = *(const bf16x8*)(Am + (16 * it + fr) * LS + 32 + fq * 8);
        {
            const int s = s_of(dir, n * 64 + 16 * it + fr);
            bf16_t* orow = OG + (size_t)s * 256;
#pragma unroll
            for (int d2 = 0; d2 < 2; ++d2) {
                const int dvt = hb2 + d2;
                f32x4 acc = (f32x4){0.f, 0.f, 0.f, 0.f};
#pragma unroll
                for (int ks = 0; ks < 2; ++ks) {
                    const bf16x8 vf = *(const bf16x8*)(Vt + (dvt * 16 + fr) * LS + ks * 32 + fq * 8);
                    acc = MFMA16(vf, af[ks], acc);
                    const bf16x8 sf = *(const bf16x8*)(St + (dvt * 16 + fr) * LS + ks * 32 + fq * 8);
                    acc = MFMA16(sf, qf[ks], acc);
                }
                *(bf16x4*)(orow + dvt * 16 + fq * 4) = pack4(acc[0], acc[1], acc[2], acc[3]);
            }
        }
        gfl[((n + 1) & 1) * 512 + tid] = gfn;
        __syncthreads();
        bf16x8 vb[2];
        vb[0] = *(const bf16x8*)(Vt + (16 * it + fr) * LS + fq * 8);
        vb[1] = *(const bf16x8*)(Vt + (16 * it + fr) * LS + 32 + fq * 8);
#pragma unroll
        for (int k2 = 0; k2 < 2; ++k2) {
            const int dkt = hb2 + k2;
            const f32x4 dec = *(const f32x4*)(decay + dkt * 16 + fq * 4);
            Sacc[k2] *= dec;
#pragma unroll
            for (int ks = 0; ks < 2; ++ks) {
                const bf16x8 kf = *(const bf16x8*)(KeT + (dkt * 16 + fr) * LS + ks * 32 + fq * 8);
                Sacc[k2] = MFMA16(kf, vb[ks], Sacc[k2]);
            }
            *(bf16x4*)(St + (16 * it + fr) * LS + dkt * 16 + fq * 4) = pack4(Sacc[k2][0], Sacc[k2][1], Sacc[k2][2], Sacc[k2][3]);
        }
    }
    __syncthreads();
}

__device__ __forceinline__ int next_task(unsigned* cnt, volatile int* s_task) {
    __syncthreads();
    if (opaque_tid() == 0) *s_task = (int)atomicAdd(cnt, 1u);
    __syncthreads();
    return *s_task;
}
__device__ __forceinline__ int wave_next(unsigned* cnt, int lane) {
    int t = 0;
    if (lane == 0) t = (int)atomicAdd(cnt, 1u);
    return __builtin_amdgcn_readfirstlane(t);
}
__device__ __forceinline__ bool combo_task(int combo, int wt, bool ctx_out, int xq, int& kind, int& b, int& a, int& c, int& h) {
    c = 0;
    if (combo < 8) {
        const int n = ctx_out ? 72 : 64;
        if (wt >= n) return false;
        b = 2 * xq + (combo >> 2); h = combo & 3;
        if (wt < 64) { kind = 0; c = wt & 3; a = wt >> 2; } else { kind = 2; a = wt - 64; }
    } else {
        const int n = ctx_out ? 144 : 128;
        if (wt >= n) return false;
        const int cc = combo - 8;
        b = 2 * xq + (cc >> 1);
        if (wt < 128) { kind = 1; h = (cc & 1) * 2 + (wt & 1); a = wt >> 1; } else { const int r = wt - 128; kind = 3; h = (cc & 1) * 2 + (r & 1); a = r >> 1; }
    }
    return true;
}
__device__ __forceinline__ void phase_mix(const Params& p, int lc, int l, unsigned char* smem) {
    volatile int* s_task = (volatile int*)(smem + LDS_MAIN + 64);
    const int tid = opaque_tid(), lane = tid & 63;
    const int w = __builtin_amdgcn_readfirstlane(tid >> 6);
    const bool ctx_out = l < DEPTH - 1;
    const int x0 = (int)(xb_xcc_id() & 7u);
    unsigned* cbase = (unsigned*)(p.ws + WS_CNT) + lc * 128;
    for (int k = 0; k < 8; ++k) {
        const int xq = (x0 + k) & 7;
        unsigned* cnt = cbase + xq * 16;
        while (true) {
            const int task = __builtin_amdgcn_readfirstlane(next_task(cnt + 0, s_task));
            if (task >= 16) break;
            gla_task(p, l, 2 * xq + (task >> 3), (task >> 1) & 3, task & 1, smem);
        }
    }
    const int slot = __builtin_amdgcn_readfirstlane(next_task(cbase + x0 * 16 + 3, s_task));
    const int mycombo = (slot & 1) ? (8 + ((slot >> 1) & 3)) : ((slot >> 1) & 7);
    {
        const int cb = 2 * x0 + (mycombo < 8 ? (mycombo >> 2) : ((mycombo - 8) >> 1));
        const bool na = mycombo < 8;
        const int hh = na ? (mycombo & 3) : ((mycombo - 8) & 1);
        unsigned char* big = p.ws + WS_BIG;
        const bf16_t* Pb = (const bf16_t*)(big + B_P) + (size_t)cb * SL * PSTR + (na ? OFF_NAK : OFF_SK) + hh * 64;
        const bf16_t* Vb = na ? ((const bf16_t*)(big + B_VTN) + (size_t)(cb * 4 + hh) * 64 * SL) : ((const bf16_t*)(big + B_VTS) + (size_t)(cb * 2 + hh) * 64 * SL);
        {
            const int row = tid >> 1, half = tid & 1;
            const bf16_t* src = Pb + (size_t)row * PSTR + half * 32;
            unsigned char* dst = smem + LDS_KC + row * 144 + half * 64;
#pragma unroll
            for (int q = 0; q < 4; ++q) *(bf16x8*)(dst + q * 16) = *(const bf16x8*)(src + q * 8);
        }
        {
            const int d = tid >> 3, part = tid & 7;
            const bf16_t* src = Vb + (size_t)d * SL + part * 32;
            unsigned char* dst = smem + LDS_VC + d * 528 + part * 64;
#pragma unroll
            for (int q = 0; q < 4; ++q) *(bf16x8*)(dst + q * 16) = *(const bf16x8*)(src + q * 8);
        }
        __syncthreads();
    }
    if (w < 4) {
        int lane_s = lane; asm volatile("" : "+v"(lane_s));
        float* bu = (float*)(smem + w * 12800);
        bf16_t* hb = (bf16_t*)(smem + w * 12800 + 8448);
        for (int k = 0; k < 8; ++k) {
            const int xq = (x0 + k) & 7;
            unsigned* cnt = cbase + xq * 16;
            while (true) {
                const int wt = wave_next(cnt + 1, lane_s);
                if (wt >= 64) break;
                s5_task(p, l, 2 * xq + (wt >> 5), (wt >> 1) & 15, wt & 1, lane_s, bu, hb);
            }
        }
    }
    int lane_a = lane; asm volatile("" : "+v"(lane_a));
    float* rpbl = (float*)(smem + LDS_RPB + w * 2048);
    const char* Kc = (const char*)(smem + LDS_KC);
    const char* Vc = (const char*)(smem + LDS_VC);
    int staged_h = -1;
    auto run_combo = [&](int xq, int combo, bool cached) {
        unsigned* cnt = cbase + xq * 16;
        while (true) {
            const int wt = wave_next(cnt + 4 + combo, lane_a);
            int kind, b, a, c, h;
            if (!combo_task(combo, wt, ctx_out, xq, kind, b, a, c, h)) break;
            if (kind == 0 && staged_h != h) {
                WAVE_LDS_SYNC();
                for (int i = lane_a; i < 15 * 31; i += 64) rpbl[i] = p.na_rpb[(size_t)(l * 4 + h) * 465 + i] * LOG2E;
                WAVE_LDS_SYNC();
                staged_h = h;
            }
            if (cached) attn_task<true>(p, l, kind, b, a, c, h, lane_a, rpbl, Kc, Vc);
            else attn_task<false>(p, l, kind, b, a, c, h, lane_a, rpbl, Kc, Vc);
        }
    };
    run_combo(x0, mycombo, true);
    const int n_na = ctx_out ? 72 : 64, n_swa = ctx_out ? 144 : 128;
    for (int k = 0; k < 8; ++k) {
        const int xq = (x0 + k) & 7;
        for (int pass = 0; pass < 2; ++pass) {
            unsigned v = 0xffffffffu;
            if (lane_a < 12) v = __hip_atomic_load(cbase + xq * 16 + 4 + lane_a, __ATOMIC_RELAXED, __HIP_MEMORY_SCOPE_AGENT);
            const bool avail = (lane_a < 12) && ((int)v < (lane_a < 8 ? n_na : n_swa));
            unsigned long long mask = __ballot(avail);
            if (mask == 0ull) break;
            while (mask) {
                const int combo = __builtin_ctzll(mask);
                mask &= mask - 1ull;
                run_combo(xq, combo, false);
            }
        }
    }
}

__device__ __forceinline__ void phase_fin(const Params& p, int l, unsigned char* smem) {
    const int tid = opaque_tid(), lane = tid & 63, w = tid >> 6, fr = lane & 15, fq = lane >> 4;
    const bool ctx_out = l < DEPTH - 1;
    unsigned char* big = p.ws + WS_BIG;
    const bf16_t* P = (const bf16_t*)(big + B_P);
    bf16_t* YM = (bf16_t*)(big + B_YM);
    const bf16_t* YS = (const bf16_t*)(big + B_YS);
    const bf16_t* OG = (const bf16_t*)(big + B_OG);
    const bf16_t* WG = (const bf16_t*)(p.ws + WS_WGLU) + (size_t)l * 256 * 256;
    constexpr int TB = 144, ZS = 264;
    bf16_t* zb = (bf16_t*)smem;
    for (int bt = opaque_bid(); bt < NT / TB; bt += gridDim.x) {
        const size_t tok0 = (size_t)bt * TB;
        bf16x8 wA[2][8];
#pragma unroll
        for (int t = 0; t < 2; ++t)
#pragma unroll
            for (int ks = 0; ks < 8; ++ks) wA[t][ks] = *(const bf16x8*)(WG + (size_t)(w * 32 + t * 16 + fr) * 256 + ks * 32 + fq * 8);
        for (int idx = tid; idx < TB * 32; idx += NTH) {
            const int tt = idx >> 5, c = (idx & 31) * 8;
            const size_t tok = tok0 + tt;
            const bf16x8 u = *(const bf16x8*)(P + tok * PSTR + OFF_A + c);
            const bf16x8 yf = *(const bf16x8*)(YS + tok * 256 + c);
            const bf16x8 yr = *(const bf16x8*)(YS + ((size_t)NT + tok) * 256 + c);
            const float4 d0 = *(const float4*)(p.s5_d + l * 256 + c);
            const float4 d1 = *(const float4*)(p.s5_d + l * 256 + c + 4);
            const float dd[8] = {d0.x, d0.y, d0.z, d0.w, d1.x, d1.y, d1.z, d1.w};
            float z[8];
#pragma unroll
            for (int k = 0; k < 8; ++k) z[k] = gelu_tanh(dd[k] * bf2f((bf16_t)u[k]) + bf2f((bf16_t)yf[k]) + bf2f((bf16_t)yr[k]));
            *(bf16x8*)(zb + tt * ZS + c) = pack8(z[0], z[1], z[2], z[3], z[4], z[5], z[6], z[7]);
        }
        __syncthreads();
        for (int tg = 0; tg < TB / 16; ++tg) {
            bf16x8 zB[8];
#pragma unroll
            for (int ks = 0; ks < 8; ++ks) zB[ks] = *(const bf16x8*)(zb + (tg * 16 + fr) * ZS + ks * 32 + fq * 8);
            bf16_t* orow = YM + (tok0 + tg * 16 + fr) * DM;
#pragma unroll
            for (int t = 0; t < 2; ++t) {
                f32x4 acc = (f32x4){0.f, 0.f, 0.f, 0.f};
#pragma unroll
                for (int ks = 0; ks < 8; ++ks) acc = MFMA16(wA[t][ks], zB[ks], acc);
                const int n0 = w * 32 + t * 16 + fq * 4;
                const bf16x4 z4 = *(const bf16x4*)(zb + (tg * 16 + fr) * ZS + n0);
                *(bf16x4*)(orow + n0) = pack4(bf2f((bf16_t)z4[0]) * sigmoidf_(acc[0]), bf2f((bf16_t)z4[1]) * sigmoidf_(acc[1]),
                                              bf2f((bf16_t)z4[2]) * sigmoidf_(acc[2]), bf2f((bf16_t)z4[3]) * sigmoidf_(acc[3]));
            }
        }
        __syncthreads();
    }
    {
        const int gw = opaque_bid() * NW + w, nw = gridDim.x * NW;
        const int tk = lane >> 4, c = (lane & 15) * 16;
        const float4 g0 = *(const float4*)(p.gla_g_norm + l * 64 + (c & 63));
        const float4 g1 = *(const float4*)(p.gla_g_norm + l * 64 + (c & 63) + 4);
        const float4 g2 = *(const float4*)(p.gla_g_norm + l * 64 + (c & 63) + 8);
        const float4 g3 = *(const float4*)(p.gla_g_norm + l * 64 + (c & 63) + 12);
        const float gn[16] = {g0.x, g0.y, g0.z, g0.w, g1.x, g1.y, g1.z, g1.w, g2.x, g2.y, g2.z, g2.w, g3.x, g3.y, g3.z, g3.w};
        for (int t4 = gw; t4 < NT / 4; t4 += nw) {
            const size_t tok = (size_t)t4 * 4 + tk;
            if (!ctx_out && (int)(tok % SL) < CL) continue;
            float o[16]; float ss = 0.f;
#pragma unroll
            for (int hlf = 0; hlf < 2; ++hlf) {
                const bf16x8 a = *(const bf16x8*)(OG + tok * 256 + c + hlf * 8);
                const bf16x8 bq = *(const bf16x8*)(OG + ((size_t)NT + tok) * 256 + c + hlf * 8);
#pragma unroll
                for (int k = 0; k < 8; ++k) { o[hlf * 8 + k] = bf2f((bf16_t)a[k]) + bf2f((bf16_t)bq[k]); ss += o[hlf * 8 + k] * o[hlf * 8 + k]; }
            }
            ss = DPP_ADD(ss, 0xB1); ss = DPP_ADD(ss, 0x4E);
            const float rstd = rsqrtf(ss * (1.f / 64.f) + EPS);
#pragma unroll
            for (int hlf = 0; hlf < 2; ++hlf) {
                const bf16x8 rr = *(const bf16x8*)(P + tok * PSTR + OFF_GR + c + hlf * 8);
                float v[8];
#pragma unroll
                for (int k = 0; k < 8; ++k) v[k] = o[hlf * 8 + k] * rstd * gn[hlf * 8 + k] * siluf_(bf2f((bf16_t)rr[k]));
                *(bf16x8*)(YM + tok * DM + 512 + c + hlf * 8) = pack8(v[0], v[1], v[2], v[3], v[4], v[5], v[6], v[7]);
            }
        }
    }
}

__device__ __forceinline__ void phase_fixup(const Params& p, int l) {
    unsigned char* big = p.ws + WS_BIG;
    bf16_t* ACT = (bf16_t*)(big + B_ACT);
    const bf16_t* GB = (const bf16_t*)(big + B_GB);
    const bf16_t* VB = (const bf16_t*)(big + B_VB);
    const float* cw = p.ffn_conv + (size_t)l * 3 * DFF;
    constexpr int NG = DFF / 8, NS = NT / 64;
    const int total = NS * 2 * NG;
    for (int idx = opaque_bid() * NTH + opaque_tid(); idx < total; idx += gridDim.x * NTH) {
        const int j = (idx % NG) * 8, rs = idx / NG, which = rs & 1, s = rs >> 1;
        const int sin = s % 36;
        if (l == DEPTH - 1 && sin < 4) continue;
        const bf16x8 zero8 = (bf16x8){0, 0, 0, 0, 0, 0, 0, 0};
        bf16x8 gp, gc, gn, vv; int row;
        if (which == 0) {
            row = s * 64;
            const bool hasp = !(sin == 0 || sin == 4);
            gp = hasp ? *(const bf16x8*)(GB + ((size_t)(s - 1) * 4 + 3) * DFF + j) : zero8;
            gc = *(const bf16x8*)(GB + ((size_t)s * 4 + 0) * DFF + j);
            gn = *(const bf16x8*)(GB + ((size_t)s * 4 + 1) * DFF + j);
            vv = *(const bf16x8*)(VB + ((size_t)s * 2 + 0) * DFF + j);
        } else {
            row = s * 64 + 63;
            const bool hasn = !(sin == 3 || sin == 35);
            gp = *(const bf16x8*)(GB + ((size_t)s * 4 + 2) * DFF + j);
            gc = *(const bf16x8*)(GB + ((size_t)s * 4 + 3) * DFF + j);
            gn = hasn ? *(const bf16x8*)(GB + ((size_t)(s + 1) * 4 + 0) * DFF + j) : zero8;
            vv = *(const bf16x8*)(VB + ((size_t)s * 2 + 1) * DFF + j);
        }
        float c0[8], c1[8], c2[8], o[8];
        *(float4*)&c0[0] = *(const float4*)(cw + j); *(float4*)&c0[4] = *(const float4*)(cw + j + 4);
        *(float4*)&c1[0] = *(const float4*)(cw + DFF + j); *(float4*)&c1[4] = *(const float4*)(cw + DFF + j + 4);
        *(float4*)&c2[0] = *(const float4*)(cw + 2 * DFF + j); *(float4*)&c2[4] = *(const float4*)(cw + 2 * DFF + j + 4);
#pragma unroll
        for (int k = 0; k < 8; ++k) {
            const float gg = c0[k] * bf2f((bf16_t)gp[k]) + c1[k] * bf2f((bf16_t)gc[k]) + c2[k] * bf2f((bf16_t)gn[k]);
            o[k] = gelu_tanh(gg) * bf2f((bf16_t)vv[k]);
        }
        *(bf16x8*)(ACT + (size_t)row * DFF + j) = pack8(o[0], o[1], o[2], o[3], o[4], o[5], o[6], o[7]);
    }
}

#define LAUNDER(ptr) asm volatile("" : "+s"(ptr))
__device__ __forceinline__ void run_phase(const Params& p0, int ph, unsigned char* smem) {
    Params p = p0;
    { size_t zoff = 0; asm volatile("" : "+s"(zoff)); p.ws = p0.ws + zoff; }
    unsigned char* big = p.ws + WS_BIG;
    if (ph == 0) { phase_mod(p, smem); return; }
    if (ph == 1) { phase_pre0(p, smem); phase_rowwise(p, 0, 0); return; }
    const int l = ph < NPRE ? 0 : (ph - NPRE) / NPL, q = ph < NPRE ? -1 : (ph - NPRE) % NPL;
    const bool last = (l == DEPTH - 1);
    if (q == 5 || q == 9) {
        phase_rowwise(p, q == 5 ? 1 : 2, l);
    } else if (q == 1) {
        phase_prep(p, smem);
    } else if (q == 2) {
        phase_mix(p, l, l, smem);
    } else if (q == 3) {
        phase_fin(p, l, smem);
    } else if (q == 7) {
        phase_fixup(p, l);
    } else if (q == 6) {
        pg8::Gemm g; g.A = (const bf16_t*)(big + B_HFFN); g.Bt = (const bf16_t*)(p.ws + WS_WUP) + (size_t)l * DUP * DM; g.M = NT; g.N = DUP; g.K = DM; g.ld = DM;
        EpiConv E; E.ACT = (bf16_t*)(big + B_ACT); E.GB = (bf16_t*)(big + B_GB); E.VB = (bf16_t*)(big + B_VB); E.cw = p.ffn_conv + (size_t)l * 3 * DFF;
        SkipOrder S; S.skip = last ? 1 : 0;
        S.init(last ? (g.M / 9) * 8 : g.M, g.N, (int)gridDim.x, opaque_bid());
        pg8::gemm_phase<EpiConv, SkipOrder>((PG8_LAS unsigned char*)smem, g, S, E, nullptr);
    } else {
        pg8::Gemm g; EpiStore E; E.split_cols = 0; E.split_stride = 0; int skip = last ? 1 : 0;
        if (q == 0) {
            g.A = (const bf16_t*)(big + B_HMIX); g.Bt = (const bf16_t*)(p.ws + WS_WIN) + (size_t)l * PSTR * DM; g.M = NT; g.N = PSTR; g.K = DM; g.ld = DM;
            E.O = (bf16_t*)(big + B_P); E.ldc = PSTR; skip = 0;
        } else if (q == 4) {
            g.A = (const bf16_t*)(big + B_YM); g.Bt = (const bf16_t*)(p.ws + WS_WOUT) + (size_t)l * DM * DM; g.M = NT; g.N = DM; g.K = DM; g.ld = DM;
            E.O = (bf16_t*)(big + B_T); E.ldc = DM; if (!last) skip = 1;
        } else {
            g.A = (const bf16_t*)(big + B_ACT); g.Bt = (const bf16_t*)(p.ws + WS_WDOWN) + (size_t)l * DM * DFF; g.M = NT; g.N = DM; g.K = DFF; g.ld = DFF;
            E.O = (bf16_t*)(big + B_T); E.ldc = DM; skip = 1;
        }
        SkipOrder S; S.skip = skip;
        S.init(skip ? (g.M / 9) * 8 : g.M, g.N, (int)gridDim.x, opaque_bid());
        pg8::gemm_phase<EpiStore, SkipOrder>((PG8_LAS unsigned char*)smem, g, S, E, nullptr);
        if ((q == 8 || q == 4) && !last) {
#pragma unroll 1
            for (int kq = 0; kq < 2; ++kq) {
                const int kh = g.K / 2;
                pg8::Gemm g2 = g; g2.A = g.A + kq * kh; g2.Bt = g.Bt + kq * kh; g2.K = kh; g2.ld = g.K; g2.M = NBATCH * 256;
                EpiPart E2; E2.O = (float*)(big + (q == 8 ? B_PART : B_ACT)) + (size_t)kq * NBATCH * CL * DM;
                CtxOrder S2; S2.init(g2.M, g2.N, (int)gridDim.x, (opaque_bid() + (int)gridDim.x - kq * 64) % (int)gridDim.x);
                pg8::gemm_phase<EpiPart, CtxOrder>((PG8_LAS unsigned char*)smem, g2, S2, E2, nullptr);
            }
        }
    }
}

__global__ void __launch_bounds__(NTH, 2) mega(Params p) {
    extern __shared__ __attribute__((aligned(16))) unsigned char smem[];
    if (threadIdx.x < 64) ((volatile unsigned*)(smem + LDS_MAIN))[threadIdx.x] = 0u;
    __syncthreads();
    XcdBarrier bar = xcd_barrier_post((unsigned*)(p.ws + WS_BAR), (volatile LAS unsigned*)(smem + LDS_MAIN));
    if (p.phase_lo < 0) cg::this_grid().sync();
    for (int ph = p.phase_lo; ph < p.phase_hi; ++ph) {
        run_phase(p, ph, smem);
        if (ph + 1 < p.phase_hi) xcd_barrier(bar);
    }
}

extern "C" void kernel_launch(void* const* d_in, const int* in_sizes, int n_in, void* d_out, int out_size, void* d_ws, size_t ws_size,
                              hipStream_t stream) {
    Params p{};
    const float** f = (const float**)&p;
    for (int i = 0; i < 29; ++i) f[i] = (const float*)d_in[i];
    p.out = (float*)d_out;
    p.ws = (unsigned char*)d_ws;
    static int grid_blocks = 0;
    if (!grid_blocks) {
        int dev = 0, cus = 0;
        (void)hipGetDevice(&dev);
        (void)hipDeviceGetAttribute(&cus, hipDeviceAttributeMultiprocessorCount, dev);
        (void)hipFuncSetAttribute((const void*)mega, hipFuncAttributeMaxDynamicSharedMemorySize, LDS_BYTES);
        grid_blocks = cus;
        if (ws_size < WS_TOTAL) fprintf(stderr, "workspace too small: %zu < %zu\n", ws_size, (size_t)WS_TOTAL);
    }
    (void)hipMemsetAsync((char*)d_ws + WS_CNT, 0, WS_CTL_BYTES, stream);
    p.phase_lo = 0; p.phase_hi = NPHASE;
    void* args[] = {&p};
    hipError_t e = hipLaunchCooperativeKernel((void*)mega, dim3(grid_blocks), dim3(NTH), args, LDS_BYTES, stream);
    if (e != hipSuccess) fprintf(stderr, "cooperative launch failed: %s (grid %d)\n", hipGetErrorString(e), grid_blocks);
}
```

```cpp
#include <hip/hip_runtime.h>
#include <hip/hip_cooperative_groups.h>
#include <cstdio>
namespace cg = cooperative_groups;

__device__ __forceinline__ int pg8_opaque_tid() { int t = threadIdx.x; asm volatile("" : "+v"(t)); return t; }
namespace pg8 {
#define PG8_LAS __attribute__((address_space(3)))
typedef unsigned short bf16_t;
typedef short bf16x8 __attribute__((ext_vector_type(8)));
typedef float f32x4 __attribute__((ext_vector_type(4)));
typedef unsigned u32x4 __attribute__((ext_vector_type(4)));
constexpr int BM = 256, BK = 64, HALF = 128, HTB = HALF * BK * 2  , STAGE_BYTES = 8 * HTB, NXCD = 8, WGM = 8;

__host__ __device__ __forceinline__ int lds_byte(int r, int c) { const int st = (r >> 4) * 2 + (c >> 5), rr = r & 15, cc = c & 31, ob = rr * 64 + cc * 2; return st * 1024 + (ob ^ (((ob >> 9) & 1) << 5)); }
__host__ __device__ __forceinline__ void stage_rc(int b, int& R, int& C) { const int st = b / 1024, sb = b % 1024, swz = sb ^ (((sb >> 9) & 1) << 5); R = (st >> 1) * 16 + swz / 64; C = (st & 1) * 32 + (swz % 64) / 2; }
__host__ __device__ __forceinline__ int perm32(int rho) { const int n = rho >> 4, i = rho & 15; return 8 * (i >> 2) + 4 * n + (i & 3); }

struct Unit { int pm, pn; };
struct Gemm { const bf16_t* A; const bf16_t* Bt; int M, N, K, ld; };

struct StaticOrder {
    int nM, nN, nwg, G, c;
    __host__ __device__ void init(int M, int N, int G_, int c_) { nM = M / BM; nN = N / BM; nwg = nM * nN; G = G_; c = c_; }
    __host__ __device__ bool next(int i, Unit& u) const {
        const long L = (long)i * G + c; if (L >= nwg) return false;
        int wgid = (int)L; { const int q = nwg / NXCD, r = nwg % NXCD, xcd = wgid % NXCD, off = wgid / NXCD; wgid = (xcd < r ? xcd * (q + 1) : r * (q + 1) + (xcd - r) * q) + off; }
        const int nig = WGM * nN, gid = wgid / nig, fm = gid * WGM, gsz = (nM - fm) < WGM ? (nM - fm) : WGM;
        u.pm = fm + ((wgid % nig) % gsz); u.pn = (wgid % nig) / gsz; return true;
    }
    __device__ __forceinline__ void a_ready(const Unit&) const {}
    __device__ __forceinline__ void done(const Unit&) const {}
};
__device__ __forceinline__ unsigned cvt_pk_bf16(float lo, float hi) { unsigned r; asm volatile("v_cvt_pk_bf16_f32 %0, %1, %2" : "=v"(r) : "v"(lo), "v"(hi)); return r; }
template <class Epi, class Sched, bool STAMP = false>
__device__ __forceinline__ void gemm_phase(PG8_LAS unsigned char* lds, const Gemm g, const Sched& S, const Epi& E, unsigned long long* stamps) {
    const int tid = pg8_opaque_tid(), wid = __builtin_amdgcn_readfirstlane(tid >> 6), lane = tid & 63, wr = wid >> 2, wc = wid & 3, fr = lane & 15, fq = lane >> 4;
    const int K = g.K, nt = K / BK, LD = g.ld;
    int ts_lo = 0, ts_hi = 0, nts = 0; const unsigned long long rt_entry = STAMP ? (unsigned long long)wall_clock64() : 0ull;
#define PG8_STAMP() do { if (STAMP && wid == 0 && nts < 64) { const unsigned long long _c = (unsigned long long)clock64(); \
        ts_lo = (lane == nts) ? (int)(unsigned)_c : ts_lo; ts_hi = (lane == nts) ? (int)(unsigned)(_c >> 32) : ts_hi; ++nts; } } while (0)
    PG8_STAMP();
    unsigned voffA[2], voffB[2];
#pragma unroll
    for (int i = 0; i < 2; ++i) { int R, C; stage_rc(tid * 16 + i * 8192, R, C); const int Rb = Epi::PERM ? ((R & ~31) + perm32(R & 31)) : R;
        voffA[i] = (unsigned)(R * LD + C) * 2u; voffB[i] = (unsigned)(Rb * LD + C) * 2u; }
    const size_t kstep = (size_t)(BK * 2);
    const size_t hstep = (size_t)HALF * LD * 2;
    const size_t tstep = 2 * hstep;
    const unsigned ldsw = (unsigned)wid * 1024u;
    const int aoff = lds_byte(wr * 64 + fr, fq * 8), boff = lds_byte(wc * 32 + fr, fq * 8);
#define PG8_SA(b, h) (((b) * 2 + (h)) * HTB)
#define PG8_SB(b, h) ((4 + (b) * 2 + (h)) * HTB)
#define PG8_STAGE(bufoff, gbase, voff) do { _Pragma("unroll") for (int _i = 0; _i < 2; ++_i) \
        __builtin_amdgcn_global_load_lds((const unsigned*)((const char*)(gbase) + (voff)[_i]), (PG8_LAS unsigned*)(lds + (bufoff) + ldsw + _i * 8192), 16, 0, 0); } while (0)
#define PG8_LDA(dst, b, h) do { _Pragma("unroll") for (int m = 0; m < 4; ++m) _Pragma("unroll") for (int k = 0; k < 2; ++k) dst[m][k] = *(const PG8_LAS bf16x8*)(lds + PG8_SA(b, h) + aoff + m * 2048 + k * 1024); } while (0)
#define PG8_LDB(dst, b, h) do { _Pragma("unroll") for (int n = 0; n < 2; ++n) _Pragma("unroll") for (int k = 0; k < 2; ++k) dst[n][k] = *(const PG8_LAS bf16x8*)(lds + PG8_SB(b, h) + boff + n * 2048 + k * 1024); } while (0)
#define PG8_MMA(ai, bj, At, Bt) do { __builtin_amdgcn_s_setprio(1); _Pragma("unroll") for (int m = 0; m < 4; ++m) _Pragma("unroll") for (int n = 0; n < 2; ++n) _Pragma("unroll") for (int k = 0; k < 2; ++k) \
        acc[ai][bj][m][n] = __builtin_amdgcn_mfma_f32_16x16x32_bf16(Bt[n][k], At[m][k], acc[ai][bj][m][n], 0, 0, 0); __builtin_amdgcn_s_setprio(0); } while (0)
#define PG8_WAIT_V(n) asm volatile("s_waitcnt vmcnt(" #n ")" ::: "memory")
#define PG8_WAIT_L(n) asm volatile("s_waitcnt lgkmcnt(" #n ")" ::: "memory")
#define PG8_BAR __builtin_amdgcn_s_barrier()
#define PG8_SCHED __builtin_amdgcn_sched_barrier(0)
    Unit cur, nxt; int ui = 0;
    if (!S.next(0, cur)) return;
    f32x4 acc[2][2][4][2];
#pragma unroll
    for (int a = 0; a < 2; ++a)
#pragma unroll
        for (int b = 0; b < 2; ++b)
#pragma unroll
            for (int m = 0; m < 4; ++m)
#pragma unroll
                for (int n = 0; n < 2; ++n) acc[a][b][m][n] = (f32x4){0.f, 0.f, 0.f, 0.f};
    bf16x8 At[4][2], B0[2][2], B1[2][2];
    const char* cA = (const char*)g.A + (size_t)cur.pm * tstep; const char* cB = (const char*)g.Bt + (size_t)cur.pn * tstep;
    S.a_ready(cur);
    PG8_STAGE(PG8_SB(0, 0), cB, voffB); PG8_STAGE(PG8_SA(0, 0), cA, voffA); PG8_STAGE(PG8_SB(0, 1), cB + hstep, voffB); PG8_STAGE(PG8_SA(0, 1), cA + hstep, voffA);
    if (wr == 1) PG8_BAR;
    PG8_WAIT_V(4); PG8_BAR;
    PG8_STAGE(PG8_SB(1, 0), cB + kstep, voffB); PG8_STAGE(PG8_SA(1, 0), cA + kstep, voffA); PG8_STAGE(PG8_SB(1, 1), cB + hstep + kstep, voffB);
    PG8_WAIT_V(6); PG8_BAR;
    PG8_STAMP();
    for (;;) {
        const bool has_next = S.next(ui + 1, nxt);
        const char* nA = has_next ? (const char*)g.A + (size_t)nxt.pm * tstep : cA; const char* nB = has_next ? (const char*)g.Bt + (size_t)nxt.pn * tstep : cB;
        for (int t = 0; t < nt; t += 2) {
            const bool last = (t == nt - 2);
            const char* a1 = cA + (size_t)(t + 1) * kstep;
            const char* a2 = last ? nA : cA + (size_t)(t + 2) * kstep; const char* b2 = last ? nB : cB + (size_t)(t + 2) * kstep;
            const char* a3 = a2 + kstep; const char* b3 = b2 + kstep;
            if (last && has_next) S.a_ready(nxt);
            PG8_LDB(B0, 0, 0); PG8_SCHED; PG8_LDA(At, 0, 0); PG8_STAGE(PG8_SA(1, 1), a1 + hstep, voffA);
            PG8_WAIT_L(8); PG8_BAR; PG8_WAIT_L(0); PG8_MMA(0, 0, At, B0); PG8_BAR; PG8_SCHED;
            PG8_LDB(B1, 0, 1); PG8_STAGE(PG8_SB(0, 0), b2, voffB);
            PG8_BAR; PG8_WAIT_L(0); PG8_MMA(0, 1, At, B1); PG8_BAR;
            PG8_LDA(At, 0, 1); PG8_STAGE(PG8_SA(0, 0), a2, voffA);
            PG8_BAR; PG8_WAIT_L(0); PG8_MMA(1, 0, At, B0); PG8_BAR; PG8_SCHED;
            PG8_STAGE(PG8_SB(0, 1), b2 + hstep, voffB);
            PG8_WAIT_V(6); PG8_BAR; PG8_MMA(1, 1, At, B1); PG8_BAR;
            PG8_LDB(B0, 1, 0); PG8_SCHED; PG8_LDA(At, 1, 0); PG8_STAGE(PG8_SA(0, 1), a2 + hstep, voffA);
            PG8_WAIT_L(8); PG8_BAR; PG8_WAIT_L(0); PG8_MMA(0, 0, At, B0); PG8_BAR; PG8_SCHED;
            PG8_LDB(B1, 1, 1); PG8_STAGE(PG8_SB(1, 0), b3, voffB);
            PG8_BAR; PG8_WAIT_L(0); PG8_MMA(0, 1, At, B1); PG8_BAR;
            PG8_LDA(At, 1, 1); PG8_STAGE(PG8_SA(1, 0), a3, voffA);
            PG8_BAR; PG8_WAIT_L(0); PG8_MMA(1, 0, At, B0); PG8_BAR; PG8_SCHED;
            PG8_STAGE(PG8_SB(1, 1), b3 + hstep, voffB);
            PG8_WAIT_V(6); PG8_BAR; PG8_MMA(1, 1, At, B1); PG8_BAR;
        }
        PG8_STAMP();
        if constexpr (!Epi::AFTER_DRAIN) { E(acc, cur, wr, wc, fr, fq); S.done(cur); }
        PG8_STAMP();
        if (!has_next) break;
#pragma unroll
        for (int a = 0; a < 2; ++a)
#pragma unroll
            for (int b = 0; b < 2; ++b)
#pragma unroll
                for (int m = 0; m < 4; ++m)
#pragma unroll
                    for (int n = 0; n < 2; ++n) acc[a][b][m][n] = (f32x4){0.f, 0.f, 0.f, 0.f};
        cur = nxt; cA = nA; cB = nB; ++ui;
    }
    PG8_WAIT_V(0);
    if (wr == 0) PG8_BAR;
    PG8_BAR;
    if constexpr (Epi::AFTER_DRAIN) { E.fused(acc, cur, wr, wc, fr, fq, lds, wid, lane); S.done(cur); }
    PG8_STAMP();
    if (STAMP && wid == 0) { stamps[lane] = lane < nts ? (((unsigned long long)(unsigned)ts_hi << 32) | (unsigned)ts_lo) : 0ull;
        if (lane == 62) stamps[62] = rt_entry; if (lane == 63) stamps[63] = (unsigned long long)wall_clock64(); }
#undef PG8_STAMP
#undef PG8_SA
#undef PG8_SB
#undef PG8_STAGE
#undef PG8_LDA
#undef PG8_LDB
#undef PG8_MMA
#undef PG8_WAIT_V
#undef PG8_WAIT_L
#undef PG8_BAR
#undef PG8_SCHED
}
}


#define XB_SPIN_CAP_OVERRIDE 1
#define XB_TMO      128
#define XB_XCNT(j)  (256  + 64 * (j))
#define XB_XSUB(j)  (1280 + 64 * (j))
#define XB_XGEN(j)  (2304 + 64 * (j))
#define XB_TOP      3328
#define XB_TOPGEN   3392
#define XCD_BAR_WORDS 3456
#define XB_SPIN_CAP (1u << 22)
#define LAS __attribute__((address_space(3)))

__device__ __forceinline__ unsigned xb_ld(unsigned* p)              { return __hip_atomic_load(p, __ATOMIC_RELAXED, __HIP_MEMORY_SCOPE_AGENT); }
__device__ __forceinline__ unsigned xb_add(unsigned* p, unsigned v) { return __hip_atomic_fetch_add(p, v, __ATOMIC_RELAXED, __HIP_MEMORY_SCOPE_AGENT); }
__device__ __forceinline__ unsigned xb_xcc_id() { return (unsigned)__builtin_amdgcn_s_getreg((3 << 11) | 20) & 0xFu; }
#define XB_SPIN(cond, bar) do { unsigned _sp = 0; while (cond) { __builtin_amdgcn_s_sleep(1); \
    if ((++_sp & 255u) == 0u) { if (xb_ld(&(bar)[XB_TMO])) break; if (_sp > XB_SPIN_CAP) { atomicAdd(&(bar)[XB_TMO], 1u); break; } } } } while (0)

struct XcdBarrier {
    unsigned* bar; unsigned x;
    volatile LAS unsigned* st;
};

__device__ __forceinline__ XcdBarrier xcd_barrier_post(unsigned* bar, volatile LAS unsigned* st) {
    XcdBarrier b; b.bar = bar; b.x = xb_xcc_id(); b.st = st;
    if (threadIdx.x == 0) (void)xb_add(&bar[XB_XCNT(b.x)], 1u);
    return b;
}
__device__ __forceinline__ void xcd_barrier_complete(unsigned* bar, unsigned x, unsigned& nloc, unsigned& nx) {
    const unsigned G = gridDim.x * gridDim.y * gridDim.z;
    unsigned sum, cnt, mine, sp = 0u;
    for (;;) {
        sum = 0u; cnt = 0u; mine = 0u;
#pragma unroll
        for (unsigned j = 0; j < 16; ++j) { const unsigned c = xb_ld(&bar[XB_XCNT(j)]); sum += c; cnt += (c > 0u) ? 1u : 0u; mine = (j == x) ? c : mine; }
        if (sum == G) break;
        __builtin_amdgcn_s_sleep(1);
        if ((++sp & 255u) == 0u) { if (xb_ld(&bar[XB_TMO])) break; if (sp > XB_SPIN_CAP) { atomicAdd(&bar[XB_TMO], 1u); break; } }
    }
    nloc = mine > 0u ? mine : 1u; nx = cnt > 0u ? cnt : 1u;
}

__device__ __forceinline__ void xcd_barrier(const XcdBarrier& b) {
    asm volatile("s_waitcnt vmcnt(0)" ::: "memory");
    __syncthreads();
    if (threadIdx.x == 0) {
        unsigned* bar = b.bar;
        __builtin_amdgcn_s_waitcnt(0);
        unsigned nloc = b.st[0], nx = b.st[1];
        if (nloc == 0u) { xcd_barrier_complete(bar, b.x, nloc, nx); b.st[0] = nloc; b.st[1] = nx; }
        const unsigned old = xb_add(&bar[XB_XSUB(b.x)], 1u);
        const unsigned gen = old / nloc;
        if (old + 1u == (gen + 1u) * nloc) {
            __builtin_amdgcn_fence(__ATOMIC_RELEASE, "agent");
            asm volatile("s_waitcnt vmcnt(0)" ::: "memory");
            const unsigned og = xb_add(&bar[XB_TOP], 1u);
            const unsigned tg = og / nx;
            if (og + 1u == (tg + 1u) * nx) xb_add(&bar[XB_TOPGEN], 1u);
            else XB_SPIN(xb_ld(&bar[XB_TOPGEN]) == tg, bar);
            __builtin_amdgcn_fence(__ATOMIC_ACQUIRE, "agent");
            xb_add(&bar[XB_XGEN(b.x)], 1u);
            asm volatile("s_waitcnt vmcnt(0)" ::: "memory");
        } else {
            XB_SPIN(xb_ld(&bar[XB_XGEN(b.x)]) == gen, bar);
            __builtin_amdgcn_fence(__ATOMIC_ACQUIRE, "agent");
            asm volatile("s_waitcnt vmcnt(0)" ::: "memory");
        }
    }
    __syncthreads();
}


typedef unsigned short bf16_t;
typedef short bf16x8 __attribute__((ext_vector_type(8)));
typedef short bf16x4 __attribute__((ext_vector_type(4)));
typedef float f32x4 __attribute__((ext_vector_type(4)));
typedef unsigned u32x4 __attribute__((ext_vector_type(4)));
#define MFMA16(a, b, c) __builtin_amdgcn_mfma_f32_16x16x32_bf16(a, b, c, 0, 0, 0)
#define WAVE_LDS_SYNC() asm volatile("s_waitcnt lgkmcnt(0)" ::: "memory")

constexpr int NTH = 512, NW = 8;
constexpr int DM = 1024, NBATCH = 16, SEQ = 2048, CL = 256, SL = 2304, NT = NBATCH * SL, DEPTH = 4;
constexpr int DIN = 2592, PSTR = 2816, DFF = 2816, DUP = 5632, HALF_T = NT / 2;
constexpr int OFF_A = 0, OFF_NAQ = 256, OFF_NAK = 512, OFF_NAV = 768, OFF_GQ = 1024, OFF_GK = 1280, OFF_GV = 1536,
              OFF_GF = 1792, OFF_GB = 1808, OFF_GR = 1824, OFF_SQ = 2080, OFF_SK = 2336, OFF_SV = 2464;
constexpr float EPS = 1e-6f;
constexpr float NEG = -1e30f;

constexpr size_t WS_XC = 0;
constexpr size_t WS_WIN = WS_XC + (size_t)NBATCH * CL * DM * 4;
constexpr size_t WS_WOUT = WS_WIN + (size_t)DEPTH * PSTR * DM * 2;
constexpr size_t WS_WUP = WS_WOUT + (size_t)DEPTH * DM * DM * 2;
constexpr size_t WS_WDOWN = WS_WUP + (size_t)DEPTH * DUP * DM * 2;
constexpr size_t WS_WGLU = WS_WDOWN + (size_t)DEPTH * DM * DFF * 2;
constexpr size_t WS_SC = WS_WGLU + (size_t)DEPTH * 256 * 256 * 2;
constexpr size_t WS_MOD = WS_SC + (size_t)17 * 1024 * 4;
constexpr size_t WS_CNT = WS_MOD + (size_t)DEPTH * 17 * 6144 * 4;
constexpr size_t WS_BAR = WS_CNT + 4096;
constexpr size_t WS_CTL_BYTES = 4096 + (size_t)XCD_BAR_WORDS * 4;
constexpr size_t WS_BIG = (WS_BAR + (size_t)XCD_BAR_WORDS * 4 + 255) / 256 * 256;
constexpr size_t B_P = 0;
constexpr size_t B_YM = B_P + (size_t)NT * PSTR * 2;
constexpr size_t B_VTN = B_YM + (size_t)NT * DM * 2;
constexpr size_t B_VTS = B_VTN + (size_t)NBATCH * 4 * 64 * SL * 2;
constexpr size_t B_YS = B_VTS + (size_t)NBATCH * 2 * 64 * SL * 2;
constexpr size_t B_OG = B_YS + (size_t)2 * NT * 256 * 2;
constexpr size_t B_END = B_OG + (size_t)2 * NT * 256 * 2;
constexpr size_t B_T = 0;
constexpr size_t B_ACT = B_T + (size_t)NT * DM * 2;
constexpr size_t B_HFFN = B_ACT + (size_t)NT * DFF * 2;
constexpr size_t B_GB = B_HFFN + (size_t)NT * DM * 2;
constexpr size_t B_VB = B_GB + (size_t)(NT / 64) * 4 * DFF * 2;
constexpr size_t B_HMIX = B_YM;
constexpr size_t B_PART = B_HFFN;
static_assert(B_VB + (size_t)(NT / 64) * 2 * DFF * 2 <= B_END, "ws overlay");
constexpr size_t WS_TOTAL = WS_BIG + B_END;

constexpr int LDS_MAIN = 139264, LDS_BYTES = LDS_MAIN + 256;
constexpr int LDS_KC = 51200, LDS_VC = LDS_KC + 256 * 144, LDS_RPB = LDS_VC + 64 * 528;
static_assert(LDS_RPB + 8 * 2048 <= LDS_MAIN, "lds map");
constexpr int NPRE = 2, NPL = 10, NPHASE = NPRE + DEPTH * NPL;

struct Params {
    const float *x, *c, *ctx, *c_ctx, *w_mod, *b_mod, *g_pre_mix, *g_post_mix, *g_pre_ffn, *g_post_ffn, *w_in, *w_out;
    const float *s5_lam_re, *s5_lam_im, *s5_b_re, *s5_b_im, *s5_c_re, *s5_c_im, *s5_log_step, *s5_d, *s5_w_glu;
    const float *na_rpb, *gla_w_gate2, *gla_b_gate, *gla_g_norm, *swa_sink, *ffn_w_up, *ffn_conv, *ffn_w_down;
    float* out;
    unsigned char* ws;
    int phase_lo, phase_hi;
};

__device__ __forceinline__ float bf2f(bf16_t h) { return __uint_as_float(((unsigned)h) << 16); }
__device__ __forceinline__ bf16_t f2bf(float f) { return __builtin_bit_cast(bf16_t, (__bf16)f); }
__device__ __forceinline__ float sigmoidf_(float x) { return 1.f / (1.f + __expf(-x)); }
__device__ __forceinline__ float siluf_(float x) { return x / (1.f + __expf(-x)); }
__device__ __forceinline__ float gelu_tanh(float x) {
    float u = 1.5957691216f * (x + 0.044715f * x * x * x);
    return x / (1.f + __expf(-u));
}
#define DPP_ADD(v, CTRL) ((v) + __uint_as_float(__builtin_amdgcn_update_dpp(0u, __float_as_uint(v), (CTRL), 0xF, 0xF, false)))
__device__ __forceinline__ float wave_sum(float v) {
    v = DPP_ADD(v, 0xB1);
    v = DPP_ADD(v, 0x4E);
    v = DPP_ADD(v, 0x141);
    v = DPP_ADD(v, 0x140);
    unsigned x = __float_as_uint(v);
    auto r = __builtin_amdgcn_permlane16_swap(x, x, false, false);
    v = __uint_as_float(r[0]) + __uint_as_float(r[1]);
    x = __float_as_uint(v);
    auto r2 = __builtin_amdgcn_permlane32_swap(x, x, false, false);
    return __uint_as_float(r2[0]) + __uint_as_float(r2[1]);
}
typedef unsigned u32x2 __attribute__((ext_vector_type(2)));
typedef float f32x2_t __attribute__((ext_vector_type(2)));
typedef __bf16 bf16v2_t __attribute__((ext_vector_type(2)));
__device__ __forceinline__ unsigned cvt2(float lo, float hi) { f32x2_t v = {lo, hi}; return __builtin_bit_cast(unsigned, __builtin_convertvector(v, bf16v2_t)); }
__device__ __forceinline__ bf16x4 pack4(float a, float b, float c, float d) {
    u32x2 r; r.x = cvt2(a, b); r.y = cvt2(c, d);
    return __builtin_bit_cast(bf16x4, r);
}
__device__ __forceinline__ bf16x8 pack8(float a, float b, float c, float d, float e, float f, float g, float h) {
    u32x4 r; r.x = cvt2(a, b); r.y = cvt2(c, d); r.z = cvt2(e, f); r.w = cvt2(g, h);
    return __builtin_bit_cast(bf16x8, r);
}
__device__ __forceinline__ int s_of(int dir, int i) { return dir == 0 ? i : (i < CL ? (CL - 1 - i) : (SL + CL - 1 - i)); }
__device__ __forceinline__ int clampi(int v, int lo, int hi) { return v < lo ? lo : (v > hi ? hi : v); }
__device__ __forceinline__ int opaque_tid() { int t = threadIdx.x; asm volatile("" : "+v"(t)); return t; }
__device__ __forceinline__ int opaque_bid() { int b = blockIdx.x; asm volatile("" : "+s"(b)); return b; }

__device__ __forceinline__ void phase_pre0(const Params& p, unsigned char* smem) {
    float(*tile)[65] = (float(*)[65])smem;
    const int tid = opaque_tid();
    constexpr int T_IN = 16 * 44, T_OUT = 16 * 16, T_UP = 16 * 88, T_DOWN = 44 * 16, T_GLU = 4 * 4;
    constexpr int T_L = T_IN + T_OUT + T_UP + T_DOWN + T_GLU;
    for (int task = opaque_bid(); task < DEPTH * T_L; task += gridDim.x) {
        const int l = task / T_L;
        int r = task % T_L;
        const float* src; bf16_t* dst; int K, N, nkt;
        if (r < T_IN) { src = p.w_in + (size_t)l * DM * DIN; dst = (bf16_t*)(p.ws + WS_WIN) + (size_t)l * PSTR * DM; K = DM; N = DIN; nkt = 16; }
        else if ((r -= T_IN) < T_OUT) { src = p.w_out + (size_t)l * DM * DM; dst = (bf16_t*)(p.ws + WS_WOUT) + (size_t)l * DM * DM; K = DM; N = DM; nkt = 16; }
        else if ((r -= T_OUT) < T_UP) { src = p.ffn_w_up + (size_t)l * DM * DUP; dst = (bf16_t*)(p.ws + WS_WUP) + (size_t)l * DUP * DM; K = DM; N = DUP; nkt = 16; }
        else if ((r -= T_UP) < T_DOWN) { src = p.ffn_w_down + (size_t)l * DFF * DM; dst = (bf16_t*)(p.ws + WS_WDOWN) + (size_t)l * DM * DFF; K = DFF; N = DM; nkt = 44; }
        else { r -= T_DOWN; src = p.s5_w_glu + (size_t)l * 256 * 256; dst = (bf16_t*)(p.ws + WS_WGLU) + (size_t)l * 256 * 256; K = 256; N = 256; nkt = 4; }
        const int kt = r % nkt, nt = r / nkt, k0 = kt * 64, n0 = nt * 64;
        const int tx = tid & 63, ty = tid >> 6;
#pragma unroll
        for (int i = 0; i < 8; ++i) {
            const int k = ty + 8 * i, n = n0 + tx;
            tile[k][tx] = (n < N) ? src[(size_t)(k0 + k) * N + n] : 0.f;
        }
        __syncthreads();
#pragma unroll
        for (int i = 0; i < 8; ++i) {
            const int n = ty + 8 * i;
            int nrow = n0 + n;
            if (N == DUP) { const int nn = nrow < DFF ? nrow : nrow - DFF; nrow = (nn >> 7) * 256 + (nrow < DFF ? 0 : 128) + (nn & 127); }
            dst[(size_t)nrow * K + k0 + tx] = f2bf(tile[tx][n]);
        }
        __syncthreads();
    }
}

__device__ __forceinline__ void phase_mod(const Params& p, unsigned char* smem) {
    float* red = (float*)smem;
    float* scl = (float*)(smem + 36864);
    const int tid = opaque_tid(), lane = tid & 63;
    const int w = __builtin_amdgcn_readfirstlane(tid >> 6);
    float* MOD = (float*)(p.ws + WS_MOD);
    for (int i = tid; i < 17 * 1024; i += NTH) {
        const float v = (i < 16 * 1024) ? p.c[i] : p.c_ctx[i - 16 * 1024];
        scl[i] = siluf_(v);
    }
    __syncthreads();
    for (int task = opaque_bid(); task < DEPTH * 96; task += gridDim.x) {
        const int l = task / 96, j0 = (task % 96) * 64;
        const float* W = p.w_mod + (size_t)l * DM * 6144 + j0 + lane;
        float acc[17];
#pragma unroll
        for (int r = 0; r < 17; ++r) acc[r] = 0.f;
        for (int k = w * 128; k < w * 128 + 128; ++k) {
            const float wv = W[(size_t)k * 6144];
#pragma unroll
            for (int r = 0; r < 17; ++r) acc[r] += scl[r * 1024 + k] * wv;
        }
#pragma unroll
        for (int r = 0; r < 17; ++r) red[(w * 17 + r) * 64 + lane] = acc[r];
        __syncthreads();
        for (int i = tid; i < 17 * 64; i += NTH) {
            const int r = i >> 6, jj = i & 63;
            float s = 0.f;
#pragma unroll
            for (int ww = 0; ww < NW; ++ww) s += red[(ww * 17 + r) * 64 + jj];
            MOD[((size_t)(l * 17 + r)) * 6144 + j0 + jj] = s + p.b_mod[l * 6144 + j0 + jj];
        }
        __syncthreads();
    }
}

__device__ __forceinline__ void phase_rowwise(const Params& p, int mode, int l) {
    const int tid = opaque_tid();
    const int lane = tid & 63;
    const int gw = opaque_bid() * NW + (tid >> 6), nw = gridDim.x * NW;
    const float* MOD = (const float*)(p.ws + WS_MOD);
    float* Xc = (float*)(p.ws + WS_XC);
    unsigned char* big = p.ws + WS_BIG;
    const bf16_t* T = (const bf16_t*)(big + B_T);
    bf16_t* Hdst = (bf16_t*)(big + (mode == 1 ? B_HFFN : B_HMIX));
    const bool in_from_input = (l == 0 && mode != 2);
    const bool skipctx = (l == DEPTH - 1 && mode != 0);
    const int nrows = skipctx ? NBATCH * SEQ : NT;
    for (int i0 = gw; i0 < nrows; i0 += 2 * nw) {
        int tt[2]; bool ok[2];
        const float* xin[2]; float* xout[2]; int modrow[2];
#pragma unroll
        for (int r = 0; r < 2; ++r) {
            const int i = i0 + r * nw;
            ok[r] = i < nrows;
            const int ii = ok[r] ? i : i0;
            int b, s;
            if (skipctx) { b = ii / SEQ; s = CL + (ii - b * SEQ); } else { b = ii / SL; s = ii - b * SL; }
            tt[r] = b * SL + s;
            const bool isctx = s < CL;
            modrow[r] = isctx ? 16 : b;
            if (isctx) { xin[r] = (in_from_input ? p.ctx : Xc) + (size_t)(b * CL + s) * DM; xout[r] = Xc + (size_t)(b * CL + s) * DM; }
            else { xin[r] = (in_from_input ? p.x : p.out) + (size_t)(b * SEQ + s - CL) * DM; xout[r] = p.out + (size_t)(b * SEQ + s - CL) * DM; }
        }
        float xv[2][16];
#pragma unroll
        for (int r = 0; r < 2; ++r)
#pragma unroll
            for (int i = 0; i < 4; ++i) {
                const float4 v = *(const float4*)(xin[r] + i * 256 + lane * 4);
                xv[r][4 * i] = v.x; xv[r][4 * i + 1] = v.y; xv[r][4 * i + 2] = v.z; xv[r][4 * i + 3] = v.w;
            }
        if (mode != 0) {
            float rv[2][16]; float ss[2] = {0.f, 0.f};
#pragma unroll
            for (int r = 0; r < 2; ++r) {
                const bf16_t* tr = T + (size_t)tt[r] * DM;
                const bool part = (modrow[r] == 16);
                if (part) {
                    const int bb = tt[r] / SL, s = tt[r] - bb * SL;
                    const float* p0 = (const float*)(big + (mode == 2 ? B_PART : B_ACT)) + (size_t)(bb * CL + s) * DM;
                    const float* p1 = p0 + (size_t)NBATCH * CL * DM;
#pragma unroll
                    for (int i = 0; i < 4; ++i) {
                        const float4 a = *(const float4*)(p0 + i * 256 + lane * 4), c4 = *(const float4*)(p1 + i * 256 + lane * 4);
                        rv[r][4 * i] = a.x + c4.x; rv[r][4 * i + 1] = a.y + c4.y; rv[r][4 * i + 2] = a.z + c4.z; rv[r][4 * i + 3] = a.w + c4.w;
#pragma unroll
                        for (int k = 0; k < 4; ++k) ss[r] += rv[r][4 * i + k] * rv[r][4 * i + k];
                    }
                } else {
#pragma unroll
                    for (int i = 0; i < 4; ++i) {
                        const bf16x4 v = *(const bf16x4*)(tr + i * 256 + lane * 4);
#pragma unroll
                        for (int k = 0; k < 4; ++k) { rv[r][4 * i + k] = bf2f((bf16_t)v[k]); ss[r] += rv[r][4 * i + k] * rv[r][4 * i + k]; }
                    }
                }
            }
            ss[0] = wave_sum(ss[0]); ss[1] = wave_sum(ss[1]);
            const float* gpost = (mode == 1 ? p.g_post_mix : p.g_post_ffn) + l * DM;
#pragma unroll
            for (int r = 0; r < 2; ++r) {
                const float rstd = rsqrtf(ss[r] * (1.f / DM) + EPS);
                const float* gate = MOD + (size_t)(l * 17 + modrow[r]) * 6144 + (mode == 1 ? 2 : 5) * 1024;
#pragma unroll
                for (int i = 0; i < 4; ++i) {
                    const int c = i * 256 + lane * 4;
                    const float4 g4 = *(const float4*)(gpost + c);
                    const float4 t4 = *(const float4*)(gate + c);
                    xv[r][4 * i] += t4.x * (rv[r][4 * i] * rstd * g4.x);
                    xv[r][4 * i + 1] += t4.y * (rv[r][4 * i + 1] * rstd * g4.y);
                    xv[r][4 * i + 2] += t4.z * (rv[r][4 * i + 2] * rstd * g4.z);
                    xv[r][4 * i + 3] += t4.w * (rv[r][4 * i + 3] * rstd * g4.w);
                    float4 o; o.x = xv[r][4 * i]; o.y = xv[r][4 * i + 1]; o.z = xv[r][4 * i + 2]; o.w = xv[r][4 * i + 3];
                    if (ok[r]) *(float4*)(xout[r] + c) = o;
                }
            }
        }
        if (mode == 2 && l == DEPTH - 1) continue;
        float ss[2] = {0.f, 0.f};
#pragma unroll
        for (int r = 0; r < 2; ++r)
#pragma unroll
            for (int k = 0; k < 16; ++k) ss[r] += xv[r][k] * xv[r][k];
        ss[0] = wave_sum(ss[0]); ss[1] = wave_sum(ss[1]);
        const int ln = (mode == 2) ? l + 1 : l;
        const float* g = (mode == 1 ? p.g_pre_ffn : p.g_pre_mix) + ln * DM;
#pragma unroll
        for (int r = 0; r < 2; ++r) {
            const float rstd = rsqrtf(ss[r] * (1.f / DM) + EPS);
            const float* mrn = MOD + (size_t)(ln * 17 + modrow[r]) * 6144;
            const float* sh = mrn + (mode == 1 ? 3 : 0) * 1024;
            const float* sc = mrn + (mode == 1 ? 4 : 1) * 1024;
#pragma unroll
            for (int i = 0; i < 4; ++i) {
                const int c = i * 256 + lane * 4;
                const float4 g4 = *(const float4*)(g + c);
                const float4 s4 = *(const float4*)(sc + c);
                const float4 h4 = *(const float4*)(sh + c);
                const bf16x4 o = pack4(xv[r][4 * i] * rstd * g4.x * (1.f + s4.x) + h4.x, xv[r][4 * i + 1] * rstd * g4.y * (1.f + s4.y) + h4.y,
                                       xv[r][4 * i + 2] * rstd * g4.z * (1.f + s4.z) + h4.z, xv[r][4 * i + 3] * rstd * g4.w * (1.f + s4.w) + h4.w);
                if (ok[r]) *(bf16x4*)(Hdst + (size_t)tt[r] * DM + c) = o;
            }
        }
    }
}

struct EpiStore {
    static constexpr bool PERM = true, AFTER_DRAIN = false;
    bf16_t* O; int ldc; int split_cols; size_t split_stride;
    __device__ __forceinline__ void operator()(const f32x4 (&acc)[2][2][4][2], const pg8::Unit& u, int wr, int wc, int fr, int fq) const {
        const int row0 = u.pm * 256 + wr * 64 + fr; int colt = u.pn * 256; bf16_t* base = O;
        if (split_cols) { const int t = colt / split_cols; base += (size_t)t * split_stride; colt -= t * split_cols; }
        const int col0 = colt + wc * 32 + 8 * fq;
#pragma unroll
        for (int ai = 0; ai < 2; ++ai)
#pragma unroll
            for (int m = 0; m < 4; ++m) {
                bf16_t* rowp = base + (size_t)(row0 + ai * 128 + m * 16) * ldc + col0;
#pragma unroll
                for (int bj = 0; bj < 2; ++bj) {
                    const f32x4 v0 = acc[ai][bj][m][0], v1 = acc[ai][bj][m][1];
                    u32x4 w; w.x = cvt2(v0[0], v0[1]); w.y = cvt2(v0[2], v0[3]); w.z = cvt2(v1[0], v1[1]); w.w = cvt2(v1[2], v1[3]);
                    *(u32x4*)(rowp + bj * 128) = w;
                }
            }
    }
};
__device__ __forceinline__ float dpp_ror1(float v) { return __uint_as_float(__builtin_amdgcn_update_dpp(0u, __float_as_uint(v), 0x121, 0xF, 0xF, false)); }
__device__ __forceinline__ float dpp_ror15(float v) { return __uint_as_float(__builtin_amdgcn_update_dpp(0u, __float_as_uint(v), 0x12F, 0xF, 0xF, false)); }
__device__ __forceinline__ float dpp_prev(float edge, float v) { return __uint_as_float(__builtin_amdgcn_update_dpp(__float_as_uint(edge), __float_as_uint(v), 0x111, 0xF, 0xF, false)); }
__device__ __forceinline__ float dpp_next(float edge, float v) { return __uint_as_float(__builtin_amdgcn_update_dpp(__float_as_uint(edge), __float_as_uint(v), 0x101, 0xF, 0xF, false)); }
typedef float f32x2v __attribute__((ext_vector_type(2)));
struct EpiConv {
    static constexpr bool PERM = true, AFTER_DRAIN = false;
    bf16_t* ACT; bf16_t* GB; bf16_t* VB; const float* cw;
    __device__ __forceinline__ void operator()(const f32x4 (&acc)[2][2][4][2], const pg8::Unit& u, int wr, int wc, int fr, int fq) const {
        const int col0 = u.pn * 128 + wc * 32 + 8 * fq;
        f32x2v c0[4], c1[4], c2[4];
#pragma unroll
        for (int q = 0; q < 4; ++q) {
            c0[q] = *(const f32x2v*)(cw + col0 + 2 * q); c1[q] = *(const f32x2v*)(cw + DFF + col0 + 2 * q); c2[q] = *(const f32x2v*)(cw + 2 * DFF + col0 + 2 * q);
        }
#pragma unroll
        for (int ai = 0; ai < 2; ++ai) {
            const int row0 = u.pm * 256 + ai * 128 + wr * 64;
            const int strip = row0 >> 6;
            unsigned outp[4][4];
#pragma unroll
            for (int q = 0; q < 4; ++q) {
                const int n = q >> 1, j = (q & 1) * 2;
                f32x2v g[4], up[4], dn[4];
#pragma unroll
                for (int m = 0; m < 4; ++m) { g[m].x = acc[ai][0][m][n][j]; g[m].y = acc[ai][0][m][n][j + 1]; }
#pragma unroll
                for (int m = 0; m < 4; ++m) {
                    f32x2v eu = {0.f, 0.f}, ed = {0.f, 0.f};
                    if (m > 0) { eu.x = dpp_ror1(g[m > 0 ? m - 1 : 0].x); eu.y = dpp_ror1(g[m > 0 ? m - 1 : 0].y); }
                    if (m < 3) { ed.x = dpp_ror15(g[m < 3 ? m + 1 : 3].x); ed.y = dpp_ror15(g[m < 3 ? m + 1 : 3].y); }
                    up[m].x = dpp_prev(eu.x, g[m].x); up[m].y = dpp_prev(eu.y, g[m].y);
                    dn[m].x = dpp_next(ed.x, g[m].x); dn[m].y = dpp_next(ed.y, g[m].y);
                }
#pragma unroll
                for (int m = 0; m < 4; ++m) {
                    const f32x2v gg = c0[q] * up[m] + c1[q] * g[m] + c2[q] * dn[m];
                    const f32x2v t = (gg * gg) * 0.044715f + 1.0f;
                    const f32x2v uu = (gg * t) * (-1.5957691216f * 1.4426950408889634f);
                    f32x2v e; e.x = __builtin_amdgcn_exp2f(uu.x); e.y = __builtin_amdgcn_exp2f(uu.y);
                    const f32x2v dd = e + 1.0f;
                    f32x2v r; r.x = __builtin_amdgcn_rcpf(dd.x); r.y = __builtin_amdgcn_rcpf(dd.y);
                    f32x2v val; val.x = acc[ai][1][m][n][j]; val.y = acc[ai][1][m][n][j + 1];
                    const f32x2v o = (gg * r) * val;
                    outp[m][q] = cvt2(o.x, o.y);
                }
            }
#pragma unroll
            for (int m = 0; m < 4; ++m) {
                const int lr = m * 16 + fr;
                if (lr != 0 && lr != 63) {
                    u32x4 w4; w4.x = outp[m][0]; w4.y = outp[m][1]; w4.z = outp[m][2]; w4.w = outp[m][3];
                    *(u32x4*)(ACT + (size_t)(row0 + lr) * DFF + col0) = w4;
                }
                if (lr < 2 || lr >= 62) {
                    const int slot = lr < 2 ? lr : lr - 60;
                    *(bf16x8*)(GB + ((size_t)strip * 4 + slot) * DFF + col0) = pack8(acc[ai][0][m][0][0], acc[ai][0][m][0][1], acc[ai][0][m][0][2], acc[ai][0][m][0][3],
                                                                                     acc[ai][0][m][1][0], acc[ai][0][m][1][1], acc[ai][0][m][1][2], acc[ai][0][m][1][3]);
                    if (lr == 0 || lr == 63)
                        *(bf16x8*)(VB + ((size_t)strip * 2 + (lr ? 1 : 0)) * DFF + col0) = pack8(acc[ai][1][m][0][0], acc[ai][1][m][0][1], acc[ai][1][m][0][2], acc[ai][1][m][0][3],
                                                                                                 acc[ai][1][m][1][0], acc[ai][1][m][1][1], acc[ai][1][m][1][2], acc[ai][1][m][1][3]);
                }
            }
        }
    }
};
struct EpiPart {
    static constexpr bool PERM = true, AFTER_DRAIN = false;
    float* O;
    __device__ __forceinline__ void operator()(const f32x4 (&acc)[2][2][4][2], const pg8::Unit& u, int wr, int wc, int fr, int fq) const {
        const int row0 = (u.pm / 9) * 256 + wr * 64 + fr, col0 = u.pn * 256 + wc * 32 + 8 * fq;
#pragma unroll
        for (int ai = 0; ai < 2; ++ai)
#pragma unroll
            for (int m = 0; m < 4; ++m) {
                float* rowp = O + (size_t)(row0 + ai * 128 + m * 16) * DM + col0;
#pragma unroll
                for (int bj = 0; bj < 2; ++bj) { *(f32x4*)(rowp + bj * 128) = acc[ai][bj][m][0]; *(f32x4*)(rowp + bj * 128 + 4) = acc[ai][bj][m][1]; }
            }
    }
};
struct CtxOrder : pg8::StaticOrder {
    __device__ __forceinline__ bool next(int i, pg8::Unit& u) const {
        if (!pg8::StaticOrder::next(i, u)) return false;
        u.pm = u.pm * 9;
        return true;
    }
};
struct SkipOrder : pg8::StaticOrder {
    int skip;
    __device__ __forceinline__ bool next(int i, pg8::Unit& u) const {
        if (!pg8::StaticOrder::next(i, u)) return false;
        if (skip) u.pm = (u.pm >> 3) * 9 + 1 + (u.pm & 7);
        return true;
    }
};

__device__ __forceinline__ void phase_prep(const Params& p, unsigned char* smem) {
    const int tid = opaque_tid();
    const int lane = tid & 63, w = tid >> 6;
    unsigned char* big = p.ws + WS_BIG;
    bf16_t* P = (bf16_t*)(big + B_P);
    bf16_t* VTN = (bf16_t*)(big + B_VTN);
    bf16_t* VTS = (bf16_t*)(big + B_VTS);
    bf16_t* tl = (bf16_t*)smem;
    constexpr int N_ROPE = NBATCH * SEQ / NW, N_VT = NBATCH * 6 * (SL / 64);
    for (int task = opaque_bid(); task < N_ROPE + N_VT; task += gridDim.x) {
        if (task < N_ROPE) {
            const int tk = task * NW + w;
            const int b = tk / SEQ, pos = tk % SEQ;
            bf16_t* pr = P + (size_t)(b * SL + CL + pos) * PSTR;
            const int row = pos >> 6, col = pos & 63;
#pragma unroll
            for (int e0 = 0; e0 < 192; e0 += 64) {
                const int e = e0 + lane;
                const int head = e >> 5, pair = e & 31, half = pair >> 4, i = pair & 15;
                const int base = (head < 4) ? (OFF_SQ + head * 64) : (OFF_SK + (head - 4) * 64);
                const int i1 = base + half * 32 + i, i2 = i1 + 16;
                const float inv_freq = exp2f(-(float)i * (13.287712379549449f / 16.f));
                const float ang = (float)(half ? col : row) * inv_freq;
                float sn, cs; __sincosf(ang, &sn, &cs);
                const float t1 = bf2f(pr[i1]), t2 = bf2f(pr[i2]);
                pr[i1] = f2bf(t1 * cs - t2 * sn);
                pr[i2] = f2bf(t1 * sn + t2 * cs);
            }
        } else {
            const int r = task - N_ROPE;
            const int st = r % (SL / 64), slot = (r / (SL / 64)) % 6, b = r / (6 * (SL / 64));
            const int s0 = st * 64;
            const int col = (slot < 4) ? (OFF_NAV + slot * 64) : (OFF_SV + (slot - 4) * 64);
            {
                const int tt = tid >> 3, dc = (tid & 7) * 8;
                const bf16x8 v = *(const bf16x8*)(P + (size_t)(b * SL + s0 + tt) * PSTR + col + dc);
#pragma unroll
                for (int k = 0; k < 8; ++k) tl[(dc + k) * 72 + tt] = (bf16_t)v[k];
            }
            __syncthreads();
            {
                const int d = tid >> 3, tc = (tid & 7) * 8;
                const bf16x8 v = *(const bf16x8*)(tl + d * 72 + tc);
                bf16_t* dst = (slot < 4) ? (VTN + ((size_t)(b * 4 + slot) * 64 + d) * SL + s0 + tc) : (VTS + ((size_t)(b * 2 + slot - 4) * 64 + d) * SL + s0 + tc);
                *(bf16x8*)dst = v;
            }
            __syncthreads();
        }
    }
}

__device__ __forceinline__ float quad_max(float v) {
    unsigned x = __float_as_uint(v);
    auto r = __builtin_amdgcn_permlane16_swap(x, x, false, false);
    float a = fmaxf(__uint_as_float(r[0]), __uint_as_float(r[1]));
    x = __float_as_uint(a);
    auto r2 = __builtin_amdgcn_permlane32_swap(x, x, false, false);
    return fmaxf(__uint_as_float(r2[0]), __uint_as_float(r2[1]));
}
__device__ __forceinline__ float quad_sum(float v) {
    unsigned x = __float_as_uint(v);
    auto r = __builtin_amdgcn_permlane16_swap(x, x, false, false);
    float a = __uint_as_float(r[0]) + __uint_as_float(r[1]);
    x = __float_as_uint(a);
    auto r2 = __builtin_amdgcn_permlane32_swap(x, x, false, false);
    return __uint_as_float(r2[0]) + __uint_as_float(r2[1]);
}
struct KFrag { bf16x8 k[4]; };
struct VFrag { bf16x8 v[4]; };
__device__ __forceinline__ KFrag load_k(const char* kb_u, unsigned ko0, unsigned ko1) {
    KFrag f;
    f.k[0] = *(const bf16x8*)(kb_u + ko0); f.k[1] = *(const bf16x8*)(kb_u + ko0 + 64);
    f.k[2] = *(const bf16x8*)(kb_u + ko1); f.k[3] = *(const bf16x8*)(kb_u + ko1 + 64);
    return f;
}
__device__ __forceinline__ VFrag load_v(const char* vb_u, const unsigned (&vo)[4]) {
    VFrag f;
#pragma unroll
    for (int dt = 0; dt < 4; ++dt) f.v[dt] = *(const bf16x8*)(vb_u + vo[dt]);
    return f;
}
constexpr float LOG2E = 1.4426950408889634f;

template <bool CTXLDS>
__device__ __forceinline__ void attn_task(const Params& p, int l, int kind, int b, int a, int c, int h, int lane, const float* rpbl  ,
                                          const char* Kc, const char* Vc) {
    const int fr = lane & 15, fq = lane >> 4;
    unsigned char* big = p.ws + WS_BIG;
    const bf16_t* Pb = (const bf16_t*)(big + B_P) + (size_t)b * SL * PSTR;
    bf16_t* YM = (bf16_t*)(big + B_YM) + (size_t)b * SL * DM;
    const bool isna = (kind == 0 || kind == 2);
    const int kvh = isna ? h : (h >> 1);
    const char* Kbase = (const char*)(Pb + (isna ? OFF_NAK : OFF_SK) + kvh * 64);
    const char* Vbase = (const char*)(isna ? ((const bf16_t*)(big + B_VTN) + (size_t)(b * 4 + kvh) * 64 * SL)
                                           : ((const bf16_t*)(big + B_VTS) + (size_t)(b * 2 + kvh) * 64 * SL));
    const int krow = (fr >> 2) * 8 + (fr & 3);
    const unsigned ko0 = (unsigned)(krow * PSTR + fq * 8) * 2u, ko1 = ko0 + 4u * PSTR * 2u;
    unsigned vo[4];
#pragma unroll
    for (int dt = 0; dt < 4; ++dt) vo[dt] = (unsigned)((dt * 16 + fr) * SL + fq * 8) * 2u;
    int qtok[2];
    if (kind == 0) { qtok[0] = CL + (2 * a) * 64 + c * 16 + fr; qtok[1] = qtok[0] + 64; }
    else if (kind == 1) { qtok[0] = CL + a * 32 + fr; qtok[1] = qtok[0] + 16; }
    else { qtok[0] = a * 32 + fr; qtok[1] = qtok[0] + 16; }
    bf16x8 qB[2][2];
#pragma unroll
    for (int g = 0; g < 2; ++g) {
        const bf16_t* qp = Pb + (size_t)qtok[g] * PSTR + (isna ? OFF_NAQ : OFF_SQ) + h * 64 + fq * 8;
        qB[g][0] = *(const bf16x8*)qp;
        qB[g][1] = *(const bf16x8*)(qp + 32);
    }
    int nloc = 0, loc0 = 0, locstep = 32;
    int row0A = 0, rowoff = 0, q0 = 0;
    int dcv[8]; unsigned vmask = 0u;
#pragma unroll
    for (int e = 0; e < 8; ++e) dcv[e] = 0;
    if (kind == 0) {
        const int r0 = 2 * a;
        row0A = clampi(r0 - 4, 0, 24);
        const int row0B = clampi(r0 - 3, 0, 24);
        rowoff = row0B - row0A;
        const int col0 = clampi(16 * c - 8, 0, 32), qcol = 16 * c + fr, wst = clampi(qcol - 8, 0, 48);
        nloc = 8 + rowoff; loc0 = CL + row0A * 64 + col0; locstep = 64;
#pragma unroll
        for (int e = 0; e < 8; ++e) {
            const int kcol = col0 + fq * 8 + e;
            if ((kcol >= wst) && (kcol < wst + 16)) vmask |= (1u << e);
            dcv[e] = clampi(kcol - qcol, -15, 15) + 15;
        }
    } else if (kind == 1) {
        q0 = a * 32;
        const int lo = q0 - 128;
        const int first = lo < 0 ? 0 : lo, last = (lo + 288) > SEQ ? SEQ : (lo + 288);
        nloc = (last - first) >> 5; loc0 = CL + first; locstep = 32;
    }
    const int nblk = 8 + nloc;
    auto s0_of = [&](int i) { const int ii = i < nblk ? i : nblk - 1; return ii < 8 ? ii * 32 : loc0 + (ii - 8) * locstep; };
    f32x4 o[2][4];
    float m[2], lsum[2];
#pragma unroll
    for (int g = 0; g < 2; ++g) {
        m[g] = NEG; lsum[g] = 0.f;
#pragma unroll
        for (int dt = 0; dt < 4; ++dt) o[g][dt] = (f32x4){0.f, 0.f, 0.f, 0.f};
    }
    constexpr float C1 = 0.125f * LOG2E;
    auto compute = [&](const KFrag& kc, const VFrag& vc, int i, int s0) {
#pragma unroll
        for (int g = 0; g < 2; ++g) {
            bool act = true;
            float badd[8];
#pragma unroll
            for (int e = 0; e < 8; ++e) badd[e] = 0.f;
            if (i >= 8) {
                if (kind == 0) {
                    const int j = i - 8;
                    act = (g == 0) ? (j < 8) : (j >= rowoff);
                    if (act) {
                        const float* bias = rpbl + (row0A + j - (2 * a + g) + 7) * 31;
#pragma unroll
                        for (int e = 0; e < 8; ++e) badd[e] = ((vmask >> e) & 1u) ? bias[dcv[e]] : NEG;
                    }
                } else {
                    const int kp0 = s0 - CL, qlo = q0 + 16 * g;
                    const bool full = (kp0 >= qlo + 15 - 128) && (kp0 + 31 <= qlo + 128);
                    if (!full) {
#pragma unroll
                        for (int e = 0; e < 8; ++e) {
                            const int d = qlo + fr - (kp0 + fq * 8 + e);
                            badd[e] = (d <= 128 && d >= -128) ? 0.f : NEG;
                        }
                    }
                }
            }
            if (act) {
                f32x4 s[2];
                s[0] = MFMA16(kc.k[0], qB[g][0], ((f32x4){0.f, 0.f, 0.f, 0.f}));
                s[0] = MFMA16(kc.k[1], qB[g][1], s[0]);
                s[1] = MFMA16(kc.k[2], qB[g][0], ((f32x4){0.f, 0.f, 0.f, 0.f}));
                s[1] = MFMA16(kc.k[3], qB[g][1], s[1]);
                float t[8];
                float bm = NEG;
#pragma unroll
                for (int e = 0; e < 8; ++e) { t[e] = fmaf(s[e >> 2][e & 3], C1, badd[e]); bm = fmaxf(bm, t[e]); }
                bm = quad_max(bm);
                if (__any(bm > m[g] + 8.f)) {
                    const float mn = fmaxf(m[g], bm);
                    const float alpha = __builtin_amdgcn_exp2f(m[g] - mn);
                    m[g] = mn;
                    lsum[g] *= alpha;
#pragma unroll
                    for (int dt = 0; dt < 4; ++dt) o[g][dt] *= alpha;
                }
                float pv[8]; float ps = 0.f;
#pragma unroll
                for (int e = 0; e < 8; ++e) { pv[e] = __builtin_amdgcn_exp2f(t[e] - m[g]); ps += pv[e]; }
                lsum[g] += ps;
                const bf16x8 pB = pack8(pv[0], pv[1], pv[2], pv[3], pv[4], pv[5], pv[6], pv[7]);
#pragma unroll
                for (int dt = 0; dt < 4; ++dt) o[g][dt] = MFMA16(vc.v[dt], pB, o[g][dt]);
            }
        }
    };
    if (CTXLDS) {
        KFrag gk0 = load_k(Kbase + (size_t)s0_of(8) * (PSTR * 2), ko0, ko1);
        VFrag gv0 = load_v(Vbase + (size_t)s0_of(8) * 2, vo);
        KFrag gk1 = load_k(Kbase + (size_t)s0_of(9) * (PSTR * 2), ko0, ko1);
        const char* kl = Kc + (krow * 144 + fq * 16);
        auto lds_k = [&](int s0) { KFrag f; const char* q = kl + s0 * 144;
            f.k[0] = *(const bf16x8*)q; f.k[1] = *(const bf16x8*)(q + 64); f.k[2] = *(const bf16x8*)(q + 4 * 144); f.k[3] = *(const bf16x8*)(q + 4 * 144 + 64); return f; };
        auto lds_v = [&](int s0) { VFrag f;
#pragma unroll
            for (int dt = 0; dt < 4; ++dt) f.v[dt] = *(const bf16x8*)(Vc + (dt * 16 + fr) * 528 + (s0 + fq * 8) * 2);
            return f; };
        KFrag kc = lds_k(0); VFrag vc = lds_v(0);
        for (int i = 0; i < 8; ++i) {
            const int sn = (i < 7 ? i + 1 : 7) * 32;
            const KFrag kn = lds_k(sn); const VFrag vn = lds_v(sn);
            compute(kc, vc, i, i * 32);
            kc = kn; vc = vn;
        }
        kc = gk0; vc = gv0;
        KFrag kn = gk1;
        for (int i = 8; i < nblk; ++i) {
            const KFrag kn2 = load_k(Kbase + (size_t)s0_of(i + 2) * (PSTR * 2), ko0, ko1);
            const VFrag vn = load_v(Vbase + (size_t)s0_of(i + 1) * 2, vo);
            compute(kc, vc, i, s0_of(i));
            kc = kn; kn = kn2; vc = vn;
        }
    } else {
        KFrag kc = load_k(Kbase + (size_t)s0_of(0) * (PSTR * 2), ko0, ko1);
        KFrag kn = load_k(Kbase + (size_t)s0_of(1) * (PSTR * 2), ko0, ko1);
        VFrag vc = load_v(Vbase + (size_t)s0_of(0) * 2, vo);
        for (int i = 0; i < nblk; ++i) {
            const KFrag kn2 = load_k(Kbase + (size_t)s0_of(i + 2) * (PSTR * 2), ko0, ko1);
            const VFrag vn = load_v(Vbase + (size_t)s0_of(i + 1) * 2, vo);
            compute(kc, vc, i, s0_of(i));
            kc = kn; kn = kn2; vc = vn;
        }
    }
#pragma unroll
    for (int g = 0; g < 2; ++g) {
        float lt = quad_sum(lsum[g]);
        if (!isna) lt += __builtin_amdgcn_exp2f(p.swa_sink[l * 4 + h] * LOG2E - m[g]);
        const float inv = 1.f / lt;
        bf16_t* dst = YM + (size_t)qtok[g] * DM + (isna ? 256 : 768) + h * 64;
#pragma unroll
        for (int dt = 0; dt < 4; ++dt)
            *(bf16x4*)(dst + dt * 16 + fq * 4) = pack4(o[g][dt][0] * inv, o[g][dt][1] * inv, o[g][dt][2] * inv, o[g][dt][3] * inv);
    }
}

__device__ __forceinline__ void s5_task(const Params& p, int l, int b, int g, int dir, int lane, float* bu  , bf16_t* hb  ) {
    const int fr = lane & 15, fq = lane >> 4;
    unsigned char* big = p.ws + WS_BIG;
    const bf16_t* Pb = (const bf16_t*)(big + B_P) + (size_t)b * SL * PSTR + OFF_A + g * 16;
    bf16_t* YS = (bf16_t*)(big + B_YS) + ((size_t)dir * NT + (size_t)b * SL) * 256 + g * 16;
    const int base = (l * 2 + dir) * 16 + g;
    const float step = expf(p.s5_log_step[base]);
    float lbr, lbi;
    {
        const float lre = p.s5_lam_re[base * 64 + lane], lim = p.s5_lam_im[base * 64 + lane];
        const float er = expf(lre * step);
        float sn, cs; sincosf(lim * step, &sn, &cs);
        lbr = er * cs; lbi = er * sn;
        const float nr = lbr - 1.f, ni = lbi;
        const float den = 1.f / (lre * lre + lim * lim);
        bu[2 * lane] = (nr * lre + ni * lim) * den;
        bu[2 * lane + 1] = (ni * lre - nr * lim) * den;
    }
    WAVE_LDS_SYNC();
    bf16x8 Bop[8];
#pragma unroll
    for (int nt = 0; nt < 8; ++nt) {
        const int pp = nt * 8 + (fr >> 1), part = fr & 1;
        const float cr = bu[2 * pp], ci = bu[2 * pp + 1];
        float v[8];
#pragma unroll
        for (int jj = 0; jj < 8; ++jj) {
            float br = 0.f, bi = 0.f;
            if (fq < 2) {
                const size_t idx = ((size_t)base * 64 + pp) * 16 + fq * 8 + jj;
                br = p.s5_b_re[idx]; bi = p.s5_b_im[idx];
            }
            v[jj] = part ? (cr * bi + ci * br) : (cr * br - ci * bi);
        }
        Bop[nt] = pack8(v[0], v[1], v[2], v[3], v[4], v[5], v[6], v[7]);
        if (nt & 1) asm volatile("" ::: "memory");
    }
    WAVE_LDS_SYNC();
    bf16x8 Cop[4];
#pragma unroll
    for (int ks = 0; ks < 4; ++ks) {
        float v[8];
#pragma unroll
        for (int jj = 0; jj < 8; ++jj) {
            const int k = ks * 32 + fq * 8 + jj;
            const size_t idx = ((size_t)base * 16 + fr) * 64 + (k >> 1);
            v[jj] = (k & 1) ? -p.s5_c_im[idx] : p.s5_c_re[idx];
        }
        Cop[ks] = pack8(v[0], v[1], v[2], v[3], v[4], v[5], v[6], v[7]);
        asm volatile("" ::: "memory");
    }
    const bf16x8 zero8 = (bf16x8){0, 0, 0, 0, 0, 0, 0, 0};
    float hr = 0.f, hi = 0.f;
    bf16x8 uN = zero8, uN2 = zero8;
    if (fq < 2) {
        uN = *(const bf16x8*)(Pb + (size_t)s_of(dir, fr) * PSTR + fq * 8);
        uN2 = *(const bf16x8*)(Pb + (size_t)s_of(dir, 16 + fr) * PSTR + fq * 8);
    }
    for (int blk = 0; blk < SL / 16; ++blk) {
        const int i0 = blk * 16;
        const bf16x8 uA = uN;
        uN = uN2;
        if (blk + 2 < SL / 16 && fq < 2) uN2 = *(const bf16x8*)(Pb + (size_t)s_of(dir, i0 + 32 + fr) * PSTR + fq * 8);
#pragma unroll
        for (int nt = 0; nt < 8; ++nt) {
            const f32x4 acc = MFMA16(uA, Bop[nt], ((f32x4){0.f, 0.f, 0.f, 0.f}));
#pragma unroll
            for (int j = 0; j < 4; ++j) bu[(fq * 4 + j) * 132 + nt * 16 + fr] = acc[j];
        }
        WAVE_LDS_SYNC();
#pragma unroll
        for (int t = 0; t < 16; ++t) {
            const float2 v = *(const float2*)(bu + t * 132 + 2 * lane);
            const float nr = lbr * hr - lbi * hi + v.x;
            const float ni = lbr * hi + lbi * hr + v.y;
            hr = nr; hi = ni;
            *(unsigned*)(hb + t * 136 + 2 * lane) = cvt2(hr, hi);
        }
        WAVE_LDS_SYNC();
        f32x4 y = (f32x4){0.f, 0.f, 0.f, 0.f};
#pragma unroll
        for (int ks = 0; ks < 4; ++ks) {
            const bf16x8 hA = *(const bf16x8*)(hb + fr * 136 + ks * 32 + fq * 8);
            y = MFMA16(hA, Cop[ks], y);
        }
#pragma unroll
        for (int j = 0; j < 4; ++j) YS[(size_t)s_of(dir, i0 + fq * 4 + j) * 256 + fr] = f2bf(y[j]);
        WAVE_LDS_SYNC();
    }
}

__device__ __forceinline__ void gla_task(const Params& p, int l, int b, int h, int dir, unsigned char* smem) {
    constexpr int LS = 72;
    bf16_t* Qd = (bf16_t*)smem;
    bf16_t* Kd = Qd + 64 * LS;
    bf16_t* KeT = Kd + 64 * LS;
    bf16_t* Vt = KeT + 64 * LS;
    bf16_t* Am = Vt + 64 * LS;
    bf16_t* St = Am + 64 * LS;
    float* segsum = (float*)(St + 64 * LS);
    float* decay = segsum + 512;
    unsigned* gfl = (unsigned*)(decay + 64);
    const int tid = opaque_tid(), lane = tid & 63, w = tid >> 6, fr = lane & 15, fq = lane >> 4;
    const int d = lane, iq = w, it = w >> 1, hb2 = (w & 1) * 2;
    unsigned char* big = p.ws + WS_BIG;
    const bf16_t* Pb = (const bf16_t*)(big + B_P) + (size_t)b * SL * PSTR;
    bf16_t* OG = (bf16_t*)(big + B_OG) + ((size_t)dir * NT + (size_t)b * SL) * 256 + h * 64;
    for (int i = tid; i < 64 * LS; i += NTH) St[i] = 0;
    f32x4 Sacc[2];
    Sacc[0] = (f32x4){0.f, 0.f, 0.f, 0.f}; Sacc[1] = (f32x4){0.f, 0.f, 0.f, 0.f};
    float wg[16];
    {
        const float* Wg = p.gla_w_gate2 + (size_t)((l * 2 + dir) * 16) * 256 + h * 64 + d;
#pragma unroll
        for (int r = 0; r < 16; ++r) wg[r] = Wg[r * 256];
    }
    const float bgv = p.gla_b_gate[(l * 2 + dir) * 256 + h * 64 + d];
    const int gcol = dir == 0 ? OFF_GF : OFF_GB;
    unsigned gfn = *(const unsigned*)(Pb + (size_t)s_of(dir, tid >> 3) * PSTR + gcol + 2 * (tid & 7));
    bf16_t qn[8], kn[8], vn[8];
#pragma unroll
    for (int ii = 0; ii < 8; ++ii) {
        const bf16_t* pr = Pb + (size_t)s_of(dir, iq * 8 + ii) * PSTR + h * 64 + d;
        qn[ii] = pr[OFF_GQ]; kn[ii] = pr[OFF_GK]; vn[ii] = pr[OFF_GV];
    }
    gfl[tid] = gfn;
    __syncthreads();
    for (int n = 0; n < SL / 64; ++n) {
        bf16_t qc[8], kc[8], vc[8];
#pragma unroll
        for (int ii = 0; ii < 8; ++ii) { qc[ii] = qn[ii]; kc[ii] = kn[ii]; vc[ii] = vn[ii]; }
        if (n + 1 < SL / 64) {
            gfn = *(const unsigned*)(Pb + (size_t)s_of(dir, (n + 1) * 64 + (tid >> 3)) * PSTR + gcol + 2 * (tid & 7));
#pragma unroll
            for (int ii = 0; ii < 8; ++ii) {
                const bf16_t* pr = Pb + (size_t)s_of(dir, (n + 1) * 64 + iq * 8 + ii) * PSTR + h * 64 + d;
                qn[ii] = pr[OFF_GQ]; kn[ii] = pr[OFF_GK]; vn[ii] = pr[OFF_GV];
            }
        }
        const unsigned* gcur = gfl + (n & 1) * 512;
        float bcum[8];
        float run = 0.f;
#pragma unroll
        for (int ii = 0; ii < 8; ++ii) {
            const bf16x8 g0 = *(const bf16x8*)(gcur + (iq * 8 + ii) * 8);
            const bf16x8 g1 = *(const bf16x8*)(gcur + (iq * 8 + ii) * 8 + 4);
            float z = bgv;
#pragma unroll
            for (int r = 0; r < 8; ++r) z += bf2f((bf16_t)g0[r]) * wg[r];
#pragma unroll
            for (int r = 0; r < 8; ++r) z += bf2f((bf16_t)g1[r]) * wg[8 + r];
            const float ls = fminf(z, 0.f) - __logf(1.f + __expf(-fabsf(z)));
            run += ls * (1.f / 16.f);
            bcum[ii] = run;
        }
        segsum[iq * 64 + d] = run;
        __syncthreads();
        float pre = 0.f, tot = 0.f;
#pragma unroll
        for (int q = 0; q < 8; ++q) {
            const float v = segsum[q * 64 + d];
            tot += v;
            if (q < iq) pre += v;
        }
        float kev[8];
#pragma unroll
        for (int ii = 0; ii < 8; ++ii) {
            const int il = iq * 8 + ii;
            const float bb = pre + bcum[ii];
            const float q = bf2f(qc[ii]), k = bf2f(kc[ii]);
            Qd[il * LS + d] = f2bf(q * 0.125f * __expf(bb));
            Kd[il * LS + d] = f2bf(k * __expf(-bb));
            kev[ii] = k * __expf(tot - bb);
        }
        *(bf16x8*)(KeT + d * LS + iq * 8) = pack8(kev[0], kev[1], kev[2], kev[3], kev[4], kev[5], kev[6], kev[7]);
        {
            bf16x8 vv;
#pragma unroll
            for (int ii = 0; ii < 8; ++ii) vv[ii] = (short)vc[ii];
            *(bf16x8*)(Vt + d * LS + iq * 8) = vv;
        }
        if (iq == 0) decay[d] = __expf(tot);
        __syncthreads();
        bf16x8 qf[2];
        qf[0] = *(const bf16x8*)(Qd + (16 * it + fr) * LS + fq * 8);
        qf[1] = *(const bf16x8*)(Qd + (16 * it + fr) * LS + 32 + fq * 8);
#pragma unroll
        for (int j2 = 0; j2 < 2; ++j2) {
            const int jt = hb2 + j2;
            f32x4 acc = (f32x4){0.f, 0.f, 0.f, 0.f};
#pragma unroll
            for (int ks = 0; ks < 2; ++ks) {
                const bf16x8 kf = *(const bf16x8*)(Kd + (jt * 16 + fr) * LS + ks * 32 + fq * 8);
                acc = MFMA16(kf, qf[ks], acc);
            }
            const int il = 16 * it + fr, j0 = jt * 16 + fq * 4;
            *(bf16x4*)(Am + il * LS + j0) = pack4(il >= j0 ? acc[0] : 0.f, il >= j0 + 1 ? acc[1] : 0.f, il >= j0 + 2 ? acc[2] : 0.f, il >= j0 + 3 ? acc[3] : 0.f);
        }
        __syncthreads();
        bf16x8 af[2];
        af[0] = *(const bf16x8*)(Am + (16 * it + fr) * LS + fq * 8);
        af[1] = *(const bf16x8*)(Am + (16 * it + fr) * LS + 32 + fq * 8);
        {
            const int s = s_of(dir, n * 64 + 16 * it + fr);
            bf16_t* orow = OG + (size_t)s * 256;
#pragma unroll
            for (int d2 = 0; d2 < 2; ++d2) {
                const int dvt = hb2 + d2;
                f32x4 acc = (f32x4){0.f, 0.f, 0.f, 0.f};
#pragma unroll
                for (int ks = 0; ks < 2; ++ks) {
                    const bf16x8 vf = *(const bf16x8*)(Vt + (dvt * 16 + fr) * LS + ks * 32 + fq * 8);
                    acc = MFMA16(vf, af[ks], acc);
                    const bf16x8 sf = *(const bf16x8*)(St + (dvt * 16 + fr) * LS + ks * 32 + fq * 8);
                    acc = MFMA16(sf, qf[ks], acc);
                }
                *(bf16x4*)(orow + dvt * 16 + fq * 4) = pack4(acc[0], acc[1], acc[2], acc[3]);
            }
        }
        gfl[((n + 1) & 1) * 512 + tid] = gfn;
        __syncthreads();
        bf16x8 vb[2];
        vb[0] = *(const bf16x8*)(Vt + (16 * it + fr) * LS + fq * 8);
        vb[1] = *(const bf16x8*)(Vt + (16 * it + fr) * LS + 32 + fq * 8);
#pragma unroll
        for (int k2 = 0; k2 < 2; ++k2) {
            const int dkt = hb2 + k2;
            const f32x4 dec = *(const f32x4*)(decay + dkt * 16 + fq * 4);
            Sacc[k2] *= dec;
#pragma unroll
            for (int ks = 0; ks < 2; ++ks) {
                const bf16x8 kf = *(const bf16x8*)(KeT + (dkt * 16 + fr) * LS + ks * 32 + fq * 8);
                Sacc[k2] = MFMA16(kf, vb[ks], Sacc[k2]);
            }
            *(bf16x4*)(St + (16 * it + fr) * LS + dkt * 16 + fq * 4) = pack4(Sacc[k2][0], Sacc[k2][1], Sacc[k2][2], Sacc[k2][3]);
        }
    }
    __syncthreads();
}

__device__ __forceinline__ int next_task(unsigned* cnt, volatile int* s_task) {
    __syncthreads();
    if (opaque_tid() == 0) *s_task = (int)atomicAdd(cnt, 1u);
    __syncthreads();
    return *s_task;
}
__device__ __forceinline__ int wave_next(unsigned* cnt, int lane) {
    int t = 0;
    if (lane == 0) t = (int)atomicAdd(cnt, 1u);
    return __builtin_amdgcn_readfirstlane(t);
}
__device__ __forceinline__ bool combo_task(int combo, int wt, bool ctx_out, int xq, int& kind, int& b, int& a, int& c, int& h) {
    c = 0;
    if (combo < 8) {
        const int n = ctx_out ? 72 : 64;
        if (wt >= n) return false;
        b = 2 * xq + (combo >> 2); h = combo & 3;
        if (wt < 64) { kind = 0; c = wt & 3; a = wt >> 2; } else { kind = 2; a = wt - 64; }
    } else {
        const int n = ctx_out ? 144 : 128;
        if (wt >= n) return false;
        const int cc = combo - 8;
        b = 2 * xq + (cc >> 1);
        if (wt < 128) { kind = 1; h = (cc & 1) * 2 + (wt & 1); a = wt >> 1; } else { const int r = wt - 128; kind = 3; h = (cc & 1) * 2 + (r & 1); a = r >> 1; }
    }
    return true;
}
__device__ __forceinline__ void phase_mix(const Params& p, int lc, int l, unsigned char* smem) {
    volatile int* s_task = (volatile int*)(smem + LDS_MAIN + 64);
    const int tid = opaque_tid(), lane = tid & 63;
    const int w = __builtin_amdgcn_readfirstlane(tid >> 6);
    const bool ctx_out = l < DEPTH - 1;
    const int x0 = (int)(xb_xcc_id() & 7u);
    unsigned* cbase = (unsigned*)(p.ws + WS_CNT) + lc * 128;
    for (int k = 0; k < 8; ++k) {
        const int xq = (x0 + k) & 7;
        unsigned* cnt = cbase + xq * 16;
        while (true) {
            const int task = __builtin_amdgcn_readfirstlane(next_task(cnt + 0, s_task));
            if (task >= 16) break;
            gla_task(p, l, 2 * xq + (task >> 3), (task >> 1) & 3, task & 1, smem);
        }
    }
    const int slot = __builtin_amdgcn_readfirstlane(next_task(cbase + x0 * 16 + 3, s_task));
    const int mycombo = (slot & 1) ? (8 + ((slot >> 1) & 3)) : ((slot >> 1) & 7);
    {
        const int cb = 2 * x0 + (mycombo < 8 ? (mycombo >> 2) : ((mycombo - 8) >> 1));
        const bool na = mycombo < 8;
        const int hh = na ? (mycombo & 3) : ((mycombo - 8) & 1);
        unsigned char* big = p.ws + WS_BIG;
        const bf16_t* Pb = (const bf16_t*)(big + B_P) + (size_t)cb * SL * PSTR + (na ? OFF_NAK : OFF_SK) + hh * 64;
        const bf16_t* Vb = na ? ((const bf16_t*)(big + B_VTN) + (size_t)(cb * 4 + hh) * 64 * SL) : ((const bf16_t*)(big + B_VTS) + (size_t)(cb * 2 + hh) * 64 * SL);
        {
            const int row = tid >> 1, half = tid & 1;
            const bf16_t* src = Pb + (size_t)row * PSTR + half * 32;
            unsigned char* dst = smem + LDS_KC + row * 144 + half * 64;
#pragma unroll
            for (int q = 0; q < 4; ++q) *(bf16x8*)(dst + q * 16) = *(const bf16x8*)(src + q * 8);
        }
        {
            const int d = tid >> 3, part = tid & 7;
            const bf16_t* src = Vb + (size_t)d * SL + part * 32;
            unsigned char* dst = smem + LDS_VC + d * 528 + part * 64;
#pragma unroll
            for (int q = 0; q < 4; ++q) *(bf16x8*)(dst + q * 16) = *(const bf16x8*)(src + q * 8);
        }
        __syncthreads();
    }
    if (w < 4) {
        int lane_s = lane; asm volatile("" : "+v"(lane_s));
        float* bu = (float*)(smem + w * 12800);
        bf16_t* hb = (bf16_t*)(smem + w * 12800 + 8448);
        for (int k = 0; k < 8; ++k) {
            const int xq = (x0 + k) & 7;
            unsigned* cnt = cbase + xq * 16;
            while (true) {
                const int wt = wave_next(cnt + 1, lane_s);
                if (wt >= 64) break;
                s5_task(p, l, 2 * xq + (wt >> 5), (wt >> 1) & 15, wt & 1, lane_s, bu, hb);
            }
        }
    }
    int lane_a = lane; asm volatile("" : "+v"(lane_a));
    float* rpbl = (float*)(smem + LDS_RPB + w * 2048);
    const char* Kc = (const char*)(smem + LDS_KC);
    const char* Vc = (const char*)(smem + LDS_VC);
    int staged_h = -1;
    auto run_combo = [&](int xq, int combo, bool cached) {
        unsigned* cnt = cbase + xq * 16;
        while (true) {
            const int wt = wave_next(cnt + 4 + combo, lane_a);
            int kind, b, a, c, h;
            if (!combo_task(combo, wt, ctx_out, xq, kind, b, a, c, h)) break;
            if (kind == 0 && staged_h != h) {
                WAVE_LDS_SYNC();
                for (int i = lane_a; i < 15 * 31; i += 64) rpbl[i] = p.na_rpb[(size_t)(l * 4 + h) * 465 + i] * LOG2E;
                WAVE_LDS_SYNC();
                staged_h = h;
            }
            if (cached) attn_task<true>(p, l, kind, b, a, c, h, lane_a, rpbl, Kc, Vc);
            else attn_task<false>(p, l, kind, b, a, c, h, lane_a, rpbl, Kc, Vc);
        }
    };
    run_combo(x0, mycombo, true);
    const int n_na = ctx_out ? 72 : 64, n_swa = ctx_out ? 144 : 128;
    for (int k = 0; k < 8; ++k) {
        const int xq = (x0 + k) & 7;
        for (int pass = 0; pass < 2; ++pass) {
            unsigned v = 0xffffffffu;
            if (lane_a < 12) v = __hip_atomic_load(cbase + xq * 16 + 4 + lane_a, __ATOMIC_RELAXED, __HIP_MEMORY_SCOPE_AGENT);
            const bool avail = (lane_a < 12) && ((int)v < (lane_a < 8 ? n_na : n_swa));
            unsigned long long mask = __ballot(avail);
            if (mask == 0ull) break;
            while (mask) {
                const int combo = __builtin_ctzll(mask);
                mask &= mask - 1ull;
                run_combo(xq, combo, false);
            }
        }
    }
}

__device__ __forceinline__ void phase_fin(const Params& p, int l, unsigned char* smem) {
    const int tid = opaque_tid(), lane = tid & 63, w = tid >> 6, fr = lane & 15, fq = lane >> 4;
    const bool ctx_out = l < DEPTH - 1;
    unsigned char* big = p.ws + WS_BIG;
    const bf16_t* P = (const bf16_t*)(big + B_P);
    bf16_t* YM = (bf16_t*)(big + B_YM);
    const bf16_t* YS = (const bf16_t*)(big + B_YS);
    const bf16_t* OG = (const bf16_t*)(big + B_OG);
    const bf16_t* WG = (const bf16_t*)(p.ws + WS_WGLU) + (size_t)l * 256 * 256;
    constexpr int TB = 144, ZS = 264;
    bf16_t* zb = (bf16_t*)smem;
    for (int bt = opaque_bid(); bt < NT / TB; bt += gridDim.x) {
        const size_t tok0 = (size_t)bt * TB;
        bf16x8 wA[2][8];
#pragma unroll
        for (int t = 0; t < 2; ++t)
#pragma unroll
            for (int ks = 0; ks < 8; ++ks) wA[t][ks] = *(const bf16x8*)(WG + (size_t)(w * 32 + t * 16 + fr) * 256 + ks * 32 + fq * 8);
        for (int idx = tid; idx < TB * 32; idx += NTH) {
            const int tt = idx >> 5, c = (idx & 31) * 8;
            const size_t tok = tok0 + tt;
            const bf16x8 u = *(const bf16x8*)(P + tok * PSTR + OFF_A + c);
            const bf16x8 yf = *(const bf16x8*)(YS + tok * 256 + c);
            const bf16x8 yr = *(const bf16x8*)(YS + ((size_t)NT + tok) * 256 + c);
            const float4 d0 = *(const float4*)(p.s5_d + l * 256 + c);
            const float4 d1 = *(const float4*)(p.s5_d + l * 256 + c + 4);
            const float dd[8] = {d0.x, d0.y, d0.z, d0.w, d1.x, d1.y, d1.z, d1.w};
            float z[8];
#pragma unroll
            for (int k = 0; k < 8; ++k) z[k] = gelu_tanh(dd[k] * bf2f((bf16_t)u[k]) + bf2f((bf16_t)yf[k]) + bf2f((bf16_t)yr[k]));
            *(bf16x8*)(zb + tt * ZS + c) = pack8(z[0], z[1], z[2], z[3], z[4], z[5], z[6], z[7]);
        }
        __syncthreads();
        for (int tg = 0; tg < TB / 16; ++tg) {
            bf16x8 zB[8];
#pragma unroll
            for (int ks = 0; ks < 8; ++ks) zB[ks] = *(const bf16x8*)(zb + (tg * 16 + fr) * ZS + ks * 32 + fq * 8);
            bf16_t* orow = YM + (tok0 + tg * 16 + fr) * DM;
#pragma unroll
            for (int t = 0; t < 2; ++t) {
                f32x4 acc = (f32x4){0.f, 0.f, 0.f, 0.f};
#pragma unroll
                for (int ks = 0; ks < 8; ++ks) acc = MFMA16(wA[t][ks], zB[ks], acc);
                const int n0 = w * 32 + t * 16 + fq * 4;
                const bf16x4 z4 = *(const bf16x4*)(zb + (tg * 16 + fr) * ZS + n0);
                *(bf16x4*)(orow + n0) = pack4(bf2f((bf16_t)z4[0]) * sigmoidf_(acc[0]), bf2f((bf16_t)z4[1]) * sigmoidf_(acc[1]),
                                              bf2f((bf16_t)z4[2]) * sigmoidf_(acc[2]), bf2f((bf16_t)z4[3]) * sigmoidf_(acc[3]));
            }
        }
        __syncthreads();
    }
    {
        const int gw = opaque_bid() * NW + w, nw = gridDim.x * NW;
        const int tk = lane >> 4, c = (lane & 15) * 16;
        const float4 g0 = *(const float4*)(p.gla_g_norm + l * 64 + (c & 63));
        const float4 g1 = *(const float4*)(p.gla_g_norm + l * 64 + (c & 63) + 4);
        const float4 g2 = *(const float4*)(p.gla_g_norm + l * 64 + (c & 63) + 8);
        const float4 g3 = *(const float4*)(p.gla_g_norm + l * 64 + (c & 63) + 12);
        const float gn[16] = {g0.x, g0.y, g0.z, g0.w, g1.x, g1.y, g1.z, g1.w, g2.x, g2.y, g2.z, g2.w, g3.x, g3.y, g3.z, g3.w};
        for (int t4 = gw; t4 < NT / 4; t4 += nw) {
            const size_t tok = (size_t)t4 * 4 + tk;
            if (!ctx_out && (int)(tok % SL) < CL) continue;
            float o[16]; float ss = 0.f;
#pragma unroll
            for (int hlf = 0; hlf < 2; ++hlf) {
                const bf16x8 a = *(const bf16x8*)(OG + tok * 256 + c + hlf * 8);
                const bf16x8 bq = *(const bf16x8*)(OG + ((size_t)NT + tok) * 256 + c + hlf * 8);
#pragma unroll
                for (int k = 0; k < 8; ++k) { o[hlf * 8 + k] = bf2f((bf16_t)a[k]) + bf2f((bf16_t)bq[k]); ss += o[hlf * 8 + k] * o[hlf * 8 + k]; }
            }
            ss = DPP_ADD(ss, 0xB1); ss = DPP_ADD(ss, 0x4E);
            const float rstd = rsqrtf(ss * (1.f / 64.f) + EPS);
#pragma unroll
            for (int hlf = 0; hlf < 2; ++hlf) {
                const bf16x8 rr = *(const bf16x8*)(P + tok * PSTR + OFF_GR + c + hlf * 8);
                float v[8];
#pragma unroll
                for (int k = 0; k < 8; ++k) v[k] = o[hlf * 8 + k] * rstd * gn[hlf * 8 + k] * siluf_(bf2f((bf16_t)rr[k]));
                *(bf16x8*)(YM + tok * DM + 512 + c + hlf * 8) = pack8(v[0], v[1], v[2], v[3], v[4], v[5], v[6], v[7]);
            }
        }
    }
}

__device__ __forceinline__ void phase_fixup(const Params& p, int l) {
    unsigned char* big = p.ws + WS_BIG;
    bf16_t* ACT = (bf16_t*)(big + B_ACT);
    const bf16_t* GB = (const bf16_t*)(big + B_GB);
    const bf16_t* VB = (const bf16_t*)(big + B_VB);
    const float* cw = p.ffn_conv + (size_t)l * 3 * DFF;
    constexpr int NG = DFF / 8, NS = NT / 64;
    const int total = NS * 2 * NG;
    for (int idx = opaque_bid() * NTH + opaque_tid(); idx < total; idx += gridDim.x * NTH) {
        const int j = (idx % NG) * 8, rs = idx / NG, which = rs & 1, s = rs >> 1;
        const int sin = s % 36;
        if (l == DEPTH - 1 && sin < 4) continue;
        const bf16x8 zero8 = (bf16x8){0, 0, 0, 0, 0, 0, 0, 0};
        bf16x8 gp, gc, gn, vv; int row;
        if (which == 0) {
            row = s * 64;
            const bool hasp = !(sin == 0 || sin == 4);
            gp = hasp ? *(const bf16x8*)(GB + ((size_t)(s - 1) * 4 + 3) * DFF + j) : zero8;
            gc = *(const bf16x8*)(GB + ((size_t)s * 4 + 0) * DFF + j);
            gn = *(const bf16x8*)(GB + ((size_t)s * 4 + 1) * DFF + j);
            vv = *(const bf16x8*)(VB + ((size_t)s * 2 + 0) * DFF + j);
        } else {
            row = s * 64 + 63;
            const bool hasn = !(sin == 3 || sin == 35);
            gp = *(const bf16x8*)(GB + ((size_t)s * 4 + 2) * DFF + j);
            gc = *(const bf16x8*)(GB + ((size_t)s * 4 + 3) * DFF + j);
            gn = hasn ? *(const bf16x8*)(GB + ((size_t)(s + 1) * 4 + 0) * DFF + j) : zero8;
            vv = *(const bf16x8*)(VB + ((size_t)s * 2 + 1) * DFF + j);
        }
        float c0[8], c1[8], c2[8], o[8];
        *(float4*)&c0[0] = *(const float4*)(cw + j); *(float4*)&c0[4] = *(const float4*)(cw + j + 4);
        *(float4*)&c1[0] = *(const float4*)(cw + DFF + j); *(float4*)&c1[4] = *(const float4*)(cw + DFF + j + 4);
        *(float4*)&c2[0] = *(const float4*)(cw + 2 * DFF + j); *(float4*)&c2[4] = *(const float4*)(cw + 2 * DFF + j + 4);
#pragma unroll
        for (int k = 0; k < 8; ++k) {
            const float gg = c0[k] * bf2f((bf16_t)gp[k]) + c1[k] * bf2f((bf16_t)gc[k]) + c2[k] * bf2f((bf16_t)gn[k]);
            o[k] = gelu_tanh(gg) * bf2f((bf16_t)vv[k]);
        }
        *(bf16x8*)(ACT + (size_t)row * DFF + j) = pack8(o[0], o[1], o[2], o[3], o[4], o[5], o[6], o[7]);
    }
}

#define LAUNDER(ptr) asm volatile("" : "+s"(ptr))
__device__ __forceinline__ void run_phase(const Params& p0, int ph, unsigned char* smem) {
    Params p = p0;
    { size_t zoff = 0; asm volatile("" : "+s"(zoff)); p.ws = p0.ws + zoff; }
    unsigned char* big = p.ws + WS_BIG;
    if (ph == 0) { phase_mod(p, smem); return; }
    if (ph == 1) { phase_pre0(p, smem); phase_rowwise(p, 0, 0); return; }
    const int l = ph < NPRE ? 0 : (ph - NPRE) / NPL, q = ph < NPRE ? -1 : (ph - NPRE) % NPL;
    const bool last = (l == DEPTH - 1);
    if (q == 5 || q == 9) {
        phase_rowwise(p, q == 5 ? 1 : 2, l);
    } else if (q == 1) {
        phase_prep(p, smem);
    } else if (q == 2) {
        phase_mix(p, l, l, smem);
    } else if (q == 3) {
        phase_fin(p, l, smem);
    } else if (q == 7) {
        phase_fixup(p, l);
    } else if (q == 6) {
        pg8::Gemm g; g.A = (const bf16_t*)(big + B_HFFN); g.Bt = (const bf16_t*)(p.ws + WS_WUP) + (size_t)l * DUP * DM; g.M = NT; g.N = DUP; g.K = DM; g.ld = DM;
        EpiConv E; E.ACT = (bf16_t*)(big + B_ACT); E.GB = (bf16_t*)(big + B_GB); E.VB = (bf16_t*)(big + B_VB); E.cw = p.ffn_conv + (size_t)l * 3 * DFF;
        SkipOrder S; S.skip = last ? 1 : 0;
        S.init(last ? (g.M / 9) * 8 : g.M, g.N, (int)gridDim.x, opaque_bid());
        pg8::gemm_phase<EpiConv, SkipOrder>((PG8_LAS unsigned char*)smem, g, S, E, nullptr);
    } else {
        pg8::Gemm g; EpiStore E; E.split_cols = 0; E.split_stride = 0; int skip = last ? 1 : 0;
        if (q == 0) {
            g.A = (const bf16_t*)(big + B_HMIX); g.Bt = (const bf16_t*)(p.ws + WS_WIN) + (size_t)l * PSTR * DM; g.M = NT; g.N = PSTR; g.K = DM; g.ld = DM;
            E.O = (bf16_t*)(big + B_P); E.ldc = PSTR; skip = 0;
        } else if (q == 4) {
            g.A = (const bf16_t*)(big + B_YM); g.Bt = (const bf16_t*)(p.ws + WS_WOUT) + (size_t)l * DM * DM; g.M = NT; g.N = DM; g.K = DM; g.ld = DM;
            E.O = (bf16_t*)(big + B_T); E.ldc = DM; if (!last) skip = 1;
        } else {
            g.A = (const bf16_t*)(big + B_ACT); g.Bt = (const bf16_t*)(p.ws + WS_WDOWN) + (size_t)l * DM * DFF; g.M = NT; g.N = DM; g.K = DFF; g.ld = DFF;
            E.O = (bf16_t*)(big + B_T); E.ldc = DM; skip = 1;
        }
        SkipOrder S; S.skip = skip;
        S.init(skip ? (g.M / 9) * 8 : g.M, g.N, (int)gridDim.x, opaque_bid());
        pg8::gemm_phase<EpiStore, SkipOrder>((PG8_LAS unsigned char*)smem, g, S, E, nullptr);
        if ((q == 8 || q == 4) && !last) {
#pragma unroll 1
            for (int kq = 0; kq < 2; ++kq) {
                const int kh = g.K / 2;
                pg8::Gemm g2 = g; g2.A = g.A + kq * kh; g2.Bt = g.Bt + kq * kh; g2.K = kh; g2.ld = g.K; g2.M = NBATCH * 256;
                EpiPart E2; E2.O = (float*)(big + (q == 8 ? B_PART : B_ACT)) + (size_t)kq * NBATCH * CL * DM;
                CtxOrder S2; S2.init(g2.M, g2.N, (int)gridDim.x, (opaque_bid() + (int)gridDim.x - kq * 64) % (int)gridDim.x);
                pg8::gemm_phase<EpiPart, CtxOrder>((PG8_LAS unsigned char*)smem, g2, S2, E2, nullptr);
            }
        }
    }
}

__global__ void __launch_bounds__(NTH, 2) mega(Params p) {
    extern __shared__ __attribute__((aligned(16))) unsigned char smem[];
    if (threadIdx.x < 64) ((volatile unsigned*)(smem + LDS_MAIN))[threadIdx.x] = 0u;
    __syncthreads();
    XcdBarrier bar = xcd_barrier_post((unsigned*)(p.ws + WS_BAR), (volatile LAS unsigned*)(smem + LDS_MAIN));
    if (p.phase_lo < 0) cg::this_grid().sync();
    for (int ph = p.phase_lo; ph < p.phase_hi; ++ph) {
        run_phase(p, ph, smem);
        if (ph + 1 < p.phase_hi) xcd_barrier(bar);
    }
}

extern "C" void kernel_launch(void* const* d_in, const int* in_sizes, int n_in, void* d_out, int out_size, void* d_ws, size_t ws_size,
                              hipStream_t stream) {
    Params p{};
    const float** f = (const float**)&p;
    for (int i = 0; i < 29; ++i) f[i] = (const float*)d_in[i];
    p.out = (float*)d_out;
    p.ws = (unsigned char*)d_ws;
    static int grid_blocks = 0;
    if (!grid_blocks) {
        int dev = 0, cus = 0;
        (void)hipGetDevice(&dev);
        (void)hipDeviceGetAttribute(&cus, hipDeviceAttributeMultiprocessorCount, dev);
        (void)hipFuncSetAttribute((const void*)mega, hipFuncAttributeMaxDynamicSharedMemorySize, LDS_BYTES);
        grid_blocks = cus;
        if (ws_size < WS_TOTAL) fprintf(stderr, "workspace too small: %zu < %zu\n", ws_size, (size_t)WS_TOTAL);
    }
    (void)hipMemsetAsync((char*)d_ws + WS_CNT, 0, WS_CTL_BYTES, stream);
    p.phase_lo = 0; p.phase_hi = NPHASE;
    void* args[] = {&p};
    hipError_t e = hipLaunchCooperativeKernel((void*)mega, dim3(grid_blocks), dim3(NTH), args, LDS_BYTES, stream);
    if (e != hipSuccess) fprintf(stderr, "cooperative launch failed: %s (grid %d)\n", hipGetErrorString(e), grid_blocks);
}
```

```cpp
#include <hip/hip_runtime.h>
#include <hip/hip_cooperative_groups.h>
#include <cstdio>
namespace cg = cooperative_groups;

__device__ __forceinline__ int pg8_opaque_tid() { int t = threadIdx.x; asm volatile("" : "+v"(t)); return t; }
namespace pg8 {
#define PG8_LAS __attribute__((address_space(3)))
typedef unsigned short bf16_t;
typedef short bf16x8 __attribute__((ext_vector_type(8)));
typedef float f32x4 __attribute__((ext_vector_type(4)));
typedef unsigned u32x4 __attribute__((ext_vector_type(4)));
constexpr int BM = 256, BK = 64, HALF = 128, HTB = HALF * BK * 2  , STAGE_BYTES = 8 * HTB, NXCD = 8, WGM = 8;

__host__ __device__ __forceinline__ int lds_byte(int r, int c) { const int st = (r >> 4) * 2 + (c >> 5), rr = r & 15, cc = c & 31, ob = rr * 64 + cc * 2; return st * 1024 + (ob ^ (((ob >> 9) & 1) << 5)); }
__host__ __device__ __forceinline__ void stage_rc(int b, int& R, int& C) { const int st = b / 1024, sb = b % 1024, swz = sb ^ (((sb >> 9) & 1) << 5); R = (st >> 1) * 16 + swz / 64; C = (st & 1) * 32 + (swz % 64) / 2; }
__host__ __device__ __forceinline__ int perm32(int rho) { const int n = rho >> 4, i = rho & 15; return 8 * (i >> 2) + 4 * n + (i & 3); }

struct Unit { int pm, pn; };
struct Gemm { const bf16_t* A; const bf16_t* Bt; int M, N, K, ld; };

struct StaticOrder {
    int nM, nN, nwg, G, c;
    __host__ __device__ void init(int M, int N, int G_, int c_) { nM = M / BM; nN = N / BM; nwg = nM * nN; G = G_; c = c_; }
    __host__ __device__ bool next(int i, Unit& u) const {
        const long L = (long)i * G + c; if (L >= nwg) return false;
        int wgid = (int)L; { const int q = nwg / NXCD, r = nwg % NXCD, xcd = wgid % NXCD, off = wgid / NXCD; wgid = (xcd < r ? xcd * (q + 1) : r * (q + 1) + (xcd - r) * q) + off; }
        const int nig = WGM * nN, gid = wgid / nig, fm = gid * WGM, gsz = (nM - fm) < WGM ? (nM - fm) : WGM;
        u.pm = fm + ((wgid % nig) % gsz); u.pn = (wgid % nig) / gsz; return true;
    }
    __device__ __forceinline__ void a_ready(const Unit&) const {}
    __device__ __forceinline__ void done(const Unit&) const {}
};
__device__ __forceinline__ unsigned cvt_pk_bf16(float lo, float hi) { unsigned r; asm volatile("v_cvt_pk_bf16_f32 %0, %1, %2" : "=v"(r) : "v"(lo), "v"(hi)); return r; }
template <class Epi, class Sched, bool STAMP = false>
__device__ __forceinline__ void gemm_phase(PG8_LAS unsigned char* lds, const Gemm g, const Sched& S, const Epi& E, unsigned long long* stamps) {
    const int tid = pg8_opaque_tid(), wid = __builtin_amdgcn_readfirstlane(tid >> 6), lane = tid & 63, wr = wid >> 2, wc = wid & 3, fr = lane & 15, fq = lane >> 4;
    const int K = g.K, nt = K / BK, LD = g.ld;
    int ts_lo = 0, ts_hi = 0, nts = 0; const unsigned long long rt_entry = STAMP ? (unsigned long long)wall_clock64() : 0ull;
#define PG8_STAMP() do { if (STAMP && wid == 0 && nts < 64) { const unsigned long long _c = (unsigned long long)clock64(); \
        ts_lo = (lane == nts) ? (int)(unsigned)_c : ts_lo; ts_hi = (lane == nts) ? (int)(unsigned)(_c >> 32) : ts_hi; ++nts; } } while (0)
    PG8_STAMP();
    unsigned voffA[2], voffB[2];
#pragma unroll
    for (int i = 0; i < 2; ++i) { int R, C; stage_rc(tid * 16 + i * 8192, R, C); const int Rb = Epi::PERM ? ((R & ~31) + perm32(R & 31)) : R;
        voffA[i] = (unsigned)(R * LD + C) * 2u; voffB[i] = (unsigned)(Rb * LD + C) * 2u; }
    const size_t kstep = (size_t)(BK * 2);
    const size_t hstep = (size_t)HALF * LD * 2;
    const size_t tstep = 2 * hstep;
    const unsigned ldsw = (unsigned)wid * 1024u;
    const int aoff = lds_byte(wr * 64 + fr, fq * 8), boff = lds_byte(wc * 32 + fr, fq * 8);
#define PG8_SA(b, h) (((b) * 2 + (h)) * HTB)
#define PG8_SB(b, h) ((4 + (b) * 2 + (h)) * HTB)
#define PG8_STAGE(bufoff, gbase, voff) do { _Pragma("unroll") for (int _i = 0; _i < 2; ++_i) \
        __builtin_amdgcn_global_load_lds((const unsigned*)((const char*)(gbase) + (voff)[_i]), (PG8_LAS unsigned*)(lds + (bufoff) + ldsw + _i * 8192), 16, 0, 0); } while (0)
#define PG8_LDA(dst, b, h) do { _Pragma("unroll") for (int m = 0; m < 4; ++m) _Pragma("unroll") for (int k = 0; k < 2; ++k) dst[m][k] = *(const PG8_LAS bf16x8*)(lds + PG8_SA(b, h) + aoff + m * 2048 + k * 1024); } while (0)
#define PG8_LDB(dst, b, h) do { _Pragma("unroll") for (int n = 0; n < 2; ++n) _Pragma("unroll") for (int k = 0; k < 2; ++k) dst[n][k] = *(const PG8_LAS bf16x8*)(lds + PG8_SB(b, h) + boff + n * 2048 + k * 1024); } while (0)
#define PG8_MMA(ai, bj, At, Bt) do { __builtin_amdgcn_s_setprio(1); _Pragma("unroll") for (int m = 0; m < 4; ++m) _Pragma("unroll") for (int n = 0; n < 2; ++n) _Pragma("unroll") for (int k = 0; k < 2; ++k) \
        acc[ai][bj][m][n] = __builtin_amdgcn_mfma_f32_16x16x32_bf16(Bt[n][k], At[m][k], acc[ai][bj][m][n], 0, 0, 0); __builtin_amdgcn_s_setprio(0); } while (0)
#define PG8_WAIT_V(n) asm volatile("s_waitcnt vmcnt(" #n ")" ::: "memory")
#define PG8_WAIT_L(n) asm volatile("s_waitcnt lgkmcnt(" #n ")" ::: "memory")
#define PG8_BAR __builtin_amdgcn_s_barrier()
#define PG8_SCHED __builtin_amdgcn_sched_barrier(0)
    Unit cur, nxt; int ui = 0;
    if (!S.next(0, cur)) return;
    f32x4 acc[2][2][4][2];
#pragma unroll
    for (int a = 0; a < 2; ++a)
#pragma unroll
        for (int b = 0; b < 2; ++b)
#pragma unroll
            for (int m = 0; m < 4; ++m)
#pragma unroll
                for (int n = 0; n < 2; ++n) acc[a][b][m][n] = (f32x4){0.f, 0.f, 0.f, 0.f};
    bf16x8 At[4][2], B0[2][2], B1[2][2];
    const char* cA = (const char*)g.A + (size_t)cur.pm * tstep; const char* cB = (const char*)g.Bt + (size_t)cur.pn * tstep;
    S.a_ready(cur);
    PG8_STAGE(PG8_SB(0, 0), cB, voffB); PG8_STAGE(PG8_SA(0, 0), cA, voffA); PG8_STAGE(PG8_SB(0, 1), cB + hstep, voffB); PG8_STAGE(PG8_SA(0, 1), cA + hstep, voffA);
    if (wr == 1) PG8_BAR;
    PG8_WAIT_V(4); PG8_BAR;
    PG8_STAGE(PG8_SB(1, 0), cB + kstep, voffB); PG8_STAGE(PG8_SA(1, 0), cA + kstep, voffA); PG8_STAGE(PG8_SB(1, 1), cB + hstep + kstep, voffB);
    PG8_WAIT_V(6); PG8_BAR;
    PG8_STAMP();
    for (;;) {
        const bool has_next = S.next(ui + 1, nxt);
        const char* nA = has_next ? (const char*)g.A + (size_t)nxt.pm * tstep : cA; const char* nB = has_next ? (const char*)g.Bt + (size_t)nxt.pn * tstep : cB;
        for (int t = 0; t < nt; t += 2) {
            const bool last = (t == nt - 2);
            const char* a1 = cA + (size_t)(t + 1) * kstep;
            const char* a2 = last ? nA : cA + (size_t)(t + 2) * kstep; const char* b2 = last ? nB : cB + (size_t)(t + 2) * kstep;
            const char* a3 = a2 + kstep; const char* b3 = b2 + kstep;
            if (last && has_next) S.a_ready(nxt);
            PG8_LDB(B0, 0, 0); PG8_SCHED; PG8_LDA(At, 0, 0); PG8_STAGE(PG8_SA(1, 1), a1 + hstep, voffA);
            PG8_WAIT_L(8); PG8_BAR; PG8_WAIT_L(0); PG8_MMA(0, 0, At, B0); PG8_BAR; PG8_SCHED;
            PG8_LDB(B1, 0, 1); PG8_STAGE(PG8_SB(0, 0), b2, voffB);
            PG8_BAR; PG8_WAIT_L(0); PG8_MMA(0, 1, At, B1); PG8_BAR;
            PG8_LDA(At, 0, 1); PG8_STAGE(PG8_SA(0, 0), a2, voffA);
            PG8_BAR; PG8_WAIT_L(0); PG8_MMA(1, 0, At, B0); PG8_BAR; PG8_SCHED;
            PG8_STAGE(PG8_SB(0, 1), b2 + hstep, voffB);
            PG8_WAIT_V(6); PG8_BAR; PG8_MMA(1, 1, At, B1); PG8_BAR;
            PG8_LDB(B0, 1, 0); PG8_SCHED; PG8_LDA(At, 1, 0); PG8_STAGE(PG8_SA(0, 1), a2 + hstep, voffA);
            PG8_WAIT_L(8); PG8_BAR; PG8_WAIT_L(0); PG8_MMA(0, 0, At, B0); PG8_BAR; PG8_SCHED;
            PG8_LDB(B1, 1, 1); PG8_STAGE(PG8_SB(1, 0), b3, voffB);
            PG8_BAR; PG8_WAIT_L(0); PG8_MMA(0, 1, At, B1); PG8_BAR;
            PG8_LDA(At, 1, 1); PG8_STAGE(PG8_SA(1, 0), a3, voffA);
            PG8_BAR; PG8_WAIT_L(0); PG8_MMA(1, 0, At, B0); PG8_BAR; PG8_SCHED;
            PG8_STAGE(PG8_SB(1, 1), b3 + hstep, voffB);
            PG8_WAIT_V(6); PG8_BAR; PG8_MMA(1, 1, At, B1); PG8_BAR;
        }
        PG8_STAMP();
        if constexpr (!Epi::AFTER_DRAIN) { E(acc, cur, wr, wc, fr, fq); S.done(cur); }
        PG8_STAMP();
        if (!has_next) break;
#pragma unroll
        for (int a = 0; a < 2; ++a)
#pragma unroll
            for (int b = 0; b < 2; ++b)
#pragma unroll
                for (int m = 0; m < 4; ++m)
#pragma unroll
                    for (int n = 0; n < 2; ++n) acc[a][b][m][n] = (f32x4){0.f, 0.f, 0.f, 0.f};
        cur = nxt; cA = nA; cB = nB; ++ui;
    }
    PG8_WAIT_V(0);
    if (wr == 0) PG8_BAR;
    PG8_BAR;
    if constexpr (Epi::AFTER_DRAIN) { E.fused(acc, cur, wr, wc, fr, fq, lds, wid, lane); S.done(cur); }
    PG8_STAMP();
    if (STAMP && wid == 0) { stamps[lane] = lane < nts ? (((unsigned long long)(unsigned)ts_hi << 32) | (unsigned)ts_lo) : 0ull;
        if (lane == 62) stamps[62] = rt_entry; if (lane == 63) stamps[63] = (unsigned long long)wall_clock64(); }
#undef PG8_STAMP
#undef PG8_SA
#undef PG8_SB
#undef PG8_STAGE
#undef PG8_LDA
#undef PG8_LDB
#undef PG8_MMA
#undef PG8_WAIT_V
#undef PG8_WAIT_L
#undef PG8_BAR
#undef PG8_SCHED
}
}


#define XB_SPIN_CAP_OVERRIDE 1
#define XB_TMO      128
#define XB_XCNT(j)  (256  + 64 * (j))
#define XB_XSUB(j)  (1280 + 64 * (j))
#define XB_XGEN(j)  (2304 + 64 * (j))
#define XB_TOP      3328
#define XB_TOPGEN   3392
#define XCD_BAR_WORDS 3456
#define XB_SPIN_CAP (1u << 22)
#define LAS __attribute__((address_space(3)))

__device__ __forceinline__ unsigned xb_ld(unsigned* p)              { return __hip_atomic_load(p, __ATOMIC_RELAXED, __HIP_MEMORY_SCOPE_AGENT); }
__device__ __forceinline__ unsigned xb_add(unsigned* p, unsigned v) { return __hip_atomic_fetch_add(p, v, __ATOMIC_RELAXED, __HIP_MEMORY_SCOPE_AGENT); }
__device__ __forceinline__ unsigned xb_xcc_id() { return (unsigned)__builtin_amdgcn_s_getreg((3 << 11) | 20) & 0xFu; }
#define XB_SPIN(cond, bar) do { unsigned _sp = 0; while (cond) { __builtin_amdgcn_s_sleep(1); \
    if ((++_sp & 255u) == 0u) { if (xb_ld(&(bar)[XB_TMO])) break; if (_sp > XB_SPIN_CAP) { atomicAdd(&(bar)[XB_TMO], 1u); break; } } } } while (0)

struct XcdBarrier {
    unsigned* bar; unsigned x;
    volatile LAS unsigned* st;
};

__device__ __forceinline__ XcdBarrier xcd_barrier_post(unsigned* bar, volatile LAS unsigned* st) {
    XcdBarrier b; b.bar = bar; b.x = xb_xcc_id(); b.st = st;
    if (threadIdx.x == 0) (void)xb_add(&bar[XB_XCNT(b.x)], 1u);
    return b;
}
__device__ __forceinline__ void xcd_barrier_complete(unsigned* bar, unsigned x, unsigned& nloc, unsigned& nx) {
    const unsigned G = gridDim.x * gridDim.y * gridDim.z;
    unsigned sum, cnt, mine, sp = 0u;
    for (;;) {
        sum = 0u; cnt = 0u; mine = 0u;
#pragma unroll
        for (unsigned j = 0; j < 16; ++j) { const unsigned c = xb_ld(&bar[XB_XCNT(j)]); sum += c; cnt += (c > 0u) ? 1u : 0u; mine = (j == x) ? c : mine; }
        if (sum == G) break;
        __builtin_amdgcn_s_sleep(1);
        if ((++sp & 255u) == 0u) { if (xb_ld(&bar[XB_TMO])) break; if (sp > XB_SPIN_CAP) { atomicAdd(&bar[XB_TMO], 1u); break; } }
    }
    nloc = mine > 0u ? mine : 1u; nx = cnt > 0u ? cnt : 1u;
}

__device__ __forceinline__ void xcd_barrier(const XcdBarrier& b) {
    asm volatile("s_waitcnt vmcnt(0)" ::: "memory");
    __syncthreads();
    if (threadIdx.x == 0) {
        unsigned* bar = b.bar;
        __builtin_amdgcn_s_waitcnt(0);
        unsigned nloc = b.st[0], nx = b.st[1];
        if (nloc == 0u) { xcd_barrier_complete(bar, b.x, nloc, nx); b.st[0] = nloc; b.st[1] = nx; }
        const unsigned old = xb_add(&bar[XB_XSUB(b.x)], 1u);
        const unsigned gen = old / nloc;
        if (old + 1u == (gen + 1u) * nloc) {
            __builtin_amdgcn_fence(__ATOMIC_RELEASE, "agent");
            asm volatile("s_waitcnt vmcnt(0)" ::: "memory");
            const unsigned og = xb_add(&bar[XB_TOP], 1u);
            const unsigned tg = og / nx;
            if (og + 1u == (tg + 1u) * nx) xb_add(&bar[XB_TOPGEN], 1u);
            else XB_SPIN(xb_ld(&bar[XB_TOPGEN]) == tg, bar);
            __builtin_amdgcn_fence(__ATOMIC_ACQUIRE, "agent");
            xb_add(&bar[XB_XGEN(b.x)], 1u);
            asm volatile("s_waitcnt vmcnt(0)" ::: "memory");
        } else {
            XB_SPIN(xb_ld(&bar[XB_XGEN(b.x)]) == gen, bar);
            __builtin_amdgcn_fence(__ATOMIC_ACQUIRE, "agent");
            asm volatile("s_waitcnt vmcnt(0)" ::: "memory");
        }
    }
    __syncthreads();
}


typedef unsigned short bf16_t;
typedef short bf16x8 __attribute__((ext_vector_type(8)));
typedef short bf16x4 __attribute__((ext_vector_type(4)));
typedef float f32x4 __attribute__((ext_vector_type(4)));
typedef unsigned u32x4 __attribute__((ext_vector_type(4)));
#define MFMA16(a, b, c) __builtin_amdgcn_mfma_f32_16x16x32_bf16(a, b, c, 0, 0, 0)
#define WAVE_LDS_SYNC() asm volatile("s_waitcnt lgkmcnt(0)" ::: "memory")

constexpr int NTH = 512, NW = 8;
constexpr int DM = 1024, NBATCH = 16, SEQ = 2048, CL = 256, SL = 2304, NT = NBATCH * SL, DEPTH = 4;
constexpr int DIN = 2592, PSTR = 2816, DFF = 2816, DUP = 5632, HALF_T = NT / 2;
constexpr int OFF_A = 0, OFF_NAQ = 256, OFF_NAK = 512, OFF_NAV = 768, OFF_GQ = 1024, OFF_GK = 1280, OFF_GV = 1536,
              OFF_GF = 1792, OFF_GB = 1808, OFF_GR = 1824, OFF_SQ = 2080, OFF_SK = 2336, OFF_SV = 2464;
constexpr float EPS = 1e-6f;
constexpr float NEG = -1e30f;

constexpr size_t WS_XC = 0;
constexpr size_t WS_WIN = WS_XC + (size_t)NBATCH * CL * DM * 4;
constexpr size_t WS_WOUT = WS_WIN + (size_t)DEPTH * PSTR * DM * 2;
constexpr size_t WS_WUP = WS_WOUT + (size_t)DEPTH * DM * DM * 2;
constexpr size_t WS_WDOWN = WS_WUP + (size_t)DEPTH * DUP * DM * 2;
constexpr size_t WS_WGLU = WS_WDOWN + (size_t)DEPTH * DM * DFF * 2;
constexpr size_t WS_SC = WS_WGLU + (size_t)DEPTH * 256 * 256 * 2;
constexpr size_t WS_MOD = WS_SC + (size_t)17 * 1024 * 4;
constexpr size_t WS_CNT = WS_MOD + (size_t)DEPTH * 17 * 6144 * 4;
constexpr size_t WS_BAR = WS_CNT + 4096;
constexpr size_t WS_CTL_BYTES = 4096 + (size_t)XCD_BAR_WORDS * 4;
constexpr size_t WS_BIG = (WS_BAR + (size_t)XCD_BAR_WORDS * 4 + 255) / 256 * 256;
constexpr size_t B_P = 0;
constexpr size_t B_YM = B_P + (size_t)NT * PSTR * 2;
constexpr size_t B_VTN = B_YM + (size_t)NT * DM * 2;
constexpr size_t B_VTS = B_VTN + (size_t)NBATCH * 4 * 64 * SL * 2;
constexpr size_t B_YS = B_VTS + (size_t)NBATCH * 2 * 64 * SL * 2;
constexpr size_t B_OG = B_YS + (size_t)2 * NT * 256 * 2;
constexpr size_t B_END = B_OG + (size_t)2 * NT * 256 * 2;
constexpr size_t B_T = 0;
constexpr size_t B_ACT = B_T + (size_t)NT * DM * 2;
constexpr size_t B_HFFN = B_ACT + (size_t)NT * DFF * 2;
constexpr size_t B_GB = B_HFFN + (size_t)NT * DM * 2;
constexpr size_t B_VB = B_GB + (size_t)(NT / 64) * 4 * DFF * 2;
constexpr size_t B_HMIX = B_YM;
constexpr size_t B_PART = B_HFFN;
static_assert(B_VB + (size_t)(NT / 64) * 2 * DFF * 2 <= B_END, "ws overlay");
constexpr size_t WS_TOTAL = WS_BIG + B_END;

constexpr int LDS_MAIN = 139264, LDS_BYTES = LDS_MAIN + 256;
constexpr int LDS_KC = 51200, LDS_VC = LDS_KC + 256 * 144, LDS_RPB = LDS_VC + 64 * 528;
static_assert(LDS_RPB + 8 * 2048 <= LDS_MAIN, "lds map");
constexpr int NPRE = 2, NPL = 10, NPHASE = NPRE + DEPTH * NPL;

struct Params {
    const float *x, *c, *ctx, *c_ctx, *w_mod, *b_mod, *g_pre_mix, *g_post_mix, *g_pre_ffn, *g_post_ffn, *w_in, *w_out;
    const float *s5_lam_re, *s5_lam_im, *s5_b_re, *s5_b_im, *s5_c_re, *s5_c_im, *s5_log_step, *s5_d, *s5_w_glu;
    const float *na_rpb, *gla_w_gate2, *gla_b_gate, *gla_g_norm, *swa_sink, *ffn_w_up, *ffn_conv, *ffn_w_down;
    float* out;
    unsigned char* ws;
    int phase_lo, phase_hi;
};

__device__ __forceinline__ float bf2f(bf16_t h) { return __uint_as_float(((unsigned)h) << 16); }
__device__ __forceinline__ bf16_t f2bf(float f) { return __builtin_bit_cast(bf16_t, (__bf16)f); }
__device__ __forceinline__ float sigmoidf_(float x) { return 1.f / (1.f + __expf(-x)); }
__device__ __forceinline__ float siluf_(float x) { return x / (1.f + __expf(-x)); }
__device__ __forceinline__ float gelu_tanh(float x) {
    float u = 1.5957691216f * (x + 0.044715f * x * x * x);
    return x / (1.f + __expf(-u));
}
#define DPP_ADD(v, CTRL) ((v) + __uint_as_float(__builtin_amdgcn_update_dpp(0u, __float_as_uint(v), (CTRL), 0xF, 0xF, false)))
__device__ __forceinline__ float wave_sum(float v) {
    v = DPP_ADD(v, 0xB1);
    v = DPP_ADD(v, 0x4E);
    v = DPP_ADD(v, 0x141);
    v = DPP_ADD(v, 0x140);
    unsigned x = __float_as_uint(v);
    auto r = __builtin_amdgcn_permlane16_swap(x, x, false, false);
    v = __uint_as_float(r[0]) + __uint_as_float(r[1]);
    x = __float_as_uint(v);
    auto r2 = __builtin_amdgcn_permlane32_swap(x, x, false, false);
    return __uint_as_float(r2[0]) + __uint_as_float(r2[1]);
}
typedef unsigned u32x2 __attribute__((ext_vector_type(2)));
typedef float f32x2_t __attribute__((ext_vector_type(2)));
typedef __bf16 bf16v2_t __attribute__((ext_vector_type(2)));
__device__ __forceinline__ unsigned cvt2(float lo, float hi) { f32x2_t v = {lo, hi}; return __builtin_bit_cast(unsigned, __builtin_convertvector(v, bf16v2_t)); }
__device__ __forceinline__ bf16x4 pack4(float a, float b, float c, float d) {
    u32x2 r; r.x = cvt2(a, b); r.y = cvt2(c, d);
    return __builtin_bit_cast(bf16x4, r);
}
__device__ __forceinline__ bf16x8 pack8(float a, float b, float c, float d, float e, float f, float g, float h) {
    u32x4 r; r.x = cvt2(a, b); r.y = cvt2(c, d); r.z = cvt2(e, f); r.w = cvt2(g, h);
    return __builtin_bit_cast(bf16x8, r);
}
__device__ __forceinline__ int s_of(int dir, int i) { return dir == 0 ? i : (i < CL ? (CL - 1 - i) : (SL + CL - 1 - i)); }
__device__ __forceinline__ int clampi(int v, int lo, int hi) { return v < lo ? lo : (v > hi ? hi : v); }
__device__ __forceinline__ int opaque_tid() { int t = threadIdx.x; asm volatile("" : "+v"(t)); return t; }
__device__ __forceinline__ int opaque_bid() { int b = blockIdx.x; asm volatile("" : "+s"(b)); return b; }

constexpr int CVT_T_L = 16 * 44 + 16 * 16 + 16 * 88 + 44 * 16 + 4 * 4;
struct CvtTask { const float* src; bf16_t* dst; int K, N, k0, n0; bool up; };
__device__ __forceinline__ CvtTask cvt_task(const Params& p, int l, int r) {
    constexpr int T_IN = 16 * 44, T_OUT = 16 * 16, T_UP = 16 * 88, T_DOWN = 44 * 16;
    CvtTask t; int nkt;
    if (r < T_IN) { t.src = p.w_in + (size_t)l * DM * DIN; t.dst = (bf16_t*)(p.ws + WS_WIN) + (size_t)l * PSTR * DM; t.K = DM; t.N = DIN; nkt = 16; }
    else if ((r -= T_IN) < T_OUT) { t.src = p.w_out + (size_t)l * DM * DM; t.dst = (bf16_t*)(p.ws + WS_WOUT) + (size_t)l * DM * DM; t.K = DM; t.N = DM; nkt = 16; }
    else if ((r -= T_OUT) < T_UP) { t.src = p.ffn_w_up + (size_t)l * DM * DUP; t.dst = (bf16_t*)(p.ws + WS_WUP) + (size_t)l * DUP * DM; t.K = DM; t.N = DUP; nkt = 16; }
    else if ((r -= T_UP) < T_DOWN) { t.src = p.ffn_w_down + (size_t)l * DFF * DM; t.dst = (bf16_t*)(p.ws + WS_WDOWN) + (size_t)l * DM * DFF; t.K = DFF; t.N = DM; nkt = 44; }
    else { r -= T_DOWN; t.src = p.s5_w_glu + (size_t)l * 256 * 256; t.dst = (bf16_t*)(p.ws + WS_WGLU) + (size_t)l * 256 * 256; t.K = 256; t.N = 256; nkt = 4; }
    t.k0 = (r % nkt) * 64; t.n0 = (r / nkt) * 64; t.up = (t.N == DUP);
    return t;
}
__device__ __forceinline__ void cvt_tile(const CvtTask& t, float (*tile)[65], int tid) {
    const int tx = tid & 63, ty = tid >> 6;
#pragma unroll
    for (int i = 0; i < 8; ++i) {
        const int k = ty + 8 * i, n = t.n0 + tx;
        tile[k][tx] = (n < t.N) ? t.src[(size_t)(t.k0 + k) * t.N + n] : 0.f;
    }
    __syncthreads();
#pragma unroll
    for (int i = 0; i < 8; ++i) {
        const int n = ty + 8 * i;
        int nrow = t.n0 + n;
        if (t.up) { const int nn = nrow < DFF ? nrow : nrow - DFF; nrow = (nn >> 7) * 256 + (nrow < DFF ? 0 : 128) + (nn & 127); }
        t.dst[(size_t)nrow * t.K + t.k0 + tx] = f2bf(tile[tx][n]);
    }
    __syncthreads();
}
__device__ __forceinline__ void phase_pre0(const Params& p, int l, unsigned char* smem) {
    float(*tile)[65] = (float(*)[65])smem;
    const int tid = opaque_tid();
    for (int r = opaque_bid(); r < CVT_T_L; r += gridDim.x) cvt_tile(cvt_task(p, l, r), tile, tid);
}
__device__ __forceinline__ void cvt_filler(const Params& p, int l, unsigned* cnt, unsigned char* smem) {
    float(*tile)[65] = (float(*)[65])smem;
    volatile int* s_task = (volatile int*)(smem + LDS_MAIN + 64);
    const int tid = opaque_tid();
    while (true) {
        __syncthreads();
        if (tid == 0) *s_task = (int)atomicAdd(cnt, 4u);
        __syncthreads();
        const int r0 = __builtin_amdgcn_readfirstlane(*s_task);
        if (r0 >= CVT_T_L) break;
        for (int r = r0; r < r0 + 4 && r < CVT_T_L; ++r) cvt_tile(cvt_task(p, l, r), tile, tid);
    }
}

__device__ __forceinline__ void phase_mod(const Params& p, unsigned char* smem) {
    float* red = (float*)smem;
    float* scl = (float*)(smem + 36864);
    const int tid = opaque_tid(), lane = tid & 63;
    const int w = __builtin_amdgcn_readfirstlane(tid >> 6);
    float* MOD = (float*)(p.ws + WS_MOD);
    for (int i = tid; i < 17 * 1024; i += NTH) {
        const float v = (i < 16 * 1024) ? p.c[i] : p.c_ctx[i - 16 * 1024];
        scl[i] = siluf_(v);
    }
    __syncthreads();
    for (int task = opaque_bid(); task < DEPTH * 96; task += gridDim.x) {
        const int l = task / 96, j0 = (task % 96) * 64;
        const float* W = p.w_mod + (size_t)l * DM * 6144 + j0 + lane;
        float acc[17];
#pragma unroll
        for (int r = 0; r < 17; ++r) acc[r] = 0.f;
        for (int k = w * 128; k < w * 128 + 128; ++k) {
            const float wv = W[(size_t)k * 6144];
#pragma unroll
            for (int r = 0; r < 17; ++r) acc[r] += scl[r * 1024 + k] * wv;
        }
#pragma unroll
        for (int r = 0; r < 17; ++r) red[(w * 17 + r) * 64 + lane] = acc[r];
        __syncthreads();
        for (int i = tid; i < 17 * 64; i += NTH) {
            const int r = i >> 6, jj = i & 63;
            float s = 0.f;
#pragma unroll
            for (int ww = 0; ww < NW; ++ww) s += red[(ww * 17 + r) * 64 + jj];
            MOD[((size_t)(l * 17 + r)) * 6144 + j0 + jj] = s + p.b_mod[l * 6144 + j0 + jj];
        }
        __syncthreads();
    }
}

__device__ __forceinline__ void phase_rowwise(const Params& p, int mode, int l) {
    const int tid = opaque_tid();
    const int lane = tid & 63;
    const int gw = opaque_bid() * NW + (tid >> 6), nw = gridDim.x * NW;
    const float* MOD = (const float*)(p.ws + WS_MOD);
    float* Xc = (float*)(p.ws + WS_XC);
    unsigned char* big = p.ws + WS_BIG;
    const bf16_t* T = (const bf16_t*)(big + B_T);
    bf16_t* Hdst = (bf16_t*)(big + (mode == 1 ? B_HFFN : B_HMIX));
    const bool in_from_input = (l == 0 && mode != 2);
    const bool skipctx = (l == DEPTH - 1 && mode != 0);
    const int nrows = skipctx ? NBATCH * SEQ : NT;
    for (int i0 = gw; i0 < nrows; i0 += 2 * nw) {
        int tt[2]; bool ok[2];
        const float* xin[2]; float* xout[2]; int modrow[2];
#pragma unroll
        for (int r = 0; r < 2; ++r) {
            const int i = i0 + r * nw;
            ok[r] = i < nrows;
            const int ii = ok[r] ? i : i0;
            int b, s;
            if (skipctx) { b = ii / SEQ; s = CL + (ii - b * SEQ); } else { b = ii / SL; s = ii - b * SL; }
            tt[r] = b * SL + s;
            const bool isctx = s < CL;
            modrow[r] = isctx ? 16 : b;
            if (isctx) { xin[r] = (in_from_input ? p.ctx : Xc) + (size_t)(b * CL + s) * DM; xout[r] = Xc + (size_t)(b * CL + s) * DM; }
            else { xin[r] = (in_from_input ? p.x : p.out) + (size_t)(b * SEQ + s - CL) * DM; xout[r] = p.out + (size_t)(b * SEQ + s - CL) * DM; }
        }
        float xv[2][16];
#pragma unroll
        for (int r = 0; r < 2; ++r)
#pragma unroll
            for (int i = 0; i < 4; ++i) {
                const float4 v = *(const float4*)(xin[r] + i * 256 + lane * 4);
                xv[r][4 * i] = v.x; xv[r][4 * i + 1] = v.y; xv[r][4 * i + 2] = v.z; xv[r][4 * i + 3] = v.w;
            }
        if (mode != 0) {
            float rv[2][16]; float ss[2] = {0.f, 0.f};
#pragma unroll
            for (int r = 0; r < 2; ++r) {
                const bf16_t* tr = T + (size_t)tt[r] * DM;
                const bool part = (modrow[r] == 16);
                if (part) {
                    const int bb = tt[r] / SL, s = tt[r] - bb * SL;
                    const float* p0 = (const float*)(big + (mode == 2 ? B_PART : B_ACT)) + (size_t)(bb * CL + s) * DM;
                    const float* p1 = p0 + (size_t)NBATCH * CL * DM;
#pragma unroll
                    for (int i = 0; i < 4; ++i) {
                        const float4 a = *(const float4*)(p0 + i * 256 + lane * 4), c4 = *(const float4*)(p1 + i * 256 + lane * 4);
                        rv[r][4 * i] = a.x + c4.x; rv[r][4 * i + 1] = a.y + c4.y; rv[r][4 * i + 2] = a.z + c4.z; rv[r][4 * i + 3] = a.w + c4.w;
#pragma unroll
                        for (int k = 0; k < 4; ++k) ss[r] += rv[r][4 * i + k] * rv[r][4 * i + k];
                    }
                } else {
#pragma unroll
                    for (int i = 0; i < 4; ++i) {
                        const bf16x4 v = *(const bf16x4*)(tr + i * 256 + lane * 4);
#pragma unroll
                        for (int k = 0; k < 4; ++k) { rv[r][4 * i + k] = bf2f((bf16_t)v[k]); ss[r] += rv[r][4 * i + k] * rv[r][4 * i + k]; }
                    }
                }
            }
            ss[0] = wave_sum(ss[0]); ss[1] = wave_sum(ss[1]);
            const float* gpost = (mode == 1 ? p.g_post_mix : p.g_post_ffn) + l * DM;
#pragma unroll
            for (int r = 0; r < 2; ++r) {
                const float rstd = rsqrtf(ss[r] * (1.f / DM) + EPS);
                const float* gate = MOD + (size_t)(l * 17 + modrow[r]) * 6144 + (mode == 1 ? 2 : 5) * 1024;
#pragma unroll
                for (int i = 0; i < 4; ++i) {
                    const int c = i * 256 + lane * 4;
                    const float4 g4 = *(const float4*)(gpost + c);
                    const float4 t4 = *(const float4*)(gate + c);
                    xv[r][4 * i] += t4.x * (rv[r][4 * i] * rstd * g4.x);
                    xv[r][4 * i + 1] += t4.y * (rv[r][4 * i + 1] * rstd * g4.y);
                    xv[r][4 * i + 2] += t4.z * (rv[r][4 * i + 2] * rstd * g4.z);
                    xv[r][4 * i + 3] += t4.w * (rv[r][4 * i + 3] * rstd * g4.w);
                    float4 o; o.x = xv[r][4 * i]; o.y = xv[r][4 * i + 1]; o.z = xv[r][4 * i + 2]; o.w = xv[r][4 * i + 3];
                    if (ok[r]) *(float4*)(xout[r] + c) = o;
                }
            }
        }
        if (mode == 2 && l == DEPTH - 1) continue;
        float ss[2] = {0.f, 0.f};
#pragma unroll
        for (int r = 0; r < 2; ++r)
#pragma unroll
            for (int k = 0; k < 16; ++k) ss[r] += xv[r][k] * xv[r][k];
        ss[0] = wave_sum(ss[0]); ss[1] = wave_sum(ss[1]);
        const int ln = (mode == 2) ? l + 1 : l;
        const float* g = (mode == 1 ? p.g_pre_ffn : p.g_pre_mix) + ln * DM;
#pragma unroll
        for (int r = 0; r < 2; ++r) {
            const float rstd = rsqrtf(ss[r] * (1.f / DM) + EPS);
            const float* mrn = MOD + (size_t)(ln * 17 + modrow[r]) * 6144;
            const float* sh = mrn + (mode == 1 ? 3 : 0) * 1024;
            const float* sc = mrn + (mode == 1 ? 4 : 1) * 1024;
#pragma unroll
            for (int i = 0; i < 4; ++i) {
                const int c = i * 256 + lane * 4;
                const float4 g4 = *(const float4*)(g + c);
                const float4 s4 = *(const float4*)(sc + c);
                const float4 h4 = *(const float4*)(sh + c);
                const bf16x4 o = pack4(xv[r][4 * i] * rstd * g4.x * (1.f + s4.x) + h4.x, xv[r][4 * i + 1] * rstd * g4.y * (1.f + s4.y) + h4.y,
                                       xv[r][4 * i + 2] * rstd * g4.z * (1.f + s4.z) + h4.z, xv[r][4 * i + 3] * rstd * g4.w * (1.f + s4.w) + h4.w);
                if (ok[r]) *(bf16x4*)(Hdst + (size_t)tt[r] * DM + c) = o;
            }
        }
    }
}

struct EpiStore {
    static constexpr bool PERM = true, AFTER_DRAIN = false;
    bf16_t* O; int ldc; int split_cols; size_t split_stride;
    __device__ __forceinline__ void operator()(const f32x4 (&acc)[2][2][4][2], const pg8::Unit& u, int wr, int wc, int fr, int fq) const {
        const int row0 = u.pm * 256 + wr * 64 + fr; int colt = u.pn * 256; bf16_t* base = O;
        if (split_cols) { const int t = colt / split_cols; base += (size_t)t * split_stride; colt -= t * split_cols; }
        const int col0 = colt + wc * 32 + 8 * fq;
#pragma unroll
        for (int ai = 0; ai < 2; ++ai)
#pragma unroll
            for (int m = 0; m < 4; ++m) {
                bf16_t* rowp = base + (size_t)(row0 + ai * 128 + m * 16) * ldc + col0;
#pragma unroll
                for (int bj = 0; bj < 2; ++bj) {
                    const f32x4 v0 = acc[ai][bj][m][0], v1 = acc[ai][bj][m][1];
                    u32x4 w; w.x = cvt2(v0[0], v0[1]); w.y = cvt2(v0[2], v0[3]); w.z = cvt2(v1[0], v1[1]); w.w = cvt2(v1[2], v1[3]);
                    *(u32x4*)(rowp + bj * 128) = w;
                }
            }
    }
};
__device__ __forceinline__ float dpp_ror1(float v) { return __uint_as_float(__builtin_amdgcn_update_dpp(0u, __float_as_uint(v), 0x121, 0xF, 0xF, false)); }
__device__ __forceinline__ float dpp_ror15(float v) { return __uint_as_float(__builtin_amdgcn_update_dpp(0u, __float_as_uint(v), 0x12F, 0xF, 0xF, false)); }
__device__ __forceinline__ float dpp_prev(float edge, float v) { return __uint_as_float(__builtin_amdgcn_update_dpp(__float_as_uint(edge), __float_as_uint(v), 0x111, 0xF, 0xF, false)); }
__device__ __forceinline__ float dpp_next(float edge, float v) { return __uint_as_float(__builtin_amdgcn_update_dpp(__float_as_uint(edge), __float_as_uint(v), 0x101, 0xF, 0xF, false)); }
typedef float f32x2v __attribute__((ext_vector_type(2)));
struct EpiConv {
    static constexpr bool PERM = true, AFTER_DRAIN = false;
    bf16_t* ACT; bf16_t* GB; bf16_t* VB; const float* cw;
    __device__ __forceinline__ void operator()(const f32x4 (&acc)[2][2][4][2], const pg8::Unit& u, int wr, int wc, int fr, int fq) const {
        const int col0 = u.pn * 128 + wc * 32 + 8 * fq;
        f32x2v c0[4], c1[4], c2[4];
#pragma unroll
        for (int q = 0; q < 4; ++q) {
            c0[q] = *(const f32x2v*)(cw + col0 + 2 * q); c1[q] = *(const f32x2v*)(cw + DFF + col0 + 2 * q); c2[q] = *(const f32x2v*)(cw + 2 * DFF + col0 + 2 * q);
        }
#pragma unroll
        for (int ai = 0; ai < 2; ++ai) {
            const int row0 = u.pm * 256 + ai * 128 + wr * 64;
            const int strip = row0 >> 6;
            unsigned outp[4][4];
#pragma unroll
            for (int q = 0; q < 4; ++q) {
                const int n = q >> 1, j = (q & 1) * 2;
                f32x2v g[4], up[4], dn[4];
#pragma unroll
                for (int m = 0; m < 4; ++m) { g[m].x = acc[ai][0][m][n][j]; g[m].y = acc[ai][0][m][n][j + 1]; }
#pragma unroll
                for (int m = 0; m < 4; ++m) {
                    f32x2v eu = {0.f, 0.f}, ed = {0.f, 0.f};
                    if (m > 0) { eu.x = dpp_ror1(g[m > 0 ? m - 1 : 0].x); eu.y = dpp_ror1(g[m > 0 ? m - 1 : 0].y); }
                    if (m < 3) { ed.x = dpp_ror15(g[m < 3 ? m + 1 : 3].x); ed.y = dpp_ror15(g[m < 3 ? m + 1 : 3].y); }
                    up[m].x = dpp_prev(eu.x, g[m].x); up[m].y = dpp_prev(eu.y, g[m].y);
                    dn[m].x = dpp_next(ed.x, g[m].x); dn[m].y = dpp_next(ed.y, g[m].y);
                }
#pragma unroll
                for (int m = 0; m < 4; ++m) {
                    const f32x2v gg = c0[q] * up[m] + c1[q] * g[m] + c2[q] * dn[m];
                    const f32x2v t = (gg * gg) * 0.044715f + 1.0f;
                    const f32x2v uu = (gg * t) * (-1.5957691216f * 1.4426950408889634f);
                    f32x2v e; e.x = __builtin_amdgcn_exp2f(uu.x); e.y = __builtin_amdgcn_exp2f(uu.y);
                    const f32x2v dd = e + 1.0f;
                    f32x2v r; r.x = __builtin_amdgcn_rcpf(dd.x); r.y = __builtin_amdgcn_rcpf(dd.y);
                    f32x2v val; val.x = acc[ai][1][m][n][j]; val.y = acc[ai][1][m][n][j + 1];
                    const f32x2v o = (gg * r) * val;
                    outp[m][q] = cvt2(o.x, o.y);
                }
            }
#pragma unroll
            for (int m = 0; m < 4; ++m) {
                const int lr = m * 16 + fr;
                if (lr != 0 && lr != 63) {
                    u32x4 w4; w4.x = outp[m][0]; w4.y = outp[m][1]; w4.z = outp[m][2]; w4.w = outp[m][3];
                    *(u32x4*)(ACT + (size_t)(row0 + lr) * DFF + col0) = w4;
                }
                if (lr < 2 || lr >= 62) {
                    const int slot = lr < 2 ? lr : lr - 60;
                    *(bf16x8*)(GB + ((size_t)strip * 4 + slot) * DFF + col0) = pack8(acc[ai][0][m][0][0], acc[ai][0][m][0][1], acc[ai][0][m][0][2], acc[ai][0][m][0][3],
                                                                                     acc[ai][0][m][1][0], acc[ai][0][m][1][1], acc[ai][0][m][1][2], acc[ai][0][m][1][3]);
                    if (lr == 0 || lr == 63)
                        *(bf16x8*)(VB + ((size_t)strip * 2 + (lr ? 1 : 0)) * DFF + col0) = pack8(acc[ai][1][m][0][0], acc[ai][1][m][0][1], acc[ai][1][m][0][2], acc[ai][1][m][0][3],
                                                                                                 acc[ai][1][m][1][0], acc[ai][1][m][1][1], acc[ai][1][m][1][2], acc[ai][1][m][1][3]);
                }
            }
        }
    }
};
struct EpiPart {
    static constexpr bool PERM = true, AFTER_DRAIN = false;
    float* O;
    __device__ __forceinline__ void operator()(const f32x4 (&acc)[2][2][4][2], const pg8::Unit& u, int wr, int wc, int fr, int fq) const {
        const int row0 = (u.pm / 9) * 256 + wr * 64 + fr, col0 = u.pn * 256 + wc * 32 + 8 * fq;
#pragma unroll
        for (int ai = 0; ai < 2; ++ai)
#pragma unroll
            for (int m = 0; m < 4; ++m) {
                float* rowp = O + (size_t)(row0 + ai * 128 + m * 16) * DM + col0;
#pragma unroll
                for (int bj = 0; bj < 2; ++bj) { *(f32x4*)(rowp + bj * 128) = acc[ai][bj][m][0]; *(f32x4*)(rowp + bj * 128 + 4) = acc[ai][bj][m][1]; }
            }
    }
};
struct CtxOrder : pg8::StaticOrder {
    __device__ __forceinline__ bool next(int i, pg8::Unit& u) const {
        if (!pg8::StaticOrder::next(i, u)) return false;
        u.pm = u.pm * 9;
        return true;
    }
};
struct SkipOrder : pg8::StaticOrder {
    int skip;
    __device__ __forceinline__ bool next(int i, pg8::Unit& u) const {
        if (!pg8::StaticOrder::next(i, u)) return false;
        if (skip) u.pm = (u.pm >> 3) * 9 + 1 + (u.pm & 7);
        return true;
    }
};

__device__ __forceinline__ void phase_prep(const Params& p, unsigned char* smem) {
    const int tid = opaque_tid();
    const int lane = tid & 63, w = tid >> 6;
    unsigned char* big = p.ws + WS_BIG;
    bf16_t* P = (bf16_t*)(big + B_P);
    bf16_t* VTN = (bf16_t*)(big + B_VTN);
    bf16_t* VTS = (bf16_t*)(big + B_VTS);
    bf16_t* tl = (bf16_t*)smem;
    constexpr int N_ROPE = NBATCH * SEQ / NW, N_VT = NBATCH * 6 * (SL / 64);
    for (int task = opaque_bid(); task < N_ROPE + N_VT; task += gridDim.x) {
        if (task < N_ROPE) {
            const int tk = task * NW + w;
            const int b = tk / SEQ, pos = tk % SEQ;
            bf16_t* pr = P + (size_t)(b * SL + CL + pos) * PSTR;
            const int row = pos >> 6, col = pos & 63;
#pragma unroll
            for (int e0 = 0; e0 < 192; e0 += 64) {
                const int e = e0 + lane;
                const int head = e >> 5, pair = e & 31, half = pair >> 4, i = pair & 15;
                const int base = (head < 4) ? (OFF_SQ + head * 64) : (OFF_SK + (head - 4) * 64);
                const int i1 = base + half * 32 + i, i2 = i1 + 16;
                const float inv_freq = exp2f(-(float)i * (13.287712379549449f / 16.f));
                const float ang = (float)(half ? col : row) * inv_freq;
                float sn, cs; __sincosf(ang, &sn, &cs);
                const float t1 = bf2f(pr[i1]), t2 = bf2f(pr[i2]);
                pr[i1] = f2bf(t1 * cs - t2 * sn);
                pr[i2] = f2bf(t1 * sn + t2 * cs);
            }
        } else {
            const int r = task - N_ROPE;
            const int st = r % (SL / 64), slot = (r / (SL / 64)) % 6, b = r / (6 * (SL / 64));
            const int s0 = st * 64;
            const int col = (slot < 4) ? (OFF_NAV + slot * 64) : (OFF_SV + (slot - 4) * 64);
            {
                const int tt = tid >> 3, dc = (tid & 7) * 8;
                const bf16x8 v = *(const bf16x8*)(P + (size_t)(b * SL + s0 + tt) * PSTR + col + dc);
#pragma unroll
                for (int k = 0; k < 8; ++k) tl[(dc + k) * 72 + tt] = (bf16_t)v[k];
            }
            __syncthreads();
            {
                const int d = tid >> 3, tc = (tid & 7) * 8;
                const bf16x8 v = *(const bf16x8*)(tl + d * 72 + tc);
                bf16_t* dst = (slot < 4) ? (VTN + ((size_t)(b * 4 + slot) * 64 + d) * SL + s0 + tc) : (VTS + ((size_t)(b * 2 + slot - 4) * 64 + d) * SL + s0 + tc);
                *(bf16x8*)dst = v;
            }
            __syncthreads();
        }
    }
}

__device__ __forceinline__ float quad_max(float v) {
    unsigned x = __float_as_uint(v);
    auto r = __builtin_amdgcn_permlane16_swap(x, x, false, false);
    float a = fmaxf(__uint_as_float(r[0]), __uint_as_float(r[1]));
    x = __float_as_uint(a);
    auto r2 = __builtin_amdgcn_permlane32_swap(x, x, false, false);
    return fmaxf(__uint_as_float(r2[0]), __uint_as_float(r2[1]));
}
__device__ __forceinline__ float quad_sum(float v) {
    unsigned x = __float_as_uint(v);
    auto r = __builtin_amdgcn_permlane16_swap(x, x, false, false);
    float a = __uint_as_float(r[0]) + __uint_as_float(r[1]);
    x = __float_as_uint(a);
    auto r2 = __builtin_amdgcn_permlane32_swap(x, x, false, false);
    return __uint_as_float(r2[0]) + __uint_as_float(r2[1]);
}
struct KFrag { bf16x8 k[4]; };
struct VFrag { bf16x8 v[4]; };
__device__ __forceinline__ KFrag load_k(const char* kb_u, unsigned ko0, unsigned ko1) {
    KFrag f;
    f.k[0] = *(const bf16x8*)(kb_u + ko0); f.k[1] = *(const bf16x8*)(kb_u + ko0 + 64);
    f.k[2] = *(const bf16x8*)(kb_u + ko1); f.k[3] = *(const bf16x8*)(kb_u + ko1 + 64);
    return f;
}
__device__ __forceinline__ VFrag load_v(const char* vb_u, const unsigned (&vo)[4]) {
    VFrag f;
#pragma unroll
    for (int dt = 0; dt < 4; ++dt) f.v[dt] = *(const bf16x8*)(vb_u + vo[dt]);
    return f;
}
constexpr float LOG2E = 1.4426950408889634f;

template <bool CTXLDS>
__device__ __forceinline__ void attn_task(const Params& p, int l, int kind, int b, int a, int c, int h, int lane, const float* rpbl  ,
                                          const char* Kc, const char* Vc) {
    const int fr = lane & 15, fq = lane >> 4;
    unsigned char* big = p.ws + WS_BIG;
    const bf16_t* Pb = (const bf16_t*)(big + B_P) + (size_t)b * SL * PSTR;
    bf16_t* YM = (bf16_t*)(big + B_YM) + (size_t)b * SL * DM;
    const bool isna = (kind == 0 || kind == 2);
    const int kvh = isna ? h : (h >> 1);
    const char* Kbase = (const char*)(Pb + (isna ? OFF_NAK : OFF_SK) + kvh * 64);
    const char* Vbase = (const char*)(isna ? ((const bf16_t*)(big + B_VTN) + (size_t)(b * 4 + kvh) * 64 * SL)
                                           : ((const bf16_t*)(big + B_VTS) + (size_t)(b * 2 + kvh) * 64 * SL));
    const int krow = (fr >> 2) * 8 + (fr & 3);
    const unsigned ko0 = (unsigned)(krow * PSTR + fq * 8) * 2u, ko1 = ko0 + 4u * PSTR * 2u;
    unsigned vo[4];
#pragma unroll
    for (int dt = 0; dt < 4; ++dt) vo[dt] = (unsigned)((dt * 16 + fr) * SL + fq * 8) * 2u;
    int qtok[2];
    if (kind == 0) { qtok[0] = CL + (2 * a) * 64 + c * 16 + fr; qtok[1] = qtok[0] + 64; }
    else if (kind == 1) { qtok[0] = CL + a * 32 + fr; qtok[1] = qtok[0] + 16; }
    else { qtok[0] = a * 32 + fr; qtok[1] = qtok[0] + 16; }
    bf16x8 qB[2][2];
#pragma unroll
    for (int g = 0; g < 2; ++g) {
        const bf16_t* qp = Pb + (size_t)qtok[g] * PSTR + (isna ? OFF_NAQ : OFF_SQ) + h * 64 + fq * 8;
        qB[g][0] = *(const bf16x8*)qp;
        qB[g][1] = *(const bf16x8*)(qp + 32);
    }
    int nloc = 0, loc0 = 0, locstep = 32;
    int row0A = 0, rowoff = 0, q0 = 0;
    int dcv[8]; unsigned vmask = 0u;
#pragma unroll
    for (int e = 0; e < 8; ++e) dcv[e] = 0;
    if (kind == 0) {
        const int r0 = 2 * a;
        row0A = clampi(r0 - 4, 0, 24);
        const int row0B = clampi(r0 - 3, 0, 24);
        rowoff = row0B - row0A;
        const int col0 = clampi(16 * c - 8, 0, 32), qcol = 16 * c + fr, wst = clampi(qcol - 8, 0, 48);
        nloc = 8 + rowoff; loc0 = CL + row0A * 64 + col0; locstep = 64;
#pragma unroll
        for (int e = 0; e < 8; ++e) {
            const int kcol = col0 + fq * 8 + e;
            if ((kcol >= wst) && (kcol < wst + 16)) vmask |= (1u << e);
            dcv[e] = clampi(kcol - qcol, -15, 15) + 15;
        }
    } else if (kind == 1) {
        q0 = a * 32;
        const int lo = q0 - 128;
        const int first = lo < 0 ? 0 : lo, last = (lo + 288) > SEQ ? SEQ : (lo + 288);
        nloc = (last - first) >> 5; loc0 = CL + first; locstep = 32;
    }
    const int nblk = 8 + nloc;
    auto s0_of = [&](int i) { const int ii = i < nblk ? i : nblk - 1; return ii < 8 ? ii * 32 : loc0 + (ii - 8) * locstep; };
    f32x4 o[2][4];
    float m[2], lsum[2];
#pragma unroll
    for (int g = 0; g < 2; ++g) {
        m[g] = NEG; lsum[g] = 0.f;
#pragma unroll
        for (int dt = 0; dt < 4; ++dt) o[g][dt] = (f32x4){0.f, 0.f, 0.f, 0.f};
    }
    constexpr float C1 = 0.125f * LOG2E;
    auto compute = [&](const KFrag& kc, const VFrag& vc, int i, int s0) {
#pragma unroll
        for (int g = 0; g < 2; ++g) {
            bool act = true;
            float badd[8];
#pragma unroll
            for (int e = 0; e < 8; ++e) badd[e] = 0.f;
            if (i >= 8) {
                if (kind == 0) {
                    const int j = i - 8;
                    act = (g == 0) ? (j < 8) : (j >= rowoff);
                    if (act) {
                        const float* bias = rpbl + (row0A + j - (2 * a + g) + 7) * 31;
#pragma unroll
                        for (int e = 0; e < 8; ++e) badd[e] = ((vmask >> e) & 1u) ? bias[dcv[e]] : NEG;
                    }
                } else {
                    const int kp0 = s0 - CL, qlo = q0 + 16 * g;
                    const bool full = (kp0 >= qlo + 15 - 128) && (kp0 + 31 <= qlo + 128);
                    if (!full) {
#pragma unroll
                        for (int e = 0; e < 8; ++e) {
                            const int d = qlo + fr - (kp0 + fq * 8 + e);
                            badd[e] = (d <= 128 && d >= -128) ? 0.f : NEG;
                        }
                    }
                }
            }
            if (act) {
                f32x4 s[2];
                s[0] = MFMA16(kc.k[0], qB[g][0], ((f32x4){0.f, 0.f, 0.f, 0.f}));
                s[0] = MFMA16(kc.k[1], qB[g][1], s[0]);
                s[1] = MFMA16(kc.k[2], qB[g][0], ((f32x4){0.f, 0.f, 0.f, 0.f}));
                s[1] = MFMA16(kc.k[3], qB[g][1], s[1]);
                float t[8];
                float bm = NEG;
#pragma unroll
                for (int e = 0; e < 8; ++e) { t[e] = fmaf(s[e >> 2][e & 3], C1, badd[e]); bm = fmaxf(bm, t[e]); }
                bm = quad_max(bm);
                if (__any(bm > m[g] + 8.f)) {
                    const float mn = fmaxf(m[g], bm);
                    const float alpha = __builtin_amdgcn_exp2f(m[g] - mn);
                    m[g] = mn;
                    lsum[g] *= alpha;
#pragma unroll
                    for (int dt = 0; dt < 4; ++dt) o[g][dt] *= alpha;
                }
                float pv[8]; float ps = 0.f;
#pragma unroll
                for (int e = 0; e < 8; ++e) { pv[e] = __builtin_amdgcn_exp2f(t[e] - m[g]); ps += pv[e]; }
                lsum[g] += ps;
                const bf16x8 pB = pack8(pv[0], pv[1], pv[2], pv[3], pv[4], pv[5], pv[6], pv[7]);
#pragma unroll
                for (int dt = 0; dt < 4; ++dt) o[g][dt] = MFMA16(vc.v[dt], pB, o[g][dt]);
            }
        }
    };
    if (CTXLDS) {
        KFrag gk0 = load_k(Kbase + (size_t)s0_of(8) * (PSTR * 2), ko0, ko1);
        VFrag gv0 = load_v(Vbase + (size_t)s0_of(8) * 2, vo);
        KFrag gk1 = load_k(Kbase + (size_t)s0_of(9) * (PSTR * 2), ko0, ko1);
        const char* kl = Kc + (krow * 144 + fq * 16);
        auto lds_k = [&](int s0) { KFrag f; const char* q = kl + s0 * 144;
            f.k[0] = *(const bf16x8*)q; f.k[1] = *(const bf16x8*)(q + 64); f.k[2] = *(const bf16x8*)(q + 4 * 144); f.k[3] = *(const bf16x8*)(q + 4 * 144 + 64); return f; };
        auto lds_v = [&](int s0) { VFrag f;
#pragma unroll
            for (int dt = 0; dt < 4; ++dt) f.v[dt] = *(const bf16x8*)(Vc + (dt * 16 + fr) * 528 + (s0 + fq * 8) * 2);
            return f; };
        KFrag kc = lds_k(0); VFrag vc = lds_v(0);
        for (int i = 0; i < 8; ++i) {
            const int sn = (i < 7 ? i + 1 : 7) * 32;
            const KFrag kn = lds_k(sn); const VFrag vn = lds_v(sn);
            compute(kc, vc, i, i * 32);
            kc = kn; vc = vn;
        }
        kc = gk0; vc = gv0;
        KFrag kn = gk1;
        for (int i = 8; i < nblk; ++i) {
            const KFrag kn2 = load_k(Kbase + (size_t)s0_of(i + 2) * (PSTR * 2), ko0, ko1);
            const VFrag vn = load_v(Vbase + (size_t)s0_of(i + 1) * 2, vo);
            compute(kc, vc, i, s0_of(i));
            kc = kn; kn = kn2; vc = vn;
        }
    } else {
        KFrag kc = load_k(Kbase + (size_t)s0_of(0) * (PSTR * 2), ko0, ko1);
        KFrag kn = load_k(Kbase + (size_t)s0_of(1) * (PSTR * 2), ko0, ko1);
        VFrag vc = load_v(Vbase + (size_t)s0_of(0) * 2, vo);
        for (int i = 0; i < nblk; ++i) {
            const KFrag kn2 = load_k(Kbase + (size_t)s0_of(i + 2) * (PSTR * 2), ko0, ko1);
            const VFrag vn = load_v(Vbase + (size_t)s0_of(i + 1) * 2, vo);
            compute(kc, vc, i, s0_of(i));
            kc = kn; kn = kn2; vc = vn;
        }
    }
#pragma unroll
    for (int g = 0; g < 2; ++g) {
        float lt = quad_sum(lsum[g]);
        if (!isna) lt += __builtin_amdgcn_exp2f(p.swa_sink[l * 4 + h] * LOG2E - m[g]);
        const float inv = 1.f / lt;
        bf16_t* dst = YM + (size_t)qtok[g] * DM + (isna ? 256 : 768) + h * 64;
#pragma unroll
        for (int dt = 0; dt < 4; ++dt)
            *(bf16x4*)(dst + dt * 16 + fq * 4) = pack4(o[g][dt][0] * inv, o[g][dt][1] * inv, o[g][dt][2] * inv, o[g][dt][3] * inv);
    }
}

__device__ __forceinline__ void s5_task(const Params& p, int l, int b, int g, int dir, int lane, float* bu  , bf16_t* hb  ) {
    const int fr = lane & 15, fq = lane >> 4;
    unsigned char* big = p.ws + WS_BIG;
    const bf16_t* Pb = (const bf16_t*)(big + B_P) + (size_t)b * SL * PSTR + OFF_A + g * 16;
    bf16_t* YS = (bf16_t*)(big + B_YS) + ((size_t)dir * NT + (size_t)b * SL) * 256 + g * 16;
    const int base = (l * 2 + dir) * 16 + g;
    const float step = expf(p.s5_log_step[base]);
    float lbr, lbi;
    {
        const float lre = p.s5_lam_re[base * 64 + lane], lim = p.s5_lam_im[base * 64 + lane];
        const float er = expf(lre * step);
        float sn, cs; sincosf(lim * step, &sn, &cs);
        lbr = er * cs; lbi = er * sn;
        const float nr = lbr - 1.f, ni = lbi;
        const float den = 1.f / (lre * lre + lim * lim);
        bu[2 * lane] = (nr * lre + ni * lim) * den;
        bu[2 * lane + 1] = (ni * lre - nr * lim) * den;
    }
    WAVE_LDS_SYNC();
    bf16x8 Bop[8];
#pragma unroll
    for (int nt = 0; nt < 8; ++nt) {
        const int pp = nt * 8 + (fr >> 1), part = fr & 1;
        const float cr = bu[2 * pp], ci = bu[2 * pp + 1];
        float v[8];
#pragma unroll
        for (int jj = 0; jj < 8; ++jj) {
            float br = 0.f, bi = 0.f;
            if (fq < 2) {
                const size_t idx = ((size_t)base * 64 + pp) * 16 + fq * 8 + jj;
                br = p.s5_b_re[idx]; bi = p.s5_b_im[idx];
            }
            v[jj] = part ? (cr * bi + ci * br) : (cr * br - ci * bi);
        }
        Bop[nt] = pack8(v[0], v[1], v[2], v[3], v[4], v[5], v[6], v[7]);
        if (nt & 1) asm volatile("" ::: "memory");
    }
    WAVE_LDS_SYNC();
    bf16x8 Cop[4];
#pragma unroll
    for (int ks = 0; ks < 4; ++ks) {
        float v[8];
#pragma unroll
        for (int jj = 0; jj < 8; ++jj) {
            const int k = ks * 32 + fq * 8 + jj;
            const size_t idx = ((size_t)base * 16 + fr) * 64 + (k >> 1);
            v[jj] = (k & 1) ? -p.s5_c_im[idx] : p.s5_c_re[idx];
        }
        Cop[ks] = pack8(v[0], v[1], v[2], v[3], v[4], v[5], v[6], v[7]);
        asm volatile("" ::: "memory");
    }
    const bf16x8 zero8 = (bf16x8){0, 0, 0, 0, 0, 0, 0, 0};
    float hr = 0.f, hi = 0.f;
    bf16x8 uN = zero8, uN2 = zero8;
    if (fq < 2) {
        uN = *(const bf16x8*)(Pb + (size_t)s_of(dir, fr) * PSTR + fq * 8);
        uN2 = *(const bf16x8*)(Pb + (size_t)s_of(dir, 16 + fr) * PSTR + fq * 8);
    }
    for (int blk = 0; blk < SL / 16; ++blk) {
        const int i0 = blk * 16;
        const bf16x8 uA = uN;
        uN = uN2;
        if (blk + 2 < SL / 16 && fq < 2) uN2 = *(const bf16x8*)(Pb + (size_t)s_of(dir, i0 + 32 + fr) * PSTR + fq * 8);
#pragma unroll
        for (int nt = 0; nt < 8; ++nt) {
            const f32x4 acc = MFMA16(uA, Bop[nt], ((f32x4){0.f, 0.f, 0.f, 0.f}));
#pragma unroll
            for (int j = 0; j < 4; ++j) bu[(fq * 4 + j) * 132 + nt * 16 + fr] = acc[j];
        }
        WAVE_LDS_SYNC();
#pragma unroll
        for (int t = 0; t < 16; ++t) {
            const float2 v = *(const float2*)(bu + t * 132 + 2 * lane);
            const float nr = lbr * hr - lbi * hi + v.x;
            const float ni = lbr * hi + lbi * hr + v.y;
            hr = nr; hi = ni;
            *(unsigned*)(hb + t * 136 + 2 * lane) = cvt2(hr, hi);
        }
        WAVE_LDS_SYNC();
        f32x4 y = (f32x4){0.f, 0.f, 0.f, 0.f};
#pragma unroll
        for (int ks = 0; ks < 4; ++ks) {
            const bf16x8 hA = *(const bf16x8*)(hb + fr * 136 + ks * 32 + fq * 8);
            y = MFMA16(hA, Cop[ks], y);
        }
#pragma unroll
        for (int j = 0; j < 4; ++j) YS[(size_t)s_of(dir, i0 + fq * 4 + j) * 256 + fr] = f2bf(y[j]);
        WAVE_LDS_SYNC();
    }
}

__device__ __forceinline__ void gla_task(const Params& p, int l, int b, int h, int dir, unsigned char* smem) {
    constexpr int LS = 72;
    bf16_t* Qd = (bf16_t*)smem;
    bf16_t* Kd = Qd + 64 * LS;
    bf16_t* KeT = Kd + 64 * LS;
    bf16_t* Vt = KeT + 64 * LS;
    bf16_t* Am = Vt + 64 * LS;
    bf16_t* St = Am + 64 * LS;
    float* segsum = (float*)(St + 64 * LS);
    float* decay = segsum + 512;
    unsigned* gfl = (unsigned*)(decay + 64);
    const int tid = opaque_tid(), lane = tid & 63, w = tid >> 6, fr = lane & 15, fq = lane >> 4;
    const int d = lane, iq = w, it = w >> 1, hb2 = (w & 1) * 2;
    unsigned char* big = p.ws + WS_BIG;
    const bf16_t* Pb = (const bf16_t*)(big + B_P) + (size_t)b * SL * PSTR;
    bf16_t* OG = (bf16_t*)(big + B_OG) + ((size_t)dir * NT + (size_t)b * SL) * 256 + h * 64;
    for (int i = tid; i < 64 * LS; i += NTH) St[i] = 0;
    f32x4 Sacc[2];
    Sacc[0] = (f32x4){0.f, 0.f, 0.f, 0.f}; Sacc[1] = (f32x4){0.f, 0.f, 0.f, 0.f};
    float wg[16];
    {
        const float* Wg = p.gla_w_gate2 + (size_t)((l * 2 + dir) * 16) * 256 + h * 64 + d;
#pragma unroll
        for (int r = 0; r < 16; ++r) wg[r] = Wg[r * 256];
    }
    const float bgv = p.gla_b_gate[(l * 2 + dir) * 256 + h * 64 + d];
    const int gcol = dir == 0 ? OFF_GF : OFF_GB;
    unsigned gfn = *(const unsigned*)(Pb + (size_t)s_of(dir, tid >> 3) * PSTR + gcol + 2 * (tid & 7));
    bf16_t qn[8], kn[8], vn[8];
#pragma unroll
    for (int ii = 0; ii < 8; ++ii) {
        const bf16_t* pr = Pb + (size_t)s_of(dir, iq * 8 + ii) * PSTR + h * 64 + d;
        qn[ii] = pr[OFF_GQ]; kn[ii] = pr[OFF_GK]; vn[ii] = pr[OFF_GV];
    }
    gfl[tid] = gfn;
    __syncthreads();
    for (int n = 0; n < SL / 64; ++n) {
        bf16_t qc[8], kc[8], vc[8];
#pragma unroll
        for (int ii = 0; ii < 8; ++ii) { qc[ii] = qn[ii]; kc[ii] = kn[ii]; vc[ii] = vn[ii]; }
        if (n + 1 < SL / 64) {
            gfn = *(const unsigned*)(Pb + (size_t)s_of(dir, (n + 1) * 64 + (tid >> 3)) * PSTR + gcol + 2 * (tid & 7));
#pragma unroll
            for (int ii = 0; ii < 8; ++ii) {
                const bf16_t* pr = Pb + (size_t)s_of(dir, (n + 1) * 64 + iq * 8 + ii) * PSTR + h * 64 + d;
                qn[ii] = pr[OFF_GQ]; kn[ii] = pr[OFF_GK]; vn[ii] = pr[OFF_GV];
            }
        }
        const unsigned* gcur = gfl + (n & 1) * 512;
        float bcum[8];
        float run = 0.f;
#pragma unroll
        for (int ii = 0; ii < 8; ++ii) {
            const bf16x8 g0 = *(const bf16x8*)(gcur + (iq * 8 + ii) * 8);
            const bf16x8 g1 = *(const bf16x8*)(gcur + (iq * 8 + ii) * 8 + 4);
            float z = bgv;
#pragma unroll
            for (int r = 0; r < 8; ++r) z += bf2f((bf16_t)g0[r]) * wg[r];
#pragma unroll
            for (int r = 0; r < 8; ++r) z += bf2f((bf16_t)g1[r]) * wg[8 + r];
            const float ls = fminf(z, 0.f) - __logf(1.f + __expf(-fabsf(z)));
            run += ls * (1.f / 16.f);
            bcum[ii] = run;
        }
        segsum[iq * 64 + d] = run;
        __syncthreads();
        float pre = 0.f, tot = 0.f;
#pragma unroll
        for (int q = 0; q < 8; ++q) {
            const float v = segsum[q * 64 + d];
            tot += v;
            if (q < iq) pre += v;
        }
        float kev[8];
#pragma unroll
        for (int ii = 0; ii < 8; ++ii) {
            const int il = iq * 8 + ii;
            const float bb = pre + bcum[ii];
            const float q = bf2f(qc[ii]), k = bf2f(kc[ii]);
            Qd[il * LS + d] = f2bf(q * 0.125f * __expf(bb));
            Kd[il * LS + d] = f2bf(k * __expf(-bb));
            kev[ii] = k * __expf(tot - bb);
        }
        *(bf16x8*)(KeT + d * LS + iq * 8) = pack8(kev[0], kev[1], kev[2], kev[3], kev[4], kev[5], kev[6], kev[7]);
        {
            bf16x8 vv;
#pragma unroll
            for (int ii = 0; ii < 8; ++ii) vv[ii] = (short)vc[ii];
            *(bf16x8*)(Vt + d * LS + iq * 8) = vv;
        }
        if (iq == 0) decay[d] = __expf(tot);
        __syncthreads();
        bf16x8 qf[2];
        qf[0] = *(const bf16x8*)(Qd + (16 * it + fr) * LS + fq * 8);
        qf[1] = *(const bf16x8*)(Qd + (16 * it + fr) * LS + 32 + fq * 8);
#pragma unroll
        for (int j2 = 0; j2 < 2; ++j2) {
            const int jt = hb2 + j2;
            f32x4 acc = (f32x4){0.f, 0.f, 0.f, 0.f};
#pragma unroll
            for (int ks = 0; ks < 2; ++ks) {
                const bf16x8 kf = *(const bf16x8*)(Kd + (jt * 16 + fr) * LS + ks * 32 + fq * 8);
                acc = MFMA16(kf, qf[ks], acc);
            }
            const int il = 16 * it + fr, j0 = jt * 16 + fq * 4;
            *(bf16x4*)(Am + il * LS + j0) = pack4(il >= j0 ? acc[0] : 0.f, il >= j0 + 1 ? acc[1] : 0.f, il >= j0 + 2 ? acc[2] : 0.f, il >= j0 + 3 ? acc[3] : 0.f);
        }
        __syncthreads();
        bf16x8 af[2];
        af[0] = *(const bf16x8*)(Am + (16 * it + fr) * LS + fq * 8);
        af[1] = *(const bf16x8*)(Am + (16 * it + fr) * LS + 32 + fq * 8);
        {
            const int s = s_of(dir, n * 64 + 16 * it + fr);
            bf16_t* orow = OG + (size_t)s * 256;
#pragma unroll
            for (int d2 = 0; d2 < 2; ++d2) {
                const int dvt = hb2 + d2;
                f32x4 acc = (f32x4){0.f, 0.f, 0.f, 0.f};
#pragma unroll
                for (int ks = 0; ks < 2; ++ks) {
                    const bf16x8 vf = *(const bf16x8*)(Vt + (dvt * 16 + fr) * LS + ks * 32 + fq * 8);
                    acc = MFMA16(vf, af[ks], acc);
                    const bf16x8 sf = *(const bf16x8*)(St + (dvt * 16 + fr) * LS + ks * 32 + fq * 8);
                    acc = MFMA16(sf, qf[ks], acc);
                }
                *(bf16x4*)(orow + dvt * 16 + fq * 4) = pack4(acc[0], acc[1], acc[2], acc[3]);
            }
        }
        gfl[((n + 1) & 1) * 512 + tid] = gfn;
        __syncthreads();
        bf16x8 vb[2];
        vb[0] = *(const bf16x8*)(Vt + (16 * it + fr) * LS + fq * 8);
        vb[1] = *(const bf16x8*)(Vt + (16 * it + fr) * LS + 32 + fq * 8);
#pragma unroll
        for (int k2 = 0; k2 < 2; ++k2) {
            const int dkt = hb2 + k2;
            const f32x4 dec = *(const f32x4*)(decay + dkt * 16 + fq * 4);
            Sacc[k2] *= dec;
#pragma unroll
            for (int ks = 0; ks < 2; ++ks) {
                const bf16x8 kf = *(const bf16x8*)(KeT + (dkt * 16 + fr) * LS + ks * 32 + fq * 8);
                Sacc[k2] = MFMA16(kf, vb[ks], Sacc[k2]);
            }
            *(bf16x4*)(St + (16 * it + fr) * LS + dkt * 16 + fq * 4) = pack4(Sacc[k2][0], Sacc[k2][1], Sacc[k2][2], Sacc[k2][3]);
        }
    }
    __syncthreads();
}

__device__ __forceinline__ int next_task(unsigned* cnt, volatile int* s_task) {
    __syncthreads();
    if (opaque_tid() == 0) *s_task = (int)atomicAdd(cnt, 1u);
    __syncthreads();
    return *s_task;
}
__device__ __forceinline__ int wave_next(unsigned* cnt, int lane) {
    int t = 0;
    if (lane == 0) t = (int)atomicAdd(cnt, 1u);
    return __builtin_amdgcn_readfirstlane(t);
}
__device__ __forceinline__ bool combo_task(int combo, int wt, bool ctx_out, int xq, int& kind, int& b, int& a, int& c, int& h) {
    c = 0;
    if (combo < 8) {
        const int n = ctx_out ? 72 : 64;
        if (wt >= n) return false;
        b = 2 * xq + (combo >> 2); h = combo & 3;
        if (wt < 64) { kind = 0; c = wt & 3; a = wt >> 2; } else { kind = 2; a = wt - 64; }
    } else {
        const int n = ctx_out ? 144 : 128;
        if (wt >= n) return false;
        const int cc = combo - 8;
        b = 2 * xq + (cc >> 1);
        if (wt < 128) { kind = 1; h = (cc & 1) * 2 + (wt & 1); a = wt >> 1; } else { const int r = wt - 128; kind = 3; h = (cc & 1) * 2 + (r & 1); a = r >> 1; }
    }
    return true;
}
__device__ __forceinline__ void phase_mix(const Params& p, int lc, int l, unsigned char* smem) {
    volatile int* s_task = (volatile int*)(smem + LDS_MAIN + 64);
    const int tid = opaque_tid(), lane = tid & 63;
    const int w = __builtin_amdgcn_readfirstlane(tid >> 6);
    const bool ctx_out = l < DEPTH - 1;
    const int x0 = (int)(xb_xcc_id() & 7u);
    unsigned* cbase = (unsigned*)(p.ws + WS_CNT) + lc * 128;
    for (int k = 0; k < 8; ++k) {
        const int xq = (x0 + k) & 7;
        unsigned* cnt = cbase + xq * 16;
        while (true) {
            const int task = __builtin_amdgcn_readfirstlane(next_task(cnt + 0, s_task));
            if (task >= 16) break;
            gla_task(p, l, 2 * xq + (task >> 3), (task >> 1) & 3, task & 1, smem);
        }
    }
    const int slot = __builtin_amdgcn_readfirstlane(next_task(cbase + x0 * 16 + 3, s_task));
    const int mycombo = (slot & 1) ? (8 + ((slot >> 1) & 3)) : ((slot >> 1) & 7);
    {
        const int cb = 2 * x0 + (mycombo < 8 ? (mycombo >> 2) : ((mycombo - 8) >> 1));
        const bool na = mycombo < 8;
        const int hh = na ? (mycombo & 3) : ((mycombo - 8) & 1);
        unsigned char* big = p.ws + WS_BIG;
        const bf16_t* Pb = (const bf16_t*)(big + B_P) + (size_t)cb * SL * PSTR + (na ? OFF_NAK : OFF_SK) + hh * 64;
        const bf16_t* Vb = na ? ((const bf16_t*)(big + B_VTN) + (size_t)(cb * 4 + hh) * 64 * SL) : ((const bf16_t*)(big + B_VTS) + (size_t)(cb * 2 + hh) * 64 * SL);
        {
            const int row = tid >> 1, half = tid & 1;
            const bf16_t* src = Pb + (size_t)row * PSTR + half * 32;
            unsigned char* dst = smem + LDS_KC + row * 144 + half * 64;
#pragma unroll
            for (int q = 0; q < 4; ++q) *(bf16x8*)(dst + q * 16) = *(const bf16x8*)(src + q * 8);
        }
        {
            const int d = tid >> 3, part = tid & 7;
            const bf16_t* src = Vb + (size_t)d * SL + part * 32;
            unsigned char* dst = smem + LDS_VC + d * 528 + part * 64;
#pragma unroll
            for (int q = 0; q < 4; ++q) *(bf16x8*)(dst + q * 16) = *(const bf16x8*)(src + q * 8);
        }
        __syncthreads();
    }
    if (w < 4) {
        int lane_s = lane; asm volatile("" : "+v"(lane_s));
        float* bu = (float*)(smem + w * 12800);
        bf16_t* hb = (bf16_t*)(smem + w * 12800 + 8448);
        for (int k = 0; k < 8; ++k) {
            const int xq = (x0 + k) & 7;
            unsigned* cnt = cbase + xq * 16;
            while (true) {
                const int wt = wave_next(cnt + 1, lane_s);
                if (wt >= 64) break;
                s5_task(p, l, 2 * xq + (wt >> 5), (wt >> 1) & 15, wt & 1, lane_s, bu, hb);
            }
        }
    }
    int lane_a = lane; asm volatile("" : "+v"(lane_a));
    float* rpbl = (float*)(smem + LDS_RPB + w * 2048);
    const char* Kc = (const char*)(smem + LDS_KC);
    const char* Vc = (const char*)(smem + LDS_VC);
    int staged_h = -1;
    auto run_combo = [&](int xq, int combo, bool cached) {
        unsigned* cnt = cbase + xq * 16;
        while (true) {
            const int wt = wave_next(cnt + 4 + combo, lane_a);
            int kind, b, a, c, h;
            if (!combo_task(combo, wt, ctx_out, xq, kind, b, a, c, h)) break;
            if (kind == 0 && staged_h != h) {
                WAVE_LDS_SYNC();
                for (int i = lane_a; i < 15 * 31; i += 64) rpbl[i] = p.na_rpb[(size_t)(l * 4 + h) * 465 + i] * LOG2E;
                WAVE_LDS_SYNC();
                staged_h = h;
            }
            if (cached) attn_task<true>(p, l, kind, b, a, c, h, lane_a, rpbl, Kc, Vc);
            else attn_task<false>(p, l, kind, b, a, c, h, lane_a, rpbl, Kc, Vc);
        }
    };
    run_combo(x0, mycombo, true);
    const int n_na = ctx_out ? 72 : 64, n_swa = ctx_out ? 144 : 128;
    for (int k = 0; k < 8; ++k) {
        const int xq = (x0 + k) & 7;
        for (int pass = 0; pass < 2; ++pass) {
            unsigned v = 0xffffffffu;
            if (lane_a < 12) v = __hip_atomic_load(cbase + xq * 16 + 4 + lane_a, __ATOMIC_RELAXED, __HIP_MEMORY_SCOPE_AGENT);
            const bool avail = (lane_a < 12) && ((int)v < (lane_a < 8 ? n_na : n_swa));
            unsigned long long mask = __ballot(avail);
            if (mask == 0ull) break;
            while (mask) {
                const int combo = __builtin_ctzll(mask);
                mask &= mask - 1ull;
                run_combo(xq, combo, false);
            }
        }
    }
}

__device__ __forceinline__ void phase_fin(const Params& p, int l, unsigned char* smem) {
    const int tid = opaque_tid(), lane = tid & 63, w = tid >> 6, fr = lane & 15, fq = lane >> 4;
    const bool ctx_out = l < DEPTH - 1;
    unsigned char* big = p.ws + WS_BIG;
    const bf16_t* P = (const bf16_t*)(big + B_P);
    bf16_t* YM = (bf16_t*)(big + B_YM);
    const bf16_t* YS = (const bf16_t*)(big + B_YS);
    const bf16_t* OG = (const bf16_t*)(big + B_OG);
    const bf16_t* WG = (const bf16_t*)(p.ws + WS_WGLU) + (size_t)l * 256 * 256;
    constexpr int TB = 144, ZS = 264;
    bf16_t* zb = (bf16_t*)smem;
    for (int bt = opaque_bid(); bt < NT / TB; bt += gridDim.x) {
        const size_t tok0 = (size_t)bt * TB;
        bf16x8 wA[2][8];
#pragma unroll
        for (int t = 0; t < 2; ++t)
#pragma unroll
            for (int ks = 0; ks < 8; ++ks) wA[t][ks] = *(const bf16x8*)(WG + (size_t)(w * 32 + t * 16 + fr) * 256 + ks * 32 + fq * 8);
        for (int idx = tid; idx < TB * 32; idx += NTH) {
            const int tt = idx >> 5, c = (idx & 31) * 8;
            const size_t tok = tok0 + tt;
            const bf16x8 u = *(const bf16x8*)(P + tok * PSTR + OFF_A + c);
            const bf16x8 yf = *(const bf16x8*)(YS + tok * 256 + c);
            const bf16x8 yr = *(const bf16x8*)(YS + ((size_t)NT + tok) * 256 + c);
            const float4 d0 = *(const float4*)(p.s5_d + l * 256 + c);
            const float4 d1 = *(const float4*)(p.s5_d + l * 256 + c + 4);
            const float dd[8] = {d0.x, d0.y, d0.z, d0.w, d1.x, d1.y, d1.z, d1.w};
            float z[8];
#pragma unroll
            for (int k = 0; k < 8; ++k) z[k] = gelu_tanh(dd[k] * bf2f((bf16_t)u[k]) + bf2f((bf16_t)yf[k]) + bf2f((bf16_t)yr[k]));
            *(bf16x8*)(zb + tt * ZS + c) = pack8(z[0], z[1], z[2], z[3], z[4], z[5], z[6], z[7]);
        }
        __syncthreads();
        for (int tg = 0; tg < TB / 16; ++tg) {
            bf16x8 zB[8];
#pragma unroll
            for (int ks = 0; ks < 8; ++ks) zB[ks] = *(const bf16x8*)(zb + (tg * 16 + fr) * ZS + ks * 32 + fq * 8);
            bf16_t* orow = YM + (tok0 + tg * 16 + fr) * DM;
#pragma unroll
            for (int t = 0; t < 2; ++t) {
                f32x4 acc = (f32x4){0.f, 0.f, 0.f, 0.f};
#pragma unroll
                for (int ks = 0; ks < 8; ++ks) acc = MFMA16(wA[t][ks], zB[ks], acc);
                const int n0 = w * 32 + t * 16 + fq * 4;
                const bf16x4 z4 = *(const bf16x4*)(zb + (tg * 16 + fr) * ZS + n0);
                *(bf16x4*)(orow + n0) = pack4(bf2f((bf16_t)z4[0]) * sigmoidf_(acc[0]), bf2f((bf16_t)z4[1]) * sigmoidf_(acc[1]),
                                              bf2f((bf16_t)z4[2]) * sigmoidf_(acc[2]), bf2f((bf16_t)z4[3]) * sigmoidf_(acc[3]));
            }
        }
        __syncthreads();
    }
    {
        const int gw = opaque_bid() * NW + w, nw = gridDim.x * NW;
        const int tk = lane >> 4, c = (lane & 15) * 16;
        const float4 g0 = *(const float4*)(p.gla_g_norm + l * 64 + (c & 63));
        const float4 g1 = *(const float4*)(p.gla_g_norm + l * 64 + (c & 63) + 4);
        const float4 g2 = *(const float4*)(p.gla_g_norm + l * 64 + (c & 63) + 8);
        const float4 g3 = *(const float4*)(p.gla_g_norm + l * 64 + (c & 63) + 12);
        const float gn[16] = {g0.x, g0.y, g0.z, g0.w, g1.x, g1.y, g1.z, g1.w, g2.x, g2.y, g2.z, g2.w, g3.x, g3.y, g3.z, g3.w};
        for (int t4 = gw; t4 < NT / 4; t4 += nw) {
            const size_t tok = (size_t)t4 * 4 + tk;
            if (!ctx_out && (int)(tok % SL) < CL) continue;
            float o[16]; float ss = 0.f;
#pragma unroll
            for (int hlf = 0; hlf < 2; ++hlf) {
                const bf16x8 a = *(const bf16x8*)(OG + tok * 256 + c + hlf * 8);
                const bf16x8 bq = *(const bf16x8*)(OG + ((size_t)NT + tok) * 256 + c + hlf * 8);
#pragma unroll
                for (int k = 0; k < 8; ++k) { o[hlf * 8 + k] = bf2f((bf16_t)a[k]) + bf2f((bf16_t)bq[k]); ss += o[hlf * 8 + k] * o[hlf * 8 + k]; }
            }
            ss = DPP_ADD(ss, 0xB1); ss = DPP_ADD(ss, 0x4E);
            const float rstd = rsqrtf(ss * (1.f / 64.f) + EPS);
#pragma unroll
            for (int hlf = 0; hlf < 2; ++hlf) {
                const bf16x8 rr = *(const bf16x8*)(P + tok * PSTR + OFF_GR + c + hlf * 8);
                float v[8];
#pragma unroll
                for (int k = 0; k < 8; ++k) v[k] = o[hlf * 8 + k] * rstd * gn[hlf * 8 + k] * siluf_(bf2f((bf16_t)rr[k]));
                *(bf16x8*)(YM + tok * DM + 512 + c + hlf * 8) = pack8(v[0], v[1], v[2], v[3], v[4], v[5], v[6], v[7]);
            }
        }
    }
}

__device__ __forceinline__ void phase_fixup(const Params& p, int l) {
    unsigned char* big = p.ws + WS_BIG;
    bf16_t* ACT = (bf16_t*)(big + B_ACT);
    const bf16_t* GB = (const bf16_t*)(big + B_GB);
    const bf16_t* VB = (const bf16_t*)(big + B_VB);
    const float* cw = p.ffn_conv + (size_t)l * 3 * DFF;
    constexpr int NG = DFF / 8, NS = NT / 64;
    const int total = NS * 2 * NG;
    for (int idx = opaque_bid() * NTH + opaque_tid(); idx < total; idx += gridDim.x * NTH) {
        const int j = (idx % NG) * 8, rs = idx / NG, which = rs & 1, s = rs >> 1;
        const int sin = s % 36;
        if (l == DEPTH - 1 && sin < 4) continue;
        const bf16x8 zero8 = (bf16x8){0, 0, 0, 0, 0, 0, 0, 0};
        bf16x8 gp, gc, gn, vv; int row;
        if (which == 0) {
            row = s * 64;
            const bool hasp = !(sin == 0 || sin == 4);
            gp = hasp ? *(const bf16x8*)(GB + ((size_t)(s - 1) * 4 + 3) * DFF + j) : zero8;
            gc = *(const bf16x8*)(GB + ((size_t)s * 4 + 0) * DFF + j);
            gn = *(const bf16x8*)(GB + ((size_t)s * 4 + 1) * DFF + j);
            vv = *(const bf16x8*)(VB + ((size_t)s * 2 + 0) * DFF + j);
        } else {
            row = s * 64 + 63;
            const bool hasn = !(sin == 3 || sin == 35);
            gp = *(const bf16x8*)(GB + ((size_t)s * 4 + 2) * DFF + j);
            gc = *(const bf16x8*)(GB + ((size_t)s * 4 + 3) * DFF + j);
            gn = hasn ? *(const bf16x8*)(GB + ((size_t)(s + 1) * 4 + 0) * DFF + j) : zero8;
            vv = *(const bf16x8*)(VB + ((size_t)s * 2 + 1) * DFF + j);
        }
        float c0[8], c1[8], c2[8], o[8];
        *(float4*)&c0[0] = *(const float4*)(cw + j); *(float4*)&c0[4] = *(const float4*)(cw + j + 4);
        *(float4*)&c1[0] = *(const float4*)(cw + DFF + j); *(float4*)&c1[4] = *(const float4*)(cw + DFF + j + 4);
        *(float4*)&c2[0] = *(const float4*)(cw + 2 * DFF + j); *(float4*)&c2[4] = *(const float4*)(cw + 2 * DFF + j + 4);
#pragma unroll
        for (int k = 0; k < 8; ++k) {
            const float gg = c0[k] * bf2f((bf16_t)gp[k]) + c1[k] * bf2f((bf16_t)gc[k]) + c2[k] * bf2f((bf16_t)gn[k]);
            o[k] = gelu_tanh(gg) * bf2f((bf16_t)vv[k]);
        }
        *(bf16x8*)(ACT + (size_t)row * DFF + j) = pack8(o[0], o[1], o[2], o[3], o[4], o[5], o[6], o[7]);
    }
}

#define LAUNDER(ptr) asm volatile("" : "+s"(ptr))
__device__ __forceinline__ void run_phase(const Params& p0, int ph, unsigned char* smem) {
    Params p = p0;
    { size_t zoff = 0; asm volatile("" : "+s"(zoff)); p.ws = p0.ws + zoff; }
    unsigned char* big = p.ws + WS_BIG;
    if (ph == 0) { phase_mod(p, smem); return; }
    if (ph == 1) { phase_pre0(p, 0, smem); phase_rowwise(p, 0, 0); return; }
    const int l = ph < NPRE ? 0 : (ph - NPRE) / NPL, q = ph < NPRE ? -1 : (ph - NPRE) % NPL;
    const bool last = (l == DEPTH - 1);
    if (q == 5 || q == 9) {
        phase_rowwise(p, q == 5 ? 1 : 2, l);
    } else if (q == 1) {
        phase_prep(p, smem);
    } else if (q == 2) {
        phase_mix(p, l, l, smem);
    } else if (q == 3) {
        phase_fin(p, l, smem);
    } else if (q == 7) {
        phase_fixup(p, l);
    } else if (q == 6) {
        pg8::Gemm g; g.A = (const bf16_t*)(big + B_HFFN); g.Bt = (const bf16_t*)(p.ws + WS_WUP) + (size_t)l * DUP * DM; g.M = NT; g.N = DUP; g.K = DM; g.ld = DM;
        EpiConv E; E.ACT = (bf16_t*)(big + B_ACT); E.GB = (bf16_t*)(big + B_GB); E.VB = (bf16_t*)(big + B_VB); E.cw = p.ffn_conv + (size_t)l * 3 * DFF;
        SkipOrder S; S.skip = last ? 1 : 0;
        S.init(last ? (g.M / 9) * 8 : g.M, g.N, (int)gridDim.x, opaque_bid());
        pg8::gemm_phase<EpiConv, SkipOrder>((PG8_LAS unsigned char*)smem, g, S, E, nullptr);
    } else {
        pg8::Gemm g; EpiStore E; E.split_cols = 0; E.split_stride = 0; int skip = last ? 1 : 0;
        if (q == 0) {
            g.A = (const bf16_t*)(big + B_HMIX); g.Bt = (const bf16_t*)(p.ws + WS_WIN) + (size_t)l * PSTR * DM; g.M = NT; g.N = PSTR; g.K = DM; g.ld = DM;
            E.O = (bf16_t*)(big + B_P); E.ldc = PSTR; skip = 0;
        } else if (q == 4) {
            g.A = (const bf16_t*)(big + B_YM); g.Bt = (const bf16_t*)(p.ws + WS_WOUT) + (size_t)l * DM * DM; g.M = NT; g.N = DM; g.K = DM; g.ld = DM;
            E.O = (bf16_t*)(big + B_T); E.ldc = DM; if (!last) skip = 1;
        } else {
            g.A = (const bf16_t*)(big + B_ACT); g.Bt = (const bf16_t*)(p.ws + WS_WDOWN) + (size_t)l * DM * DFF; g.M = NT; g.N = DM; g.K = DFF; g.ld = DFF;
            E.O = (bf16_t*)(big + B_T); E.ldc = DM; skip = 1;
        }
        SkipOrder S; S.skip = skip;
        S.init(skip ? (g.M / 9) * 8 : g.M, g.N, (int)gridDim.x, opaque_bid());
        pg8::gemm_phase<EpiStore, SkipOrder>((PG8_LAS unsigned char*)smem, g, S, E, nullptr);
        if (q == 0 && !last) cvt_filler(p, l + 1, (unsigned*)(p.ws + WS_CNT) + 1000 + l, smem);
        if ((q == 8 || q == 4) && !last) {
#pragma unroll 1
            for (int kq = 0; kq < 2; ++kq) {
                const int kh = g.K / 2;
                pg8::Gemm g2 = g; g2.A = g.A + kq * kh; g2.Bt = g.Bt + kq * kh; g2.K = kh; g2.ld = g.K; g2.M = NBATCH * 256;
                EpiPart E2; E2.O = (float*)(big + (q == 8 ? B_PART : B_ACT)) + (size_t)kq * NBATCH * CL * DM;
                CtxOrder S2; S2.init(g2.M, g2.N, (int)gridDim.x, (opaque_bid() + (int)gridDim.x - kq * 64) % (int)gridDim.x);
                pg8::gemm_phase<EpiPart, CtxOrder>((PG8_LAS unsigned char*)smem, g2, S2, E2, nullptr);
            }
        }
    }
}

__global__ void __launch_bounds__(NTH, 2) mega(Params p) {
    extern __shared__ __attribute__((aligned(16))) unsigned char smem[];
    if (threadIdx.x < 64) ((volatile unsigned*)(smem + LDS_MAIN))[threadIdx.x] = 0u;
    __syncthreads();
    XcdBarrier bar = xcd_barrier_post((unsigned*)(p.ws + WS_BAR), (volatile LAS unsigned*)(smem + LDS_MAIN));
    if (p.phase_lo < 0) cg::this_grid().sync();
    for (int ph = p.phase_lo; ph < p.phase_hi; ++ph) {
        run_phase(p, ph, smem);
        if (ph + 1 < p.phase_hi) xcd_barrier(bar);
    }
}

extern "C" void kernel_launch(void* const* d_in, const int* in_sizes, int n_in, void* d_out, int out_size, void* d_ws, size_t ws_size,
                              hipStream_t stream) {
    Params p{};
    const float** f = (const float**)&p;
    for (int i = 0; i < 29; ++i) f[i] = (const float*)d_in[i];
    p.out = (float*)d_out;
    p.ws = (unsigned char*)d_ws;
    static int grid_blocks = 0;
    if (!grid_blocks) {
        int dev = 0, cus = 0;
        (void)hipGetDevice(&dev);
        (void)hipDeviceGetAttribute(&cus, hipDeviceAttributeMultiprocessorCount, dev);
        (void)hipFuncSetAttribute((const void*)mega, hipFuncAttributeMaxDynamicSharedMemorySize, LDS_BYTES);
        grid_blocks = cus;
        if (ws_size < WS_TOTAL) fprintf(stderr, "workspace too small: %zu < %zu\n", ws_size, (size_t)WS_TOTAL);
    }
    (void)hipMemsetAsync((char*)d_ws + WS_CNT, 0, WS_CTL_BYTES, stream);
    p.phase_lo = 0; p.phase_hi = NPHASE;
    void* args[] = {&p};
    hipError_t e = hipLaunchCooperativeKernel((void*)mega, dim3(grid_blocks), dim3(NTH), args, LDS_BYTES, stream);
    if (e != hipSuccess) fprintf(stderr, "cooperative launch failed: %s (grid %d)\n", hipGetErrorString(e), grid_blocks);
}
```

```cpp
#include <hip/hip_runtime.h>
#include <hip/hip_cooperative_groups.h>
#include <cstdio>
namespace cg = cooperative_groups;

__device__ __forceinline__ int pg8_opaque_tid() { int t = threadIdx.x; asm volatile("" : "+v"(t)); return t; }
namespace pg8 {
#define PG8_LAS __attribute__((address_space(3)))
typedef unsigned short bf16_t;
typedef short bf16x8 __attribute__((ext_vector_type(8)));
typedef float f32x4 __attribute__((ext_vector_type(4)));
typedef unsigned u32x4 __attribute__((ext_vector_type(4)));
constexpr int BM = 256, BK = 64, HALF = 128, HTB = HALF * BK * 2  , STAGE_BYTES = 8 * HTB, NXCD = 8, WGM = 8;

__host__ __device__ __forceinline__ int lds_byte(int r, int c) { const int st = (r >> 4) * 2 + (c >> 5), rr = r & 15, cc = c & 31, ob = rr * 64 + cc * 2; return st * 1024 + (ob ^ (((ob >> 9) & 1) << 5)); }
__host__ __device__ __forceinline__ void stage_rc(int b, int& R, int& C) { const int st = b / 1024, sb = b % 1024, swz = sb ^ (((sb >> 9) & 1) << 5); R = (st >> 1) * 16 + swz / 64; C = (st & 1) * 32 + (swz % 64) / 2; }
__host__ __device__ __forceinline__ int perm32(int rho) { const int n = rho >> 4, i = rho & 15; return 8 * (i >> 2) + 4 * n + (i & 3); }

struct Unit { int pm, pn; };
struct Gemm { const bf16_t* A; const bf16_t* Bt; int M, N, K, ld; };

struct StaticOrder {
    int nM, nN, nwg, G, c;
    __host__ __device__ void init(int M, int N, int G_, int c_) { nM = M / BM; nN = N / BM; nwg = nM * nN; G = G_; c = c_; }
    __host__ __device__ bool next(int i, Unit& u) const {
        const long L = (long)i * G + c; if (L >= nwg) return false;
        int wgid = (int)L; { const int q = nwg / NXCD, r = nwg % NXCD, xcd = wgid % NXCD, off = wgid / NXCD; wgid = (xcd < r ? xcd * (q + 1) : r * (q + 1) + (xcd - r) * q) + off; }
        const int nig = WGM * nN, gid = wgid / nig, fm = gid * WGM, gsz = (nM - fm) < WGM ? (nM - fm) : WGM;
        u.pm = fm + ((wgid % nig) % gsz); u.pn = (wgid % nig) / gsz; return true;
    }
    __device__ __forceinline__ void a_ready(const Unit&) const {}
    __device__ __forceinline__ void done(const Unit&) const {}
};
__device__ __forceinline__ unsigned cvt_pk_bf16(float lo, float hi) { unsigned r; asm volatile("v_cvt_pk_bf16_f32 %0, %1, %2" : "=v"(r) : "v"(lo), "v"(hi)); return r; }
template <class Epi, class Sched, bool STAMP = false>
__device__ __forceinline__ void gemm_phase(PG8_LAS unsigned char* lds, const Gemm g, const Sched& S, const Epi& E, unsigned long long* stamps) {
    const int tid = pg8_opaque_tid(), wid = __builtin_amdgcn_readfirstlane(tid >> 6), lane = tid & 63, wr = wid >> 2, wc = wid & 3, fr = lane & 15, fq = lane >> 4;
    const int K = g.K, nt = K / BK, LD = g.ld;
    int ts_lo = 0, ts_hi = 0, nts = 0; const unsigned long long rt_entry = STAMP ? (unsigned long long)wall_clock64() : 0ull;
#define PG8_STAMP() do { if (STAMP && wid == 0 && nts < 64) { const unsigned long long _c = (unsigned long long)clock64(); \
        ts_lo = (lane == nts) ? (int)(unsigned)_c : ts_lo; ts_hi = (lane == nts) ? (int)(unsigned)(_c >> 32) : ts_hi; ++nts; } } while (0)
    PG8_STAMP();
    unsigned voffA[2], voffB[2];
#pragma unroll
    for (int i = 0; i < 2; ++i) { int R, C; stage_rc(tid * 16 + i * 8192, R, C); const int Rb = Epi::PERM ? ((R & ~31) + perm32(R & 31)) : R;
        voffA[i] = (unsigned)(R * LD + C) * 2u; voffB[i] = (unsigned)(Rb * LD + C) * 2u; }
    const size_t kstep = (size_t)(BK * 2);
    const size_t hstep = (size_t)HALF * LD * 2;
    const size_t tstep = 2 * hstep;
    const unsigned ldsw = (unsigned)wid * 1024u;
    const int aoff = lds_byte(wr * 64 + fr, fq * 8), boff = lds_byte(wc * 32 + fr, fq * 8);
#define PG8_SA(b, h) (((b) * 2 + (h)) * HTB)
#define PG8_SB(b, h) ((4 + (b) * 2 + (h)) * HTB)
#define PG8_STAGE(bufoff, gbase, voff) do { _Pragma("unroll") for (int _i = 0; _i < 2; ++_i) \
        __builtin_amdgcn_global_load_lds((const unsigned*)((const char*)(gbase) + (voff)[_i]), (PG8_LAS unsigned*)(lds + (bufoff) + ldsw + _i * 8192), 16, 0, 0); } while (0)
#define PG8_LDA(dst, b, h) do { _Pragma("unroll") for (int m = 0; m < 4; ++m) _Pragma("unroll") for (int k = 0; k < 2; ++k) dst[m][k] = *(const PG8_LAS bf16x8*)(lds + PG8_SA(b, h) + aoff + m * 2048 + k * 1024); } while (0)
#define PG8_LDB(dst, b, h) do { _Pragma("unroll") for (int n = 0; n < 2; ++n) _Pragma("unroll") for (int k = 0; k < 2; ++k) dst[n][k] = *(const PG8_LAS bf16x8*)(lds + PG8_SB(b, h) + boff + n * 2048 + k * 1024); } while (0)
#define PG8_MMA(ai, bj, At, Bt) do { __builtin_amdgcn_s_setprio(1); _Pragma("unroll") for (int m = 0; m < 4; ++m) _Pragma("unroll") for (int n = 0; n < 2; ++n) _Pragma("unroll") for (int k = 0; k < 2; ++k) \
        acc[ai][bj][m][n] = __builtin_amdgcn_mfma_f32_16x16x32_bf16(Bt[n][k], At[m][k], acc[ai][bj][m][n], 0, 0, 0); __builtin_amdgcn_s_setprio(0); } while (0)
#define PG8_WAIT_V(n) asm volatile("s_waitcnt vmcnt(" #n ")" ::: "memory")
#define PG8_WAIT_L(n) asm volatile("s_waitcnt lgkmcnt(" #n ")" ::: "memory")
#define PG8_BAR __builtin_amdgcn_s_barrier()
#define PG8_SCHED __builtin_amdgcn_sched_barrier(0)
    Unit cur, nxt; int ui = 0;
    if (!S.next(0, cur)) return;
    f32x4 acc[2][2][4][2];
#pragma unroll
    for (int a = 0; a < 2; ++a)
#pragma unroll
        for (int b = 0; b < 2; ++b)
#pragma unroll
            for (int m = 0; m < 4; ++m)
#pragma unroll
                for (int n = 0; n < 2; ++n) acc[a][b][m][n] = (f32x4){0.f, 0.f, 0.f, 0.f};
    bf16x8 At[4][2], B0[2][2], B1[2][2];
    const char* cA = (const char*)g.A + (size_t)cur.pm * tstep; const char* cB = (const char*)g.Bt + (size_t)cur.pn * tstep;
    S.a_ready(cur);
    PG8_STAGE(PG8_SB(0, 0), cB, voffB); PG8_STAGE(PG8_SA(0, 0), cA, voffA); PG8_STAGE(PG8_SB(0, 1), cB + hstep, voffB); PG8_STAGE(PG8_SA(0, 1), cA + hstep, voffA);
    if (wr == 1) PG8_BAR;
    PG8_WAIT_V(4); PG8_BAR;
    PG8_STAGE(PG8_SB(1, 0), cB + kstep, voffB); PG8_STAGE(PG8_SA(1, 0), cA + kstep, voffA); PG8_STAGE(PG8_SB(1, 1), cB + hstep + kstep, voffB);
    PG8_WAIT_V(6); PG8_BAR;
    PG8_STAMP();
    for (;;) {
        const bool has_next = S.next(ui + 1, nxt);
        const char* nA = has_next ? (const char*)g.A + (size_t)nxt.pm * tstep : cA; const char* nB = has_next ? (const char*)g.Bt + (size_t)nxt.pn * tstep : cB;
        for (int t = 0; t < nt; t += 2) {
            const bool last = (t == nt - 2);
            const char* a1 = cA + (size_t)(t + 1) * kstep;
            const char* a2 = last ? nA : cA + (size_t)(t + 2) * kstep; const char* b2 = last ? nB : cB + (size_t)(t + 2) * kstep;
            const char* a3 = a2 + kstep; const char* b3 = b2 + kstep;
            if (last && has_next) S.a_ready(nxt);
            PG8_LDB(B0, 0, 0); PG8_SCHED; PG8_LDA(At, 0, 0); PG8_STAGE(PG8_SA(1, 1), a1 + hstep, voffA);
            PG8_WAIT_L(8); PG8_BAR; PG8_WAIT_L(0); PG8_MMA(0, 0, At, B0); PG8_BAR; PG8_SCHED;
            PG8_LDB(B1, 0, 1); PG8_STAGE(PG8_SB(0, 0), b2, voffB);
            PG8_BAR; PG8_WAIT_L(0); PG8_MMA(0, 1, At, B1); PG8_BAR;
            PG8_LDA(At, 0, 1); PG8_STAGE(PG8_SA(0, 0), a2, voffA);
            PG8_BAR; PG8_WAIT_L(0); PG8_MMA(1, 0, At, B0); PG8_BAR; PG8_SCHED;
            PG8_STAGE(PG8_SB(0, 1), b2 + hstep, voffB);
            PG8_WAIT_V(6); PG8_BAR; PG8_MMA(1, 1, At, B1); PG8_BAR;
            PG8_LDB(B0, 1, 0); PG8_SCHED; PG8_LDA(At, 1, 0); PG8_STAGE(PG8_SA(0, 1), a2 + hstep, voffA);
            PG8_WAIT_L(8); PG8_BAR; PG8_WAIT_L(0); PG8_MMA(0, 0, At, B0); PG8_BAR; PG8_SCHED;
            PG8_LDB(B1, 1, 1); PG8_STAGE(PG8_SB(1, 0), b3, voffB);
            PG8_BAR; PG8_WAIT_L(0); PG8_MMA(0, 1, At, B1); PG8_BAR;
            PG8_LDA(At, 1, 1); PG8_STAGE(PG8_SA(1, 0), a3, voffA);
            PG8_BAR; PG8_WAIT_L(0); PG8_MMA(1, 0, At, B0); PG8_BAR; PG8_SCHED;
            PG8_STAGE(PG8_SB(1, 1), b3 + hstep, voffB);
            PG8_WAIT_V(6); PG8_BAR; PG8_MMA(1, 1, At, B1); PG8_BAR;
        }
        PG8_STAMP();
        if constexpr (!Epi::AFTER_DRAIN) { E(acc, cur, wr, wc, fr, fq); S.done(cur); }
        PG8_STAMP();
        if (!has_next) break;
#pragma unroll
        for (int a = 0; a < 2; ++a)
#pragma unroll
            for (int b = 0; b < 2; ++b)
#pragma unroll
                for (int m = 0; m < 4; ++m)
#pragma unroll
                    for (int n = 0; n < 2; ++n) acc[a][b][m][n] = (f32x4){0.f, 0.f, 0.f, 0.f};
        cur = nxt; cA = nA; cB = nB; ++ui;
    }
    PG8_WAIT_V(0);
    if (wr == 0) PG8_BAR;
    PG8_BAR;
    if constexpr (Epi::AFTER_DRAIN) { E.fused(acc, cur, wr, wc, fr, fq, lds, wid, lane); S.done(cur); }
    PG8_STAMP();
    if (STAMP && wid == 0) { stamps[lane] = lane < nts ? (((unsigned long long)(unsigned)ts_hi << 32) | (unsigned)ts_lo) : 0ull;
        if (lane == 62) stamps[62] = rt_entry; if (lane == 63) stamps[63] = (unsigned long long)wall_clock64(); }
#undef PG8_STAMP
#undef PG8_SA
#undef PG8_SB
#undef PG8_STAGE
#undef PG8_LDA
#undef PG8_LDB
#undef PG8_MMA
#undef PG8_WAIT_V
#undef PG8_WAIT_L
#undef PG8_BAR
#undef PG8_SCHED
}
}


#define XB_SPIN_CAP_OVERRIDE 1
#define XB_TMO      128
#define XB_XCNT(j)  (256  + 64 * (j))
#define XB_XSUB(j)  (1280 + 64 * (j))
#define XB_XGEN(j)  (2304 + 64 * (j))
#define XB_TOP      3328
#define XB_TOPGEN   3392
#define XCD_BAR_WORDS 3456
#define XB_SPIN_CAP (1u << 22)
#define LAS __attribute__((address_space(3)))

__device__ __forceinline__ unsigned xb_ld(unsigned* p)              { return __hip_atomic_load(p, __ATOMIC_RELAXED, __HIP_MEMORY_SCOPE_AGENT); }
__device__ __forceinline__ unsigned xb_add(unsigned* p, unsigned v) { return __hip_atomic_fetch_add(p, v, __ATOMIC_RELAXED, __HIP_MEMORY_SCOPE_AGENT); }
__device__ __forceinline__ unsigned xb_xcc_id() { return (unsigned)__builtin_amdgcn_s_getreg((3 << 11) | 20) & 0xFu; }
#define XB_SPIN(cond, bar) do { unsigned _sp = 0; while (cond) { __builtin_amdgcn_s_sleep(1); \
    if ((++_sp & 255u) == 0u) { if (xb_ld(&(bar)[XB_TMO])) break; if (_sp > XB_SPIN_CAP) { atomicAdd(&(bar)[XB_TMO], 1u); break; } } } } while (0)

struct XcdBarrier {
    unsigned* bar; unsigned x;
    volatile LAS unsigned* st;
};

__device__ __forceinline__ XcdBarrier xcd_barrier_post(unsigned* bar, volatile LAS unsigned* st) {
    XcdBarrier b; b.bar = bar; b.x = xb_xcc_id(); b.st = st;
    if (threadIdx.x == 0) (void)xb_add(&bar[XB_XCNT(b.x)], 1u);
    return b;
}
__device__ __forceinline__ void xcd_barrier_complete(unsigned* bar, unsigned x, unsigned& nloc, unsigned& nx) {
    const unsigned G = gridDim.x * gridDim.y * gridDim.z;
    unsigned sum, cnt, mine, sp = 0u;
    for (;;) {
        sum = 0u; cnt = 0u; mine = 0u;
#pragma unroll
        for (unsigned j = 0; j < 16; ++j) { const unsigned c = xb_ld(&bar[XB_XCNT(j)]); sum += c; cnt += (c > 0u) ? 1u : 0u; mine = (j == x) ? c : mine; }
        if (sum == G) break;
        __builtin_amdgcn_s_sleep(1);
        if ((++sp & 255u) == 0u) { if (xb_ld(&bar[XB_TMO])) break; if (sp > XB_SPIN_CAP) { atomicAdd(&bar[XB_TMO], 1u); break; } }
    }
    nloc = mine > 0u ? mine : 1u; nx = cnt > 0u ? cnt : 1u;
}

__device__ __forceinline__ void xcd_barrier(const XcdBarrier& b) {
    asm volatile("s_waitcnt vmcnt(0)" ::: "memory");
    __syncthreads();
    if (threadIdx.x == 0) {
        unsigned* bar = b.bar;
        __builtin_amdgcn_s_waitcnt(0);
        unsigned nloc = b.st[0], nx = b.st[1];
        if (nloc == 0u) { xcd_barrier_complete(bar, b.x, nloc, nx); b.st[0] = nloc; b.st[1] = nx; }
        const unsigned old = xb_add(&bar[XB_XSUB(b.x)], 1u);
        const unsigned gen = old / nloc;
        if (old + 1u == (gen + 1u) * nloc) {
            __builtin_amdgcn_fence(__ATOMIC_RELEASE, "agent");
            asm volatile("s_waitcnt vmcnt(0)" ::: "memory");
            const unsigned og = xb_add(&bar[XB_TOP], 1u);
            const unsigned tg = og / nx;
            if (og + 1u == (tg + 1u) * nx) xb_add(&bar[XB_TOPGEN], 1u);
            else XB_SPIN(xb_ld(&bar[XB_TOPGEN]) == tg, bar);
            __builtin_amdgcn_fence(__ATOMIC_ACQUIRE, "agent");
            xb_add(&bar[XB_XGEN(b.x)], 1u);
            asm volatile("s_waitcnt vmcnt(0)" ::: "memory");
        } else {
            XB_SPIN(xb_ld(&bar[XB_XGEN(b.x)]) == gen, bar);
            __builtin_amdgcn_fence(__ATOMIC_ACQUIRE, "agent");
            asm volatile("s_waitcnt vmcnt(0)" ::: "memory");
        }
    }
    __syncthreads();
}


typedef unsigned short bf16_t;
typedef short bf16x8 __attribute__((ext_vector_type(8)));
typedef short bf16x4 __attribute__((ext_vector_type(4)));
typedef float f32x4 __attribute__((ext_vector_type(4)));
typedef unsigned u32x4 __attribute__((ext_vector_type(4)));
#define MFMA16(a, b, c) __builtin_amdgcn_mfma_f32_16x16x32_bf16(a, b, c, 0, 0, 0)
#define WAVE_LDS_SYNC() asm volatile("s_waitcnt lgkmcnt(0)" ::: "memory")

constexpr int NTH = 512, NW = 8;
constexpr int DM = 1024, NBATCH = 16, SEQ = 2048, CL = 256, SL = 2304, NT = NBATCH * SL, DEPTH = 4;
constexpr int DIN = 2592, PSTR = 2816, DFF = 2816, DUP = 5632, HALF_T = NT / 2;
constexpr int OFF_A = 0, OFF_NAQ = 256, OFF_NAK = 512, OFF_NAV = 768, OFF_GQ = 1024, OFF_GK = 1280, OFF_GV = 1536,
              OFF_GF = 1792, OFF_GB = 1808, OFF_GR = 1824, OFF_SQ = 2080, OFF_SK = 2336, OFF_SV = 2464;
constexpr float EPS = 1e-6f;
constexpr float NEG = -1e30f;

constexpr size_t WS_XC = 0;
constexpr size_t WS_WIN = WS_XC + (size_t)NBATCH * CL * DM * 4;
constexpr size_t WS_WOUT = WS_WIN + (size_t)DEPTH * PSTR * DM * 2;
constexpr size_t WS_WUP = WS_WOUT + (size_t)DEPTH * DM * DM * 2;
constexpr size_t WS_WDOWN = WS_WUP + (size_t)DEPTH * DUP * DM * 2;
constexpr size_t WS_WGLU = WS_WDOWN + (size_t)DEPTH * DM * DFF * 2;
constexpr size_t WS_SC = WS_WGLU + (size_t)DEPTH * 256 * 256 * 2;
constexpr size_t WS_MOD = WS_SC + (size_t)17 * 1024 * 4;
constexpr size_t WS_CNT = WS_MOD + (size_t)DEPTH * 17 * 6144 * 4;
constexpr size_t WS_BAR = WS_CNT + 4096;
constexpr size_t WS_CTL_BYTES = 4096 + (size_t)XCD_BAR_WORDS * 4;
constexpr size_t WS_BIG = (WS_BAR + (size_t)XCD_BAR_WORDS * 4 + 255) / 256 * 256;
constexpr size_t B_P = 0;
constexpr size_t B_YM = B_P + (size_t)NT * PSTR * 2;
constexpr size_t B_VTN = B_YM + (size_t)NT * DM * 2;
constexpr size_t B_VTS = B_VTN + (size_t)NBATCH * 4 * 64 * SL * 2;
constexpr size_t B_YS = B_VTS + (size_t)NBATCH * 2 * 64 * SL * 2;
constexpr size_t B_OG = B_YS + (size_t)2 * NT * 256 * 2;
constexpr size_t B_END = B_OG + (size_t)2 * NT * 256 * 2;
constexpr size_t B_T = 0;
constexpr size_t B_ACT = B_T + (size_t)NT * DM * 2;
constexpr size_t B_HFFN = B_ACT + (size_t)NT * DFF * 2;
constexpr size_t B_GB = B_HFFN + (size_t)NT * DM * 2;
constexpr size_t B_VB = B_GB + (size_t)(NT / 64) * 4 * DFF * 2;
constexpr size_t B_HMIX = B_YM;
constexpr size_t B_PART = B_HFFN;
static_assert(B_VB + (size_t)(NT / 64) * 2 * DFF * 2 <= B_END, "ws overlay");
constexpr size_t WS_TOTAL = WS_BIG + B_END;

constexpr int LDS_MAIN = 139264, LDS_BYTES = LDS_MAIN + 256;
constexpr int LDS_KC = 51200, LDS_VC = LDS_KC + 256 * 144, LDS_RPB = LDS_VC + 64 * 528;
static_assert(LDS_RPB + 8 * 2048 <= LDS_MAIN, "lds map");
constexpr int NPRE = 2, NPL = 10, NPHASE = NPRE + DEPTH * NPL;

struct Params {
    const float *x, *c, *ctx, *c_ctx, *w_mod, *b_mod, *g_pre_mix, *g_post_mix, *g_pre_ffn, *g_post_ffn, *w_in, *w_out;
    const float *s5_lam_re, *s5_lam_im, *s5_b_re, *s5_b_im, *s5_c_re, *s5_c_im, *s5_log_step, *s5_d, *s5_w_glu;
    const float *na_rpb, *gla_w_gate2, *gla_b_gate, *gla_g_norm, *swa_sink, *ffn_w_up, *ffn_conv, *ffn_w_down;
    float* out;
    unsigned char* ws;
    int phase_lo, phase_hi;
};

__device__ __forceinline__ float bf2f(bf16_t h) { return __uint_as_float(((unsigned)h) << 16); }
__device__ __forceinline__ bf16_t f2bf(float f) { return __builtin_bit_cast(bf16_t, (__bf16)f); }
__device__ __forceinline__ float sigmoidf_(float x) { return 1.f / (1.f + __expf(-x)); }
__device__ __forceinline__ float siluf_(float x) { return x / (1.f + __expf(-x)); }
__device__ __forceinline__ float gelu_tanh(float x) {
    float u = 1.5957691216f * (x + 0.044715f * x * x * x);
    return x / (1.f + __expf(-u));
}
#define DPP_ADD(v, CTRL) ((v) + __uint_as_float(__builtin_amdgcn_update_dpp(0u, __float_as_uint(v), (CTRL), 0xF, 0xF, false)))
__device__ __forceinline__ float wave_sum(float v) {
    v = DPP_ADD(v, 0xB1);
    v = DPP_ADD(v, 0x4E);
    v = DPP_ADD(v, 0x141);
    v = DPP_ADD(v, 0x140);
    unsigned x = __float_as_uint(v);
    auto r = __builtin_amdgcn_permlane16_swap(x, x, false, false);
    v = __uint_as_float(r[0]) + __uint_as_float(r[1]);
    x = __float_as_uint(v);
    auto r2 = __builtin_amdgcn_permlane32_swap(x, x, false, false);
    return __uint_as_float(r2[0]) + __uint_as_float(r2[1]);
}
typedef unsigned u32x2 __attribute__((ext_vector_type(2)));
typedef float f32x2_t __attribute__((ext_vector_type(2)));
typedef __bf16 bf16v2_t __attribute__((ext_vector_type(2)));
__device__ __forceinline__ unsigned cvt2(float lo, float hi) { f32x2_t v = {lo, hi}; return __builtin_bit_cast(unsigned, __builtin_convertvector(v, bf16v2_t)); }
__device__ __forceinline__ bf16x4 pack4(float a, float b, float c, float d) {
    u32x2 r; r.x = cvt2(a, b); r.y = cvt2(c, d);
    return __builtin_bit_cast(bf16x4, r);
}
__device__ __forceinline__ bf16x8 pack8(float a, float b, float c, float d, float e, float f, float g, float h) {
    u32x4 r; r.x = cvt2(a, b); r.y = cvt2(c, d); r.z = cvt2(e, f); r.w = cvt2(g, h);
    return __builtin_bit_cast(bf16x8, r);
}
__device__ __forceinline__ int s_of(int dir, int i) { return dir == 0 ? i : (i < CL ? (CL - 1 - i) : (SL + CL - 1 - i)); }
__device__ __forceinline__ int clampi(int v, int lo, int hi) { return v < lo ? lo : (v > hi ? hi : v); }
__device__ __forceinline__ int opaque_tid() { int t = threadIdx.x; asm volatile("" : "+v"(t)); return t; }
__device__ __forceinline__ int opaque_bid() { int b = blockIdx.x; asm volatile("" : "+s"(b)); return b; }

constexpr int CVT_T_L = 16 * 44 + 16 * 16 + 16 * 88 + 44 * 16 + 4 * 4;
struct CvtTask { const float* src; bf16_t* dst; int K, N, k0, n0; bool up; };
__device__ __forceinline__ CvtTask cvt_task(const Params& p, int l, int r) {
    constexpr int T_IN = 16 * 44, T_OUT = 16 * 16, T_UP = 16 * 88, T_DOWN = 44 * 16;
    CvtTask t; int nkt;
    if (r < T_IN) { t.src = p.w_in + (size_t)l * DM * DIN; t.dst = (bf16_t*)(p.ws + WS_WIN) + (size_t)l * PSTR * DM; t.K = DM; t.N = DIN; nkt = 16; }
    else if ((r -= T_IN) < T_OUT) { t.src = p.w_out + (size_t)l * DM * DM; t.dst = (bf16_t*)(p.ws + WS_WOUT) + (size_t)l * DM * DM; t.K = DM; t.N = DM; nkt = 16; }
    else if ((r -= T_OUT) < T_UP) { t.src = p.ffn_w_up + (size_t)l * DM * DUP; t.dst = (bf16_t*)(p.ws + WS_WUP) + (size_t)l * DUP * DM; t.K = DM; t.N = DUP; nkt = 16; }
    else if ((r -= T_UP) < T_DOWN) { t.src = p.ffn_w_down + (size_t)l * DFF * DM; t.dst = (bf16_t*)(p.ws + WS_WDOWN) + (size_t)l * DM * DFF; t.K = DFF; t.N = DM; nkt = 44; }
    else { r -= T_DOWN; t.src = p.s5_w_glu + (size_t)l * 256 * 256; t.dst = (bf16_t*)(p.ws + WS_WGLU) + (size_t)l * 256 * 256; t.K = 256; t.N = 256; nkt = 4; }
    t.k0 = (r % nkt) * 64; t.n0 = (r / nkt) * 64; t.up = (t.N == DUP);
    return t;
}
__device__ __forceinline__ void cvt_tile(const CvtTask& t, float (*tile)[65], int tid) {
    const int tx = tid & 63, ty = tid >> 6;
#pragma unroll
    for (int i = 0; i < 8; ++i) {
        const int k = ty + 8 * i, n = t.n0 + tx;
        tile[k][tx] = (n < t.N) ? t.src[(size_t)(t.k0 + k) * t.N + n] : 0.f;
    }
    __syncthreads();
#pragma unroll
    for (int i = 0; i < 8; ++i) {
        const int n = ty + 8 * i;
        int nrow = t.n0 + n;
        if (t.up) { const int nn = nrow < DFF ? nrow : nrow - DFF; nrow = (nn >> 7) * 256 + (nrow < DFF ? 0 : 128) + (nn & 127); }
        t.dst[(size_t)nrow * t.K + t.k0 + tx] = f2bf(tile[tx][n]);
    }
    __syncthreads();
}
__device__ __forceinline__ void phase_pre0(const Params& p, int l, unsigned char* smem) {
    float(*tile)[65] = (float(*)[65])smem;
    const int tid = opaque_tid();
    for (int r = opaque_bid(); r < CVT_T_L; r += gridDim.x) cvt_tile(cvt_task(p, l, r), tile, tid);
}
__device__ __forceinline__ void cvt_filler(const Params& p, int l, unsigned* cnt, unsigned char* smem) {
    float(*tile)[65] = (float(*)[65])smem;
    volatile int* s_task = (volatile int*)(smem + LDS_MAIN + 64);
    const int tid = opaque_tid();
    while (true) {
        __syncthreads();
        if (tid == 0) *s_task = (int)atomicAdd(cnt, 4u);
        __syncthreads();
        const int r0 = __builtin_amdgcn_readfirstlane(*s_task);
        if (r0 >= CVT_T_L) break;
        for (int r = r0; r < r0 + 4 && r < CVT_T_L; ++r) cvt_tile(cvt_task(p, l, r), tile, tid);
    }
}

__device__ __forceinline__ void phase_mod(const Params& p, unsigned char* smem) {
    float* red = (float*)smem;
    float* scl = (float*)(smem + 36864);
    const int tid = opaque_tid(), lane = tid & 63;
    const int w = __builtin_amdgcn_readfirstlane(tid >> 6);
    float* MOD = (float*)(p.ws + WS_MOD);
    for (int i = tid; i < 17 * 1024; i += NTH) {
        const float v = (i < 16 * 1024) ? p.c[i] : p.c_ctx[i - 16 * 1024];
        scl[i] = siluf_(v);
    }
    __syncthreads();
    for (int task = opaque_bid(); task < DEPTH * 96; task += gridDim.x) {
        const int l = task / 96, j0 = (task % 96) * 64;
        const float* W = p.w_mod + (size_t)l * DM * 6144 + j0 + lane;
        float acc[17];
#pragma unroll
        for (int r = 0; r < 17; ++r) acc[r] = 0.f;
        for (int k = w * 128; k < w * 128 + 128; ++k) {
            const float wv = W[(size_t)k * 6144];
#pragma unroll
            for (int r = 0; r < 17; ++r) acc[r] += scl[r * 1024 + k] * wv;
        }
#pragma unroll
        for (int r = 0; r < 17; ++r) red[(w * 17 + r) * 64 + lane] = acc[r];
        __syncthreads();
        for (int i = tid; i < 17 * 64; i += NTH) {
            const int r = i >> 6, jj = i & 63;
            float s = 0.f;
#pragma unroll
            for (int ww = 0; ww < NW; ++ww) s += red[(ww * 17 + r) * 64 + jj];
            MOD[((size_t)(l * 17 + r)) * 6144 + j0 + jj] = s + p.b_mod[l * 6144 + j0 + jj];
        }
        __syncthreads();
    }
}

__device__ __forceinline__ void phase_rowwise(const Params& p, int mode, int l) {
    const int tid = opaque_tid();
    const int lane = tid & 63;
    const int gw = opaque_bid() * NW + (tid >> 6), nw = gridDim.x * NW;
    const float* MOD = (const float*)(p.ws + WS_MOD);
    float* Xc = (float*)(p.ws + WS_XC);
    unsigned char* big = p.ws + WS_BIG;
    const bf16_t* T = (const bf16_t*)(big + B_T);
    bf16_t* Hdst = (bf16_t*)(big + (mode == 1 ? B_HFFN : B_HMIX));
    const bool in_from_input = (l == 0 && mode != 2);
    const bool skipctx = (l == DEPTH - 1 && mode != 0);
    const int nrows = skipctx ? NBATCH * SEQ : NT;
    for (int i0 = gw; i0 < nrows; i0 += 2 * nw) {
        int tt[2]; bool ok[2];
        const float* xin[2]; float* xout[2]; int modrow[2];
#pragma unroll
        for (int r = 0; r < 2; ++r) {
            const int i = i0 + r * nw;
            ok[r] = i < nrows;
            const int ii = ok[r] ? i : i0;
            int b, s;
            if (skipctx) { b = ii / SEQ; s = CL + (ii - b * SEQ); } else { b = ii / SL; s = ii - b * SL; }
            tt[r] = b * SL + s;
            const bool isctx = s < CL;
            modrow[r] = isctx ? 16 : b;
            if (isctx) { xin[r] = (in_from_input ? p.ctx : Xc) + (size_t)(b * CL + s) * DM; xout[r] = Xc + (size_t)(b * CL + s) * DM; }
            else { xin[r] = (in_from_input ? p.x : p.out) + (size_t)(b * SEQ + s - CL) * DM; xout[r] = p.out + (size_t)(b * SEQ + s - CL) * DM; }
        }
        float xv[2][16];
#pragma unroll
        for (int r = 0; r < 2; ++r)
#pragma unroll
            for (int i = 0; i < 4; ++i) {
                const float4 v = *(const float4*)(xin[r] + i * 256 + lane * 4);
                xv[r][4 * i] = v.x; xv[r][4 * i + 1] = v.y; xv[r][4 * i + 2] = v.z; xv[r][4 * i + 3] = v.w;
            }
        if (mode != 0) {
            float rv[2][16]; float ss[2] = {0.f, 0.f};
#pragma unroll
            for (int r = 0; r < 2; ++r) {
                const bf16_t* tr = T + (size_t)tt[r] * DM;
                const bool part = (modrow[r] == 16);
                if (part) {
                    const int bb = tt[r] / SL, s = tt[r] - bb * SL;
                    const float* p0 = (const float*)(big + (mode == 2 ? B_PART : B_ACT)) + (size_t)(bb * CL + s) * DM;
                    const float* p1 = p0 + (size_t)NBATCH * CL * DM;
#pragma unroll
                    for (int i = 0; i < 4; ++i) {
                        const float4 a = *(const float4*)(p0 + i * 256 + lane * 4), c4 = *(const float4*)(p1 + i * 256 + lane * 4);
                        rv[r][4 * i] = a.x + c4.x; rv[r][4 * i + 1] = a.y + c4.y; rv[r][4 * i + 2] = a.z + c4.z; rv[r][4 * i + 3] = a.w + c4.w;
#pragma unroll
                        for (int k = 0; k < 4; ++k) ss[r] += rv[r][4 * i + k] * rv[r][4 * i + k];
                    }
                } else {
#pragma unroll
                    for (int i = 0; i < 4; ++i) {
                        const bf16x4 v = *(const bf16x4*)(tr + i * 256 + lane * 4);
#pragma unroll
                        for (int k = 0; k < 4; ++k) { rv[r][4 * i + k] = bf2f((bf16_t)v[k]); ss[r] += rv[r][4 * i + k] * rv[r][4 * i + k]; }
                    }
                }
            }
            ss[0] = wave_sum(ss[0]); ss[1] = wave_sum(ss[1]);
            const float* gpost = (mode == 1 ? p.g_post_mix : p.g_post_ffn) + l * DM;
#pragma unroll
            for (int r = 0; r < 2; ++r) {
                const float rstd = rsqrtf(ss[r] * (1.f / DM) + EPS);
                const float* gate = MOD + (size_t)(l * 17 + modrow[r]) * 6144 + (mode == 1 ? 2 : 5) * 1024;
#pragma unroll
                for (int i = 0; i < 4; ++i) {
                    const int c = i * 256 + lane * 4;
                    const float4 g4 = *(const float4*)(gpost + c);
                    const float4 t4 = *(const float4*)(gate + c);
                    xv[r][4 * i] += t4.x * (rv[r][4 * i] * rstd * g4.x);
                    xv[r][4 * i + 1] += t4.y * (rv[r][4 * i + 1] * rstd * g4.y);
                    xv[r][4 * i + 2] += t4.z * (rv[r][4 * i + 2] * rstd * g4.z);
                    xv[r][4 * i + 3] += t4.w * (rv[r][4 * i + 3] * rstd * g4.w);
                    float4 o; o.x = xv[r][4 * i]; o.y = xv[r][4 * i + 1]; o.z = xv[r][4 * i + 2]; o.w = xv[r][4 * i + 3];
                    if (ok[r]) *(float4*)(xout[r] + c) = o;
                }
            }
        }
        if (mode == 2 && l == DEPTH - 1) continue;
        float ss[2] = {0.f, 0.f};
#pragma unroll
        for (int r = 0; r < 2; ++r)
#pragma unroll
            for (int k = 0; k < 16; ++k) ss[r] += xv[r][k] * xv[r][k];
        ss[0] = wave_sum(ss[0]); ss[1] = wave_sum(ss[1]);
        const int ln = (mode == 2) ? l + 1 : l;
        const float* g = (mode == 1 ? p.g_pre_ffn : p.g_pre_mix) + ln * DM;
#pragma unroll
        for (int r = 0; r < 2; ++r) {
            const float rstd = rsqrtf(ss[r] * (1.f / DM) + EPS);
            const float* mrn = MOD + (size_t)(ln * 17 + modrow[r]) * 6144;
            const float* sh = mrn + (mode == 1 ? 3 : 0) * 1024;
            const float* sc = mrn + (mode == 1 ? 4 : 1) * 1024;
#pragma unroll
            for (int i = 0; i < 4; ++i) {
                const int c = i * 256 + lane * 4;
                const float4 g4 = *(const float4*)(g + c);
                const float4 s4 = *(const float4*)(sc + c);
                const float4 h4 = *(const float4*)(sh + c);
                const bf16x4 o = pack4(xv[r][4 * i] * rstd * g4.x * (1.f + s4.x) + h4.x, xv[r][4 * i + 1] * rstd * g4.y * (1.f + s4.y) + h4.y,
                                       xv[r][4 * i + 2] * rstd * g4.z * (1.f + s4.z) + h4.z, xv[r][4 * i + 3] * rstd * g4.w * (1.f + s4.w) + h4.w);
                if (ok[r]) *(bf16x4*)(Hdst + (size_t)tt[r] * DM + c) = o;
            }
        }
    }
}

struct EpiStore {
    static constexpr bool PERM = true, AFTER_DRAIN = false;
    bf16_t* O; int ldc; int split_cols; size_t split_stride;
    __device__ __forceinline__ void operator()(const f32x4 (&acc)[2][2][4][2], const pg8::Unit& u, int wr, int wc, int fr, int fq) const {
        const int row0 = u.pm * 256 + wr * 64 + fr; int colt = u.pn * 256; bf16_t* base = O;
        if (split_cols) { const int t = colt / split_cols; base += (size_t)t * split_stride; colt -= t * split_cols; }
        const int col0 = colt + wc * 32 + 8 * fq;
#pragma unroll
        for (int ai = 0; ai < 2; ++ai)
#pragma unroll
            for (int m = 0; m < 4; ++m) {
                bf16_t* rowp = base + (size_t)(row0 + ai * 128 + m * 16) * ldc + col0;
#pragma unroll
                for (int bj = 0; bj < 2; ++bj) {
                    const f32x4 v0 = acc[ai][bj][m][0], v1 = acc[ai][bj][m][1];
                    u32x4 w; w.x = cvt2(v0[0], v0[1]); w.y = cvt2(v0[2], v0[3]); w.z = cvt2(v1[0], v1[1]); w.w = cvt2(v1[2], v1[3]);
                    *(u32x4*)(rowp + bj * 128) = w;
                }
            }
    }
};
__device__ __forceinline__ float dpp_ror1(float v) { return __uint_as_float(__builtin_amdgcn_update_dpp(0u, __float_as_uint(v), 0x121, 0xF, 0xF, false)); }
__device__ __forceinline__ float dpp_ror15(float v) { return __uint_as_float(__builtin_amdgcn_update_dpp(0u, __float_as_uint(v), 0x12F, 0xF, 0xF, false)); }
__device__ __forceinline__ float dpp_prev(float edge, float v) { return __uint_as_float(__builtin_amdgcn_update_dpp(__float_as_uint(edge), __float_as_uint(v), 0x111, 0xF, 0xF, false)); }
__device__ __forceinline__ float dpp_next(float edge, float v) { return __uint_as_float(__builtin_amdgcn_update_dpp(__float_as_uint(edge), __float_as_uint(v), 0x101, 0xF, 0xF, false)); }
typedef float f32x2v __attribute__((ext_vector_type(2)));
struct EpiConv {
    static constexpr bool PERM = true, AFTER_DRAIN = false;
    bf16_t* ACT; bf16_t* GB; bf16_t* VB; const float* cw;
    __device__ __forceinline__ void operator()(const f32x4 (&acc)[2][2][4][2], const pg8::Unit& u, int wr, int wc, int fr, int fq) const {
        const int col0 = u.pn * 128 + wc * 32 + 8 * fq;
        f32x2v c0[4], c1[4], c2[4];
#pragma unroll
        for (int q = 0; q < 4; ++q) {
            c0[q] = *(const f32x2v*)(cw + col0 + 2 * q); c1[q] = *(const f32x2v*)(cw + DFF + col0 + 2 * q); c2[q] = *(const f32x2v*)(cw + 2 * DFF + col0 + 2 * q);
        }
#pragma unroll
        for (int ai = 0; ai < 2; ++ai) {
            const int row0 = u.pm * 256 + ai * 128 + wr * 64;
            const int strip = row0 >> 6;
            unsigned outp[4][4];
#pragma unroll
            for (int q = 0; q < 4; ++q) {
                const int n = q >> 1, j = (q & 1) * 2;
                f32x2v g[4], up[4], dn[4];
#pragma unroll
                for (int m = 0; m < 4; ++m) { g[m].x = acc[ai][0][m][n][j]; g[m].y = acc[ai][0][m][n][j + 1]; }
#pragma unroll
                for (int m = 0; m < 4; ++m) {
                    f32x2v eu = {0.f, 0.f}, ed = {0.f, 0.f};
                    if (m > 0) { eu.x = dpp_ror1(g[m > 0 ? m - 1 : 0].x); eu.y = dpp_ror1(g[m > 0 ? m - 1 : 0].y); }
                    if (m < 3) { ed.x = dpp_ror15(g[m < 3 ? m + 1 : 3].x); ed.y = dpp_ror15(g[m < 3 ? m + 1 : 3].y); }
                    up[m].x = dpp_prev(eu.x, g[m].x); up[m].y = dpp_prev(eu.y, g[m].y);
                    dn[m].x = dpp_next(ed.x, g[m].x); dn[m].y = dpp_next(ed.y, g[m].y);
                }
#pragma unroll
                for (int m = 0; m < 4; ++m) {
                    const f32x2v gg = c0[q] * up[m] + c1[q] * g[m] + c2[q] * dn[m];
                    const f32x2v t = (gg * gg) * 0.044715f + 1.0f;
                    const f32x2v uu = (gg * t) * (-1.5957691216f * 1.4426950408889634f);
                    f32x2v e; e.x = __builtin_amdgcn_exp2f(uu.x); e.y = __builtin_amdgcn_exp2f(uu.y);
                    const f32x2v dd = e + 1.0f;
                    f32x2v r; r.x = __builtin_amdgcn_rcpf(dd.x); r.y = __builtin_amdgcn_rcpf(dd.y);
                    f32x2v val; val.x = acc[ai][1][m][n][j]; val.y = acc[ai][1][m][n][j + 1];
                    const f32x2v o = (gg * r) * val;
                    outp[m][q] = cvt2(o.x, o.y);
                }
            }
#pragma unroll
            for (int m = 0; m < 4; ++m) {
                const int lr = m * 16 + fr;
                if (lr != 0 && lr != 63) {
                    u32x4 w4; w4.x = outp[m][0]; w4.y = outp[m][1]; w4.z = outp[m][2]; w4.w = outp[m][3];
                    *(u32x4*)(ACT + (size_t)(row0 + lr) * DFF + col0) = w4;
                }
                if (lr < 2 || lr >= 62) {
                    const int slot = lr < 2 ? lr : lr - 60;
                    *(bf16x8*)(GB + ((size_t)strip * 4 + slot) * DFF + col0) = pack8(acc[ai][0][m][0][0], acc[ai][0][m][0][1], acc[ai][0][m][0][2], acc[ai][0][m][0][3],
                                                                                     acc[ai][0][m][1][0], acc[ai][0][m][1][1], acc[ai][0][m][1][2], acc[ai][0][m][1][3]);
                    if (lr == 0 || lr == 63)
                        *(bf16x8*)(VB + ((size_t)strip * 2 + (lr ? 1 : 0)) * DFF + col0) = pack8(acc[ai][1][m][0][0], acc[ai][1][m][0][1], acc[ai][1][m][0][2], acc[ai][1][m][0][3],
                                                                                                 acc[ai][1][m][1][0], acc[ai][1][m][1][1], acc[ai][1][m][1][2], acc[ai][1][m][1][3]);
                }
            }
        }
    }
};
struct InLastOrder {
    pg8::StaticOrder lat; int G, c;
    __device__ __forceinline__ void init(int G_, int c_) { G = G_; c = c_; lat.init(128 * 256, PSTR, G_, c_); }
    __device__ __forceinline__ bool next(int i, pg8::Unit& u) const {
        if (lat.next(i, u)) { u.pm = (u.pm >> 3) * 9 + 1 + (u.pm & 7); return true; }
        const int L = i * G + c - 128 * (PSTR / 256);
        if (L < 0 || L >= 16 * 8) return false;
        const int t = L & 7;
        u.pm = (L >> 3) * 9;
        u.pn = t + (t >= 1 ? 1 : 0) + (t >= 3 ? 1 : 0) + (t >= 6 ? 1 : 0);
        return true;
    }
    __device__ __forceinline__ void a_ready(const pg8::Unit&) const {}
    __device__ __forceinline__ void done(const pg8::Unit&) const {}
};
struct EpiPart {
    static constexpr bool PERM = true, AFTER_DRAIN = false;
    float* O;
    __device__ __forceinline__ void operator()(const f32x4 (&acc)[2][2][4][2], const pg8::Unit& u, int wr, int wc, int fr, int fq) const {
        const int row0 = (u.pm / 9) * 256 + wr * 64 + fr, col0 = u.pn * 256 + wc * 32 + 8 * fq;
#pragma unroll
        for (int ai = 0; ai < 2; ++ai)
#pragma unroll
            for (int m = 0; m < 4; ++m) {
                float* rowp = O + (size_t)(row0 + ai * 128 + m * 16) * DM + col0;
#pragma unroll
                for (int bj = 0; bj < 2; ++bj) { *(f32x4*)(rowp + bj * 128) = acc[ai][bj][m][0]; *(f32x4*)(rowp + bj * 128 + 4) = acc[ai][bj][m][1]; }
            }
    }
};
struct CtxOrder : pg8::StaticOrder {
    __device__ __forceinline__ bool next(int i, pg8::Unit& u) const {
        if (!pg8::StaticOrder::next(i, u)) return false;
        u.pm = u.pm * 9;
        return true;
    }
};
struct SkipOrder : pg8::StaticOrder {
    int skip;
    __device__ __forceinline__ bool next(int i, pg8::Unit& u) const {
        if (!pg8::StaticOrder::next(i, u)) return false;
        if (skip) u.pm = (u.pm >> 3) * 9 + 1 + (u.pm & 7);
        return true;
    }
};

__device__ __forceinline__ void phase_prep(const Params& p, unsigned char* smem) {
    const int tid = opaque_tid();
    const int lane = tid & 63, w = tid >> 6;
    unsigned char* big = p.ws + WS_BIG;
    bf16_t* P = (bf16_t*)(big + B_P);
    bf16_t* VTN = (bf16_t*)(big + B_VTN);
    bf16_t* VTS = (bf16_t*)(big + B_VTS);
    bf16_t* tl = (bf16_t*)smem;
    constexpr int N_ROPE = NBATCH * SEQ / NW, N_VT = NBATCH * 6 * (SL / 64);
    for (int task = opaque_bid(); task < N_ROPE + N_VT; task += gridDim.x) {
        if (task < N_ROPE) {
            const int tk = task * NW + w;
            const int b = tk / SEQ, pos = tk % SEQ;
            bf16_t* pr = P + (size_t)(b * SL + CL + pos) * PSTR;
            const int row = pos >> 6, col = pos & 63;
#pragma unroll
            for (int e0 = 0; e0 < 192; e0 += 64) {
                const int e = e0 + lane;
                const int head = e >> 5, pair = e & 31, half = pair >> 4, i = pair & 15;
                const int base = (head < 4) ? (OFF_SQ + head * 64) : (OFF_SK + (head - 4) * 64);
                const int i1 = base + half * 32 + i, i2 = i1 + 16;
                const float inv_freq = exp2f(-(float)i * (13.287712379549449f / 16.f));
                const float ang = (float)(half ? col : row) * inv_freq;
                float sn, cs; __sincosf(ang, &sn, &cs);
                const float t1 = bf2f(pr[i1]), t2 = bf2f(pr[i2]);
                pr[i1] = f2bf(t1 * cs - t2 * sn);
                pr[i2] = f2bf(t1 * sn + t2 * cs);
            }
        } else {
            const int r = task - N_ROPE;
            const int st = r % (SL / 64), slot = (r / (SL / 64)) % 6, b = r / (6 * (SL / 64));
            const int s0 = st * 64;
            const int col = (slot < 4) ? (OFF_NAV + slot * 64) : (OFF_SV + (slot - 4) * 64);
            {
                const int tt = tid >> 3, dc = (tid & 7) * 8;
                const bf16x8 v = *(const bf16x8*)(P + (size_t)(b * SL + s0 + tt) * PSTR + col + dc);
#pragma unroll
                for (int k = 0; k < 8; ++k) tl[(dc + k) * 72 + tt] = (bf16_t)v[k];
            }
            __syncthreads();
            {
                const int d = tid >> 3, tc = (tid & 7) * 8;
                const bf16x8 v = *(const bf16x8*)(tl + d * 72 + tc);
                bf16_t* dst = (slot < 4) ? (VTN + ((size_t)(b * 4 + slot) * 64 + d) * SL + s0 + tc) : (VTS + ((size_t)(b * 2 + slot - 4) * 64 + d) * SL + s0 + tc);
                *(bf16x8*)dst = v;
            }
            __syncthreads();
        }
    }
}

__device__ __forceinline__ float quad_max(float v) {
    unsigned x = __float_as_uint(v);
    auto r = __builtin_amdgcn_permlane16_swap(x, x, false, false);
    float a = fmaxf(__uint_as_float(r[0]), __uint_as_float(r[1]));
    x = __float_as_uint(a);
    auto r2 = __builtin_amdgcn_permlane32_swap(x, x, false, false);
    return fmaxf(__uint_as_float(r2[0]), __uint_as_float(r2[1]));
}
__device__ __forceinline__ float quad_sum(float v) {
    unsigned x = __float_as_uint(v);
    auto r = __builtin_amdgcn_permlane16_swap(x, x, false, false);
    float a = __uint_as_float(r[0]) + __uint_as_float(r[1]);
    x = __float_as_uint(a);
    auto r2 = __builtin_amdgcn_permlane32_swap(x, x, false, false);
    return __uint_as_float(r2[0]) + __uint_as_float(r2[1]);
}
struct KFrag { bf16x8 k[4]; };
struct VFrag { bf16x8 v[4]; };
__device__ __forceinline__ KFrag load_k(const char* kb_u, unsigned ko0, unsigned ko1) {
    KFrag f;
    f.k[0] = *(const bf16x8*)(kb_u + ko0); f.k[1] = *(const bf16x8*)(kb_u + ko0 + 64);
    f.k[2] = *(const bf16x8*)(kb_u + ko1); f.k[3] = *(const bf16x8*)(kb_u + ko1 + 64);
    return f;
}
__device__ __forceinline__ VFrag load_v(const char* vb_u, const unsigned (&vo)[4]) {
    VFrag f;
#pragma unroll
    for (int dt = 0; dt < 4; ++dt) f.v[dt] = *(const bf16x8*)(vb_u + vo[dt]);
    return f;
}
constexpr float LOG2E = 1.4426950408889634f;

template <bool CTXLDS>
__device__ __forceinline__ void attn_task(const Params& p, int l, int kind, int b, int a, int c, int h, int lane, const float* rpbl  ,
                                          const char* Kc, const char* Vc) {
    const int fr = lane & 15, fq = lane >> 4;
    unsigned char* big = p.ws + WS_BIG;
    const bf16_t* Pb = (const bf16_t*)(big + B_P) + (size_t)b * SL * PSTR;
    bf16_t* YM = (bf16_t*)(big + B_YM) + (size_t)b * SL * DM;
    const bool isna = (kind == 0 || kind == 2);
    const int kvh = isna ? h : (h >> 1);
    const char* Kbase = (const char*)(Pb + (isna ? OFF_NAK : OFF_SK) + kvh * 64);
    const char* Vbase = (const char*)(isna ? ((const bf16_t*)(big + B_VTN) + (size_t)(b * 4 + kvh) * 64 * SL)
                                           : ((const bf16_t*)(big + B_VTS) + (size_t)(b * 2 + kvh) * 64 * SL));
    const int krow = (fr >> 2) * 8 + (fr & 3);
    const unsigned ko0 = (unsigned)(krow * PSTR + fq * 8) * 2u, ko1 = ko0 + 4u * PSTR * 2u;
    unsigned vo[4];
#pragma unroll
    for (int dt = 0; dt < 4; ++dt) vo[dt] = (unsigned)((dt * 16 + fr) * SL + fq * 8) * 2u;
    int qtok[2];
    if (kind == 0) { qtok[0] = CL + (2 * a) * 64 + c * 16 + fr; qtok[1] = qtok[0] + 64; }
    else if (kind == 1) { qtok[0] = CL + a * 32 + fr; qtok[1] = qtok[0] + 16; }
    else { qtok[0] = a * 32 + fr; qtok[1] = qtok[0] + 16; }
    bf16x8 qB[2][2];
#pragma unroll
    for (int g = 0; g < 2; ++g) {
        const bf16_t* qp = Pb + (size_t)qtok[g] * PSTR + (isna ? OFF_NAQ : OFF_SQ) + h * 64 + fq * 8;
        qB[g][0] = *(const bf16x8*)qp;
        qB[g][1] = *(const bf16x8*)(qp + 32);
    }
    int nloc = 0, loc0 = 0, locstep = 32;
    int row0A = 0, rowoff = 0, q0 = 0;
    int dcv[8]; unsigned vmask = 0u;
#pragma unroll
    for (int e = 0; e < 8; ++e) dcv[e] = 0;
    if (kind == 0) {
        const int r0 = 2 * a;
        row0A = clampi(r0 - 4, 0, 24);
        const int row0B = clampi(r0 - 3, 0, 24);
        rowoff = row0B - row0A;
        const int col0 = clampi(16 * c - 8, 0, 32), qcol = 16 * c + fr, wst = clampi(qcol - 8, 0, 48);
        nloc = 8 + rowoff; loc0 = CL + row0A * 64 + col0; locstep = 64;
#pragma unroll
        for (int e = 0; e < 8; ++e) {
            const int kcol = col0 + fq * 8 + e;
            if ((kcol >= wst) && (kcol < wst + 16)) vmask |= (1u << e);
            dcv[e] = clampi(kcol - qcol, -15, 15) + 15;
        }
    } else if (kind == 1) {
        q0 = a * 32;
        const int lo = q0 - 128;
        const int first = lo < 0 ? 0 : lo, last = (lo + 288) > SEQ ? SEQ : (lo + 288);
        nloc = (last - first) >> 5; loc0 = CL + first; locstep = 32;
    }
    const int nblk = 8 + nloc;
    auto s0_of = [&](int i) { const int ii = i < nblk ? i : nblk - 1; return ii < 8 ? ii * 32 : loc0 + (ii - 8) * locstep; };
    f32x4 o[2][4];
    float m[2], lsum[2];
#pragma unroll
    for (int g = 0; g < 2; ++g) {
        m[g] = NEG; lsum[g] = 0.f;
#pragma unroll
        for (int dt = 0; dt < 4; ++dt) o[g][dt] = (f32x4){0.f, 0.f, 0.f, 0.f};
    }
    constexpr float C1 = 0.125f * LOG2E;
    auto compute = [&](const KFrag& kc, const VFrag& vc, int i, int s0) {
#pragma unroll
        for (int g = 0; g < 2; ++g) {
            bool act = true;
            float badd[8];
#pragma unroll
            for (int e = 0; e < 8; ++e) badd[e] = 0.f;
            if (i >= 8) {
                if (kind == 0) {
                    const int j = i - 8;
                    act = (g == 0) ? (j < 8) : (j >= rowoff);
                    if (act) {
                        const float* bias = rpbl + (row0A + j - (2 * a + g) + 7) * 31;
#pragma unroll
                        for (int e = 0; e < 8; ++e) badd[e] = ((vmask >> e) & 1u) ? bias[dcv[e]] : NEG;
                    }
                } else {
                    const int kp0 = s0 - CL, qlo = q0 + 16 * g;
                    const bool full = (kp0 >= qlo + 15 - 128) && (kp0 + 31 <= qlo + 128);
                    if (!full) {
#pragma unroll
                        for (int e = 0; e < 8; ++e) {
                            const int d = qlo + fr - (kp0 + fq * 8 + e);
                            badd[e] = (d <= 128 && d >= -128) ? 0.f : NEG;
                        }
                    }
                }
            }
            if (act) {
                f32x4 s[2];
                s[0] = MFMA16(kc.k[0], qB[g][0], ((f32x4){0.f, 0.f, 0.f, 0.f}));
                s[0] = MFMA16(kc.k[1], qB[g][1], s[0]);
                s[1] = MFMA16(kc.k[2], qB[g][0], ((f32x4){0.f, 0.f, 0.f, 0.f}));
                s[1] = MFMA16(kc.k[3], qB[g][1], s[1]);
                float t[8];
                float bm = NEG;
#pragma unroll
                for (int e = 0; e < 8; ++e) { t[e] = fmaf(s[e >> 2][e & 3], C1, badd[e]); bm = fmaxf(bm, t[e]); }
                bm = quad_max(bm);
                if (__any(bm > m[g] + 8.f)) {
                    const float mn = fmaxf(m[g], bm);
                    const float alpha = __builtin_amdgcn_exp2f(m[g] - mn);
                    m[g] = mn;
                    lsum[g] *= alpha;
#pragma unroll
                    for (int dt = 0; dt < 4; ++dt) o[g][dt] *= alpha;
                }
                float pv[8]; float ps = 0.f;
#pragma unroll
                for (int e = 0; e < 8; ++e) { pv[e] = __builtin_amdgcn_exp2f(t[e] - m[g]); ps += pv[e]; }
                lsum[g] += ps;
                const bf16x8 pB = pack8(pv[0], pv[1], pv[2], pv[3], pv[4], pv[5], pv[6], pv[7]);
#pragma unroll
                for (int dt = 0; dt < 4; ++dt) o[g][dt] = MFMA16(vc.v[dt], pB, o[g][dt]);
            }
        }
    };
    if (CTXLDS) {
        KFrag gk0 = load_k(Kbase + (size_t)s0_of(8) * (PSTR * 2), ko0, ko1);
        VFrag gv0 = load_v(Vbase + (size_t)s0_of(8) * 2, vo);
        KFrag gk1 = load_k(Kbase + (size_t)s0_of(9) * (PSTR * 2), ko0, ko1);
        const char* kl = Kc + (krow * 144 + fq * 16);
        auto lds_k = [&](int s0) { KFrag f; const char* q = kl + s0 * 144;
            f.k[0] = *(const bf16x8*)q; f.k[1] = *(const bf16x8*)(q + 64); f.k[2] = *(const bf16x8*)(q + 4 * 144); f.k[3] = *(const bf16x8*)(q + 4 * 144 + 64); return f; };
        auto lds_v = [&](int s0) { VFrag f;
#pragma unroll
            for (int dt = 0; dt < 4; ++dt) f.v[dt] = *(const bf16x8*)(Vc + (dt * 16 + fr) * 528 + (s0 + fq * 8) * 2);
            return f; };
        KFrag kc = lds_k(0); VFrag vc = lds_v(0);
        for (int i = 0; i < 8; ++i) {
            const int sn = (i < 7 ? i + 1 : 7) * 32;
            const KFrag kn = lds_k(sn); const VFrag vn = lds_v(sn);
            compute(kc, vc, i, i * 32);
            kc = kn; vc = vn;
        }
        kc = gk0; vc = gv0;
        KFrag kn = gk1;
        for (int i = 8; i < nblk; ++i) {
            const KFrag kn2 = load_k(Kbase + (size_t)s0_of(i + 2) * (PSTR * 2), ko0, ko1);
            const VFrag vn = load_v(Vbase + (size_t)s0_of(i + 1) * 2, vo);
            compute(kc, vc, i, s0_of(i));
            kc = kn; kn = kn2; vc = vn;
        }
    } else {
        KFrag kc = load_k(Kbase + (size_t)s0_of(0) * (PSTR * 2), ko0, ko1);
        KFrag kn = load_k(Kbase + (size_t)s0_of(1) * (PSTR * 2), ko0, ko1);
        VFrag vc = load_v(Vbase + (size_t)s0_of(0) * 2, vo);
        for (int i = 0; i < nblk; ++i) {
            const KFrag kn2 = load_k(Kbase + (size_t)s0_of(i + 2) * (PSTR * 2), ko0, ko1);
            const VFrag vn = load_v(Vbase + (size_t)s0_of(i + 1) * 2, vo);
            compute(kc, vc, i, s0_of(i));
            kc = kn; kn = kn2; vc = vn;
        }
    }
#pragma unroll
    for (int g = 0; g < 2; ++g) {
        float lt = quad_sum(lsum[g]);
        if (!isna) lt += __builtin_amdgcn_exp2f(p.swa_sink[l * 4 + h] * LOG2E - m[g]);
        const float inv = 1.f / lt;
        bf16_t* dst = YM + (size_t)qtok[g] * DM + (isna ? 256 : 768) + h * 64;
#pragma unroll
        for (int dt = 0; dt < 4; ++dt)
            *(bf16x4*)(dst + dt * 16 + fq * 4) = pack4(o[g][dt][0] * inv, o[g][dt][1] * inv, o[g][dt][2] * inv, o[g][dt][3] * inv);
    }
}

__device__ __forceinline__ void s5_task(const Params& p, int l, int b, int g, int dir, int lane, float* bu  , bf16_t* hb  ) {
    const int fr = lane & 15, fq = lane >> 4;
    unsigned char* big = p.ws + WS_BIG;
    const bf16_t* Pb = (const bf16_t*)(big + B_P) + (size_t)b * SL * PSTR + OFF_A + g * 16;
    bf16_t* YS = (bf16_t*)(big + B_YS) + ((size_t)dir * NT + (size_t)b * SL) * 256 + g * 16;
    const int base = (l * 2 + dir) * 16 + g;
    const float step = expf(p.s5_log_step[base]);
    float lbr, lbi;
    {
        const float lre = p.s5_lam_re[base * 64 + lane], lim = p.s5_lam_im[base * 64 + lane];
        const float er = expf(lre * step);
        float sn, cs; sincosf(lim * step, &sn, &cs);
        lbr = er * cs; lbi = er * sn;
        const float nr = lbr - 1.f, ni = lbi;
        const float den = 1.f / (lre * lre + lim * lim);
        bu[2 * lane] = (nr * lre + ni * lim) * den;
        bu[2 * lane + 1] = (ni * lre - nr * lim) * den;
    }
    WAVE_LDS_SYNC();
    bf16x8 Bop[8];
#pragma unroll
    for (int nt = 0; nt < 8; ++nt) {
        const int pp = nt * 8 + (fr >> 1), part = fr & 1;
        const float cr = bu[2 * pp], ci = bu[2 * pp + 1];
        float v[8];
#pragma unroll
        for (int jj = 0; jj < 8; ++jj) {
            float br = 0.f, bi = 0.f;
            if (fq < 2) {
                const size_t idx = ((size_t)base * 64 + pp) * 16 + fq * 8 + jj;
                br = p.s5_b_re[idx]; bi = p.s5_b_im[idx];
            }
            v[jj] = part ? (cr * bi + ci * br) : (cr * br - ci * bi);
        }
        Bop[nt] = pack8(v[0], v[1], v[2], v[3], v[4], v[5], v[6], v[7]);
        if (nt & 1) asm volatile("" ::: "memory");
    }
    WAVE_LDS_SYNC();
    bf16x8 Cop[4];
#pragma unroll
    for (int ks = 0; ks < 4; ++ks) {
        float v[8];
#pragma unroll
        for (int jj = 0; jj < 8; ++jj) {
            const int k = ks * 32 + fq * 8 + jj;
            const size_t idx = ((size_t)base * 16 + fr) * 64 + (k >> 1);
            v[jj] = (k & 1) ? -p.s5_c_im[idx] : p.s5_c_re[idx];
        }
        Cop[ks] = pack8(v[0], v[1], v[2], v[3], v[4], v[5], v[6], v[7]);
        asm volatile("" ::: "memory");
    }
    const bf16x8 zero8 = (bf16x8){0, 0, 0, 0, 0, 0, 0, 0};
    float hr = 0.f, hi = 0.f;
    bf16x8 uN = zero8, uN2 = zero8;
    if (fq < 2) {
        uN = *(const bf16x8*)(Pb + (size_t)s_of(dir, fr) * PSTR + fq * 8);
        uN2 = *(const bf16x8*)(Pb + (size_t)s_of(dir, 16 + fr) * PSTR + fq * 8);
    }
    for (int blk = 0; blk < SL / 16; ++blk) {
        const int i0 = blk * 16;
        const bf16x8 uA = uN;
        uN = uN2;
        if (blk + 2 < SL / 16 && fq < 2) uN2 = *(const bf16x8*)(Pb + (size_t)s_of(dir, i0 + 32 + fr) * PSTR + fq * 8);
#pragma unroll
        for (int nt = 0; nt < 8; ++nt) {
            const f32x4 acc = MFMA16(uA, Bop[nt], ((f32x4){0.f, 0.f, 0.f, 0.f}));
#pragma unroll
            for (int j = 0; j < 4; ++j) bu[(fq * 4 + j) * 132 + nt * 16 + fr] = acc[j];
        }
        WAVE_LDS_SYNC();
#pragma unroll
        for (int t = 0; t < 16; ++t) {
            const float2 v = *(const float2*)(bu + t * 132 + 2 * lane);
            const float nr = lbr * hr - lbi * hi + v.x;
            const float ni = lbr * hi + lbi * hr + v.y;
            hr = nr; hi = ni;
            *(unsigned*)(hb + t * 136 + 2 * lane) = cvt2(hr, hi);
        }
        WAVE_LDS_SYNC();
        f32x4 y = (f32x4){0.f, 0.f, 0.f, 0.f};
#pragma unroll
        for (int ks = 0; ks < 4; ++ks) {
            const bf16x8 hA = *(const bf16x8*)(hb + fr * 136 + ks * 32 + fq * 8);
            y = MFMA16(hA, Cop[ks], y);
        }
#pragma unroll
        for (int j = 0; j < 4; ++j) YS[(size_t)s_of(dir, i0 + fq * 4 + j) * 256 + fr] = f2bf(y[j]);
        WAVE_LDS_SYNC();
    }
}

__device__ __forceinline__ void gla_task(const Params& p, int l, int b, int h, int dir, unsigned char* smem) {
    constexpr int LS = 72;
    bf16_t* Qd = (bf16_t*)smem;
    bf16_t* Kd = Qd + 64 * LS;
    bf16_t* KeT = Kd + 64 * LS;
    bf16_t* Vt = KeT + 64 * LS;
    bf16_t* Am = Vt + 64 * LS;
    bf16_t* St = Am + 64 * LS;
    float* segsum = (float*)(St + 64 * LS);
    float* decay = segsum + 512;
    unsigned* gfl = (unsigned*)(decay + 64);
    const int tid = opaque_tid(), lane = tid & 63, w = tid >> 6, fr = lane & 15, fq = lane >> 4;
    const int d = lane, iq = w, it = w >> 1, hb2 = (w & 1) * 2;
    unsigned char* big = p.ws + WS_BIG;
    const bf16_t* Pb = (const bf16_t*)(big + B_P) + (size_t)b * SL * PSTR;
    bf16_t* OG = (bf16_t*)(big + B_OG) + ((size_t)dir * NT + (size_t)b * SL) * 256 + h * 64;
    for (int i = tid; i < 64 * LS; i += NTH) St[i] = 0;
    f32x4 Sacc[2];
    Sacc[0] = (f32x4){0.f, 0.f, 0.f, 0.f}; Sacc[1] = (f32x4){0.f, 0.f, 0.f, 0.f};
    float wg[16];
    {
        const float* Wg = p.gla_w_gate2 + (size_t)((l * 2 + dir) * 16) * 256 + h * 64 + d;
#pragma unroll
        for (int r = 0; r < 16; ++r) wg[r] = Wg[r * 256];
    }
    const float bgv = p.gla_b_gate[(l * 2 + dir) * 256 + h * 64 + d];
    const int gcol = dir == 0 ? OFF_GF : OFF_GB;
    unsigned gfn = *(const unsigned*)(Pb + (size_t)s_of(dir, tid >> 3) * PSTR + gcol + 2 * (tid & 7));
    bf16_t qn[8], kn[8], vn[8];
#pragma unroll
    for (int ii = 0; ii < 8; ++ii) {
        const bf16_t* pr = Pb + (size_t)s_of(dir, iq * 8 + ii) * PSTR + h * 64 + d;
        qn[ii] = pr[OFF_GQ]; kn[ii] = pr[OFF_GK]; vn[ii] = pr[OFF_GV];
    }
    gfl[tid] = gfn;
    __syncthreads();
    for (int n = 0; n < SL / 64; ++n) {
        bf16_t qc[8], kc[8], vc[8];
#pragma unroll
        for (int ii = 0; ii < 8; ++ii) { qc[ii] = qn[ii]; kc[ii] = kn[ii]; vc[ii] = vn[ii]; }
        if (n + 1 < SL / 64) {
            gfn = *(const unsigned*)(Pb + (size_t)s_of(dir, (n + 1) * 64 + (tid >> 3)) * PSTR + gcol + 2 * (tid & 7));
#pragma unroll
            for (int ii = 0; ii < 8; ++ii) {
                const bf16_t* pr = Pb + (size_t)s_of(dir, (n + 1) * 64 + iq * 8 + ii) * PSTR + h * 64 + d;
                qn[ii] = pr[OFF_GQ]; kn[ii] = pr[OFF_GK]; vn[ii] = pr[OFF_GV];
            }
        }
        const unsigned* gcur = gfl + (n & 1) * 512;
        float bcum[8];
        float run = 0.f;
#pragma unroll
        for (int ii = 0; ii < 8; ++ii) {
            const bf16x8 g0 = *(const bf16x8*)(gcur + (iq * 8 + ii) * 8);
            const bf16x8 g1 = *(const bf16x8*)(gcur + (iq * 8 + ii) * 8 + 4);
            float z = bgv;
#pragma unroll
            for (int r = 0; r < 8; ++r) z += bf2f((bf16_t)g0[r]) * wg[r];
#pragma unroll
            for (int r = 0; r < 8; ++r) z += bf2f((bf16_t)g1[r]) * wg[8 + r];
            const float ls = fminf(z, 0.f) - __logf(1.f + __expf(-fabsf(z)));
            run += ls * (1.f / 16.f);
            bcum[ii] = run;
        }
        segsum[iq * 64 + d] = run;
        __syncthreads();
        float pre = 0.f, tot = 0.f;
#pragma unroll
        for (int q = 0; q < 8; ++q) {
            const float v = segsum[q * 64 + d];
            tot += v;
            if (q < iq) pre += v;
        }
        float kev[8];
#pragma unroll
        for (int ii = 0; ii < 8; ++ii) {
            const int il = iq * 8 + ii;
            const float bb = pre + bcum[ii];
            const float q = bf2f(qc[ii]), k = bf2f(kc[ii]);
            Qd[il * LS + d] = f2bf(q * 0.125f * __expf(bb));
            Kd[il * LS + d] = f2bf(k * __expf(-bb));
            kev[ii] = k * __expf(tot - bb);
        }
        *(bf16x8*)(KeT + d * LS + iq * 8) = pack8(kev[0], kev[1], kev[2], kev[3], kev[4], kev[5], kev[6], kev[7]);
        {
            bf16x8 vv;
#pragma unroll
            for (int ii = 0; ii < 8; ++ii) vv[ii] = (short)vc[ii];
            *(bf16x8*)(Vt + d * LS + iq * 8) = vv;
        }
        if (iq == 0) decay[d] = __expf(tot);
        __syncthreads();
        bf16x8 qf[2];
        qf[0] = *(const bf16x8*)(Qd + (16 * it + fr) * LS + fq * 8);
        qf[1] = *(const bf16x8*)(Qd + (16 * it + fr) * LS + 32 + fq * 8);
#pragma unroll
        for (int j2 = 0; j2 < 2; ++j2) {
            const int jt = hb2 + j2;
            f32x4 acc = (f32x4){0.f, 0.f, 0.f, 0.f};
#pragma unroll
            for (int ks = 0; ks < 2; ++ks) {
                const bf16x8 kf = *(const bf16x8*)(Kd + (jt * 16 + fr) * LS + ks * 32 + fq * 8);
                acc = MFMA16(kf, qf[ks], acc);
            }
            const int il = 16 * it + fr, j0 = jt * 16 + fq * 4;
            *(bf16x4*)(Am + il * LS + j0) = pack4(il >= j0 ? acc[0] : 0.f, il >= j0 + 1 ? acc[1] : 0.f, il >= j0 + 2 ? acc[2] : 0.f, il >= j0 + 3 ? acc[3] : 0.f);
        }
        __syncthreads();
        bf16x8 af[2];
        af[0] = *(const bf16x8*)(Am + (16 * it + fr) * LS + fq * 8);
        af[1] = *(const bf16x8*)(Am + (16 * it + fr) * LS + 32 + fq * 8);
        {
            const int s = s_of(dir, n * 64 + 16 * it + fr);
            bf16_t* orow = OG + (size_t)s * 256;
#pragma unroll
            for (int d2 = 0; d2 < 2; ++d2) {
                const int dvt = hb2 + d2;
                f32x4 acc = (f32x4){0.f, 0.f, 0.f, 0.f};
#pragma unroll
                for (int ks = 0; ks < 2; ++ks) {
                    const bf16x8 vf = *(const bf16x8*)(Vt + (dvt * 16 + fr) * LS + ks * 32 + fq * 8);
                    acc = MFMA16(vf, af[ks], acc);
                    const bf16x8 sf = *(const bf16x8*)(St + (dvt * 16 + fr) * LS + ks * 32 + fq * 8);
                    acc = MFMA16(sf, qf[ks], acc);
                }
                *(bf16x4*)(orow + dvt * 16 + fq * 4) = pack4(acc[0], acc[1], acc[2], acc[3]);
            }
        }
        gfl[((n + 1) & 1) * 512 + tid] = gfn;
        __syncthreads();
        bf16x8 vb[2];
        vb[0] = *(const bf16x8*)(Vt + (16 * it + fr) * LS + fq * 8);
        vb[1] = *(const bf16x8*)(Vt + (16 * it + fr) * LS + 32 + fq * 8);
#pragma unroll
        for (int k2 = 0; k2 < 2; ++k2) {
            const int dkt = hb2 + k2;
            const f32x4 dec = *(const f32x4*)(decay + dkt * 16 + fq * 4);
            Sacc[k2] *= dec;
#pragma unroll
            for (int ks = 0; ks < 2; ++ks) {
                const bf16x8 kf = *(const bf16x8*)(KeT + (dkt * 16 + fr) * LS + ks * 32 + fq * 8);
                Sacc[k2] = MFMA16(kf, vb[ks], Sacc[k2]);
            }
            *(bf16x4*)(St + (16 * it + fr) * LS + dkt * 16 + fq * 4) = pack4(Sacc[k2][0], Sacc[k2][1], Sacc[k2][2], Sacc[k2][3]);
        }
    }
    __syncthreads();
}

__device__ __forceinline__ int next_task(unsigned* cnt, volatile int* s_task) {
    __syncthreads();
    if (opaque_tid() == 0) *s_task = (int)atomicAdd(cnt, 1u);
    __syncthreads();
    return *s_task;
}
__device__ __forceinline__ int wave_next(unsigned* cnt, int lane) {
    int t = 0;
    if (lane == 0) t = (int)atomicAdd(cnt, 1u);
    return __builtin_amdgcn_readfirstlane(t);
}
__device__ __forceinline__ bool combo_task(int combo, int wt, bool ctx_out, int xq, int& kind, int& b, int& a, int& c, int& h) {
    c = 0;
    if (combo < 8) {
        const int n = ctx_out ? 72 : 64;
        if (wt >= n) return false;
        b = 2 * xq + (combo >> 2); h = combo & 3;
        if (wt < 64) { kind = 0; c = wt & 3; a = wt >> 2; } else { kind = 2; a = wt - 64; }
    } else {
        const int n = ctx_out ? 144 : 128;
        if (wt >= n) return false;
        const int cc = combo - 8;
        b = 2 * xq + (cc >> 1);
        if (wt < 128) { kind = 1; h = (cc & 1) * 2 + (wt & 1); a = wt >> 1; } else { const int r = wt - 128; kind = 3; h = (cc & 1) * 2 + (r & 1); a = r >> 1; }
    }
    return true;
}
__device__ __forceinline__ void phase_mix(const Params& p, int lc, int l, unsigned char* smem) {
    volatile int* s_task = (volatile int*)(smem + LDS_MAIN + 64);
    const int tid = opaque_tid(), lane = tid & 63;
    const int w = __builtin_amdgcn_readfirstlane(tid >> 6);
    const bool ctx_out = l < DEPTH - 1;
    const int x0 = (int)(xb_xcc_id() & 7u);
    unsigned* cbase = (unsigned*)(p.ws + WS_CNT) + lc * 128;
    for (int k = 0; k < 8; ++k) {
        const int xq = (x0 + k) & 7;
        unsigned* cnt = cbase + xq * 16;
        while (true) {
            const int task = __builtin_amdgcn_readfirstlane(next_task(cnt + 0, s_task));
            if (task >= 16) break;
            gla_task(p, l, 2 * xq + (task >> 3), (task >> 1) & 3, task & 1, smem);
        }
    }
    const int slot = __builtin_amdgcn_readfirstlane(next_task(cbase + x0 * 16 + 3, s_task));
    const int mycombo = (slot & 1) ? (8 + ((slot >> 1) & 3)) : ((slot >> 1) & 7);
    {
        const int cb = 2 * x0 + (mycombo < 8 ? (mycombo >> 2) : ((mycombo - 8) >> 1));
        const bool na = mycombo < 8;
        const int hh = na ? (mycombo & 3) : ((mycombo - 8) & 1);
        unsigned char* big = p.ws + WS_BIG;
        const bf16_t* Pb = (const bf16_t*)(big + B_P) + (size_t)cb * SL * PSTR + (na ? OFF_NAK : OFF_SK) + hh * 64;
        const bf16_t* Vb = na ? ((const bf16_t*)(big + B_VTN) + (size_t)(cb * 4 + hh) * 64 * SL) : ((const bf16_t*)(big + B_VTS) + (size_t)(cb * 2 + hh) * 64 * SL);
        {
            const int row = tid >> 1, half = tid & 1;
            const bf16_t* src = Pb + (size_t)row * PSTR + half * 32;
            unsigned char* dst = smem + LDS_KC + row * 144 + half * 64;
#pragma unroll
            for (int q = 0; q < 4; ++q) *(bf16x8*)(dst + q * 16) = *(const bf16x8*)(src + q * 8);
        }
        {
            const int d = tid >> 3, part = tid & 7;
            const bf16_t* src = Vb + (size_t)d * SL + part * 32;
            unsigned char* dst = smem + LDS_VC + d * 528 + part * 64;
#pragma unroll
            for (int q = 0; q < 4; ++q) *(bf16x8*)(dst + q * 16) = *(const bf16x8*)(src + q * 8);
        }
        __syncthreads();
    }
    if (w < 4) {
        int lane_s = lane; asm volatile("" : "+v"(lane_s));
        float* bu = (float*)(smem + w * 12800);
        bf16_t* hb = (bf16_t*)(smem + w * 12800 + 8448);
        for (int k = 0; k < 8; ++k) {
            const int xq = (x0 + k) & 7;
            unsigned* cnt = cbase + xq * 16;
            while (true) {
                const int wt = wave_next(cnt + 1, lane_s);
                if (wt >= 64) break;
                s5_task(p, l, 2 * xq + (wt >> 5), (wt >> 1) & 15, wt & 1, lane_s, bu, hb);
            }
        }
    }
    int lane_a = lane; asm volatile("" : "+v"(lane_a));
    float* rpbl = (float*)(smem + LDS_RPB + w * 2048);
    const char* Kc = (const char*)(smem + LDS_KC);
    const char* Vc = (const char*)(smem + LDS_VC);
    int staged_h = -1;
    auto run_combo = [&](int xq, int combo, bool cached) {
        unsigned* cnt = cbase + xq * 16;
        while (true) {
            const int wt = wave_next(cnt + 4 + combo, lane_a);
            int kind, b, a, c, h;
            if (!combo_task(combo, wt, ctx_out, xq, kind, b, a, c, h)) break;
            if (kind == 0 && staged_h != h) {
                WAVE_LDS_SYNC();
                for (int i = lane_a; i < 15 * 31; i += 64) rpbl[i] = p.na_rpb[(size_t)(l * 4 + h) * 465 + i] * LOG2E;
                WAVE_LDS_SYNC();
                staged_h = h;
            }
            if (cached) attn_task<true>(p, l, kind, b, a, c, h, lane_a, rpbl, Kc, Vc);
            else attn_task<false>(p, l, kind, b, a, c, h, lane_a, rpbl, Kc, Vc);
        }
    };
    run_combo(x0, mycombo, true);
    const int n_na = ctx_out ? 72 : 64, n_swa = ctx_out ? 144 : 128;
    for (int k = 0; k < 8; ++k) {
        const int xq = (x0 + k) & 7;
        for (int pass = 0; pass < 2; ++pass) {
            unsigned v = 0xffffffffu;
            if (lane_a < 12) v = __hip_atomic_load(cbase + xq * 16 + 4 + lane_a, __ATOMIC_RELAXED, __HIP_MEMORY_SCOPE_AGENT);
            const bool avail = (lane_a < 12) && ((int)v < (lane_a < 8 ? n_na : n_swa));
            unsigned long long mask = __ballot(avail);
            if (mask == 0ull) break;
            while (mask) {
                const int combo = __builtin_ctzll(mask);
                mask &= mask - 1ull;
                run_combo(xq, combo, false);
            }
        }
    }
}

__device__ __forceinline__ void phase_fin(const Params& p, int l, unsigned char* smem) {
    const int tid = opaque_tid(), lane = tid & 63, w = tid >> 6, fr = lane & 15, fq = lane >> 4;
    const bool ctx_out = l < DEPTH - 1;
    unsigned char* big = p.ws + WS_BIG;
    const bf16_t* P = (const bf16_t*)(big + B_P);
    bf16_t* YM = (bf16_t*)(big + B_YM);
    const bf16_t* YS = (const bf16_t*)(big + B_YS);
    const bf16_t* OG = (const bf16_t*)(big + B_OG);
    const bf16_t* WG = (const bf16_t*)(p.ws + WS_WGLU) + (size_t)l * 256 * 256;
    constexpr int TB = 144, ZS = 264;
    bf16_t* zb = (bf16_t*)smem;
    for (int bt = opaque_bid(); bt < NT / TB; bt += gridDim.x) {
        const size_t tok0 = (size_t)bt * TB;
        bf16x8 wA[2][8];
#pragma unroll
        for (int t = 0; t < 2; ++t)
#pragma unroll
            for (int ks = 0; ks < 8; ++ks) wA[t][ks] = *(const bf16x8*)(WG + (size_t)(w * 32 + t * 16 + fr) * 256 + ks * 32 + fq * 8);
        for (int idx = tid; idx < TB * 32; idx += NTH) {
            const int tt = idx >> 5, c = (idx & 31) * 8;
            const size_t tok = tok0 + tt;
            const bf16x8 u = *(const bf16x8*)(P + tok * PSTR + OFF_A + c);
            const bf16x8 yf = *(const bf16x8*)(YS + tok * 256 + c);
            const bf16x8 yr = *(const bf16x8*)(YS + ((size_t)NT + tok) * 256 + c);
            const float4 d0 = *(const float4*)(p.s5_d + l * 256 + c);
            const float4 d1 = *(const float4*)(p.s5_d + l * 256 + c + 4);
            const float dd[8] = {d0.x, d0.y, d0.z, d0.w, d1.x, d1.y, d1.z, d1.w};
            float z[8];
#pragma unroll
            for (int k = 0; k < 8; ++k) z[k] = gelu_tanh(dd[k] * bf2f((bf16_t)u[k]) + bf2f((bf16_t)yf[k]) + bf2f((bf16_t)yr[k]));
            *(bf16x8*)(zb + tt * ZS + c) = pack8(z[0], z[1], z[2], z[3], z[4], z[5], z[6], z[7]);
        }
        __syncthreads();
        for (int tg = 0; tg < TB / 16; ++tg) {
            bf16x8 zB[8];
#pragma unroll
            for (int ks = 0; ks < 8; ++ks) zB[ks] = *(const bf16x8*)(zb + (tg * 16 + fr) * ZS + ks * 32 + fq * 8);
            bf16_t* orow = YM + (tok0 + tg * 16 + fr) * DM;
#pragma unroll
            for (int t = 0; t < 2; ++t) {
                f32x4 acc = (f32x4){0.f, 0.f, 0.f, 0.f};
#pragma unroll
                for (int ks = 0; ks < 8; ++ks) acc = MFMA16(wA[t][ks], zB[ks], acc);
                const int n0 = w * 32 + t * 16 + fq * 4;
                const bf16x4 z4 = *(const bf16x4*)(zb + (tg * 16 + fr) * ZS + n0);
                *(bf16x4*)(orow + n0) = pack4(bf2f((bf16_t)z4[0]) * sigmoidf_(acc[0]), bf2f((bf16_t)z4[1]) * sigmoidf_(acc[1]),
                                              bf2f((bf16_t)z4[2]) * sigmoidf_(acc[2]), bf2f((bf16_t)z4[3]) * sigmoidf_(acc[3]));
            }
        }
        __syncthreads();
    }
    {
        const int gw = opaque_bid() * NW + w, nw = gridDim.x * NW;
        const int tk = lane >> 4, c = (lane & 15) * 16;
        const float4 g0 = *(const float4*)(p.gla_g_norm + l * 64 + (c & 63));
        const float4 g1 = *(const float4*)(p.gla_g_norm + l * 64 + (c & 63) + 4);
        const float4 g2 = *(const float4*)(p.gla_g_norm + l * 64 + (c & 63) + 8);
        const float4 g3 = *(const float4*)(p.gla_g_norm + l * 64 + (c & 63) + 12);
        const float gn[16] = {g0.x, g0.y, g0.z, g0.w, g1.x, g1.y, g1.z, g1.w, g2.x, g2.y, g2.z, g2.w, g3.x, g3.y, g3.z, g3.w};
        for (int t4 = gw; t4 < NT / 4; t4 += nw) {
            const size_t tok = (size_t)t4 * 4 + tk;
            if (!ctx_out && (int)(tok % SL) < CL) continue;
            float o[16]; float ss = 0.f;
#pragma unroll
            for (int hlf = 0; hlf < 2; ++hlf) {
                const bf16x8 a = *(const bf16x8*)(OG + tok * 256 + c + hlf * 8);
                const bf16x8 bq = *(const bf16x8*)(OG + ((size_t)NT + tok) * 256 + c + hlf * 8);
#pragma unroll
                for (int k = 0; k < 8; ++k) { o[hlf * 8 + k] = bf2f((bf16_t)a[k]) + bf2f((bf16_t)bq[k]); ss += o[hlf * 8 + k] * o[hlf * 8 + k]; }
            }
            ss = DPP_ADD(ss, 0xB1); ss = DPP_ADD(ss, 0x4E);
            const float rstd = rsqrtf(ss * (1.f / 64.f) + EPS);
#pragma unroll
            for (int hlf = 0; hlf < 2; ++hlf) {
                const bf16x8 rr = *(const bf16x8*)(P + tok * PSTR + OFF_GR + c + hlf * 8);
                float v[8];
#pragma unroll
                for (int k = 0; k < 8; ++k) v[k] = o[hlf * 8 + k] * rstd * gn[hlf * 8 + k] * siluf_(bf2f((bf16_t)rr[k]));
                *(bf16x8*)(YM + tok * DM + 512 + c + hlf * 8) = pack8(v[0], v[1], v[2], v[3], v[4], v[5], v[6], v[7]);
            }
        }
    }
}

__device__ __forceinline__ void phase_fixup(const Params& p, int l) {
    unsigned char* big = p.ws + WS_BIG;
    bf16_t* ACT = (bf16_t*)(big + B_ACT);
    const bf16_t* GB = (const bf16_t*)(big + B_GB);
    const bf16_t* VB = (const bf16_t*)(big + B_VB);
    const float* cw = p.ffn_conv + (size_t)l * 3 * DFF;
    constexpr int NG = DFF / 8, NS = NT / 64;
    const int total = NS * 2 * NG;
    for (int idx = opaque_bid() * NTH + opaque_tid(); idx < total; idx += gridDim.x * NTH) {
        const int j = (idx % NG) * 8, rs = idx / NG, which = rs & 1, s = rs >> 1;
        const int sin = s % 36;
        if (l == DEPTH - 1 && sin < 4) continue;
        const bf16x8 zero8 = (bf16x8){0, 0, 0, 0, 0, 0, 0, 0};
        bf16x8 gp, gc, gn, vv; int row;
        if (which == 0) {
            row = s * 64;
            const bool hasp = !(sin == 0 || sin == 4);
            gp = hasp ? *(const bf16x8*)(GB + ((size_t)(s - 1) * 4 + 3) * DFF + j) : zero8;
            gc = *(const bf16x8*)(GB + ((size_t)s * 4 + 0) * DFF + j);
            gn = *(const bf16x8*)(GB + ((size_t)s * 4 + 1) * DFF + j);
            vv = *(const bf16x8*)(VB + ((size_t)s * 2 + 0) * DFF + j);
        } else {
            row = s * 64 + 63;
            const bool hasn = !(sin == 3 || sin == 35);
            gp = *(const bf16x8*)(GB + ((size_t)s * 4 + 2) * DFF + j);
            gc = *(const bf16x8*)(GB + ((size_t)s * 4 + 3) * DFF + j);
            gn = hasn ? *(const bf16x8*)(GB + ((size_t)(s + 1) * 4 + 0) * DFF + j) : zero8;
            vv = *(const bf16x8*)(VB + ((size_t)s * 2 + 1) * DFF + j);
        }
        float c0[8], c1[8], c2[8], o[8];
        *(float4*)&c0[0] = *(const float4*)(cw + j); *(float4*)&c0[4] = *(const float4*)(cw + j + 4);
        *(float4*)&c1[0] = *(const float4*)(cw + DFF + j); *(float4*)&c1[4] = *(const float4*)(cw + DFF + j + 4);
        *(float4*)&c2[0] = *(const float4*)(cw + 2 * DFF + j); *(float4*)&c2[4] = *(const float4*)(cw + 2 * DFF + j + 4);
#pragma unroll
        for (int k = 0; k < 8; ++k) {
            const float gg = c0[k] * bf2f((bf16_t)gp[k]) + c1[k] * bf2f((bf16_t)gc[k]) + c2[k] * bf2f((bf16_t)gn[k]);
            o[k] = gelu_tanh(gg) * bf2f((bf16_t)vv[k]);
        }
        *(bf16x8*)(ACT + (size_t)row * DFF + j) = pack8(o[0], o[1], o[2], o[3], o[4], o[5], o[6], o[7]);
    }
}

#define LAUNDER(ptr) asm volatile("" : "+s"(ptr))
__device__ __forceinline__ void run_phase(const Params& p0, int ph, unsigned char* smem) {
    Params p = p0;
    { size_t zoff = 0; asm volatile("" : "+s"(zoff)); p.ws = p0.ws + zoff; }
    unsigned char* big = p.ws + WS_BIG;
    if (ph == 0) { phase_mod(p, smem); return; }
    if (ph == 1) { phase_pre0(p, 0, smem); phase_rowwise(p, 0, 0); return; }
    const int l = ph < NPRE ? 0 : (ph - NPRE) / NPL, q = ph < NPRE ? -1 : (ph - NPRE) % NPL;
    const bool last = (l == DEPTH - 1);
    if (q == 5 || q == 9) {
        phase_rowwise(p, q == 5 ? 1 : 2, l);
    } else if (q == 1) {
        phase_prep(p, smem);
    } else if (q == 2) {
        phase_mix(p, l, l, smem);
    } else if (q == 3) {
        phase_fin(p, l, smem);
    } else if (q == 7) {
        phase_fixup(p, l);
    } else if (q == 6) {
        pg8::Gemm g; g.A = (const bf16_t*)(big + B_HFFN); g.Bt = (const bf16_t*)(p.ws + WS_WUP) + (size_t)l * DUP * DM; g.M = NT; g.N = DUP; g.K = DM; g.ld = DM;
        EpiConv E; E.ACT = (bf16_t*)(big + B_ACT); E.GB = (bf16_t*)(big + B_GB); E.VB = (bf16_t*)(big + B_VB); E.cw = p.ffn_conv + (size_t)l * 3 * DFF;
        SkipOrder S; S.skip = last ? 1 : 0;
        S.init(last ? (g.M / 9) * 8 : g.M, g.N, (int)gridDim.x, opaque_bid());
        pg8::gemm_phase<EpiConv, SkipOrder>((PG8_LAS unsigned char*)smem, g, S, E, nullptr);
    } else {
        pg8::Gemm g; EpiStore E; E.split_cols = 0; E.split_stride = 0; int skip = last ? 1 : 0;
        if (q == 0) {
            g.A = (const bf16_t*)(big + B_HMIX); g.Bt = (const bf16_t*)(p.ws + WS_WIN) + (size_t)l * PSTR * DM; g.M = NT; g.N = PSTR; g.K = DM; g.ld = DM;
            E.O = (bf16_t*)(big + B_P); E.ldc = PSTR; skip = 0;
        } else if (q == 4) {
            g.A = (const bf16_t*)(big + B_YM); g.Bt = (const bf16_t*)(p.ws + WS_WOUT) + (size_t)l * DM * DM; g.M = NT; g.N = DM; g.K = DM; g.ld = DM;
            E.O = (bf16_t*)(big + B_T); E.ldc = DM; if (!last) skip = 1;
        } else {
            g.A = (const bf16_t*)(big + B_ACT); g.Bt = (const bf16_t*)(p.ws + WS_WDOWN) + (size_t)l * DM * DFF; g.M = NT; g.N = DM; g.K = DFF; g.ld = DFF;
            E.O = (bf16_t*)(big + B_T); E.ldc = DM; skip = 1;
        }
        if (q == 0 && last) {
            InLastOrder SL; SL.init((int)gridDim.x, opaque_bid());
            pg8::gemm_phase<EpiStore, InLastOrder>((PG8_LAS unsigned char*)smem, g, SL, E, nullptr);
            return;
        }
        SkipOrder S; S.skip = skip;
        S.init(skip ? (g.M / 9) * 8 : g.M, g.N, (int)gridDim.x, opaque_bid());
        pg8::gemm_phase<EpiStore, SkipOrder>((PG8_LAS unsigned char*)smem, g, S, E, nullptr);
        if (q == 0 && !last) cvt_filler(p, l + 1, (unsigned*)(p.ws + WS_CNT) + 1000 + l, smem);
        if ((q == 8 || q == 4) && !last) {
#pragma unroll 1
            for (int kq = 0; kq < 2; ++kq) {
                const int kh = g.K / 2;
                pg8::Gemm g2 = g; g2.A = g.A + kq * kh; g2.Bt = g.Bt + kq * kh; g2.K = kh; g2.ld = g.K; g2.M = NBATCH * 256;
                EpiPart E2; E2.O = (float*)(big + (q == 8 ? B_PART : B_ACT)) + (size_t)kq * NBATCH * CL * DM;
                CtxOrder S2; S2.init(g2.M, g2.N, (int)gridDim.x, (opaque_bid() + (int)gridDim.x - kq * 64) % (int)gridDim.x);
                pg8::gemm_phase<EpiPart, CtxOrder>((PG8_LAS unsigned char*)smem, g2, S2, E2, nullptr);
            }
        }
    }
}

__global__ void __launch_bounds__(NTH, 2) mega(Params p) {
    extern __shared__ __attribute__((aligned(16))) unsigned char smem[];
    if (threadIdx.x < 64) ((volatile unsigned*)(smem + LDS_MAIN))[threadIdx.x] = 0u;
    __syncthreads();
    XcdBarrier bar = xcd_barrier_post((unsigned*)(p.ws + WS_BAR), (volatile LAS unsigned*)(smem + LDS_MAIN));
    if (p.phase_lo < 0) cg::this_grid().sync();
    for (int ph = p.phase_lo; ph < p.phase_hi; ++ph) {
        run_phase(p, ph, smem);
        if (ph + 1 < p.phase_hi) xcd_barrier(bar);
    }
}

extern "C" void kernel_launch(void* const* d_in, const int* in_sizes, int n_in, void* d_out, int out_size, void* d_ws, size_t ws_size,
                              hipStream_t stream) {
    Params p{};
    const float** f = (const float**)&p;
    for (int i = 0; i < 29; ++i) f[i] = (const float*)d_in[i];
    p.out = (float*)d_out;
    p.ws = (unsigned char*)d_ws;
    static int grid_blocks = 0;
    if (!grid_blocks) {
        int dev = 0, cus = 0;
        (void)hipGetDevice(&dev);
        (void)hipDeviceGetAttribute(&cus, hipDeviceAttributeMultiprocessorCount, dev);
        (void)hipFuncSetAttribute((const void*)mega, hipFuncAttributeMaxDynamicSharedMemorySize, LDS_BYTES);
        grid_blocks = cus;
        if (ws_size < WS_TOTAL) fprintf(stderr, "workspace too small: %zu < %zu\n", ws_size, (size_t)WS_TOTAL);
    }
    (void)hipMemsetAsync((char*)d_ws + WS_CNT, 0, WS_CTL_BYTES, stream);
    p.phase_lo = 0; p.phase_hi = NPHASE;
    void* args[] = {&p};
    hipError_t e = hipLaunchCooperativeKernel((void*)mega, dim3(grid_blocks), dim3(NTH), args, LDS_BYTES, stream);
    if (e != hipSuccess) fprintf(stderr, "cooperative launch failed: %s (grid %d)\n", hipGetErrorString(e), grid_blocks);
}
```
